# Optimizing an MI355X kernel written in HIP

```python
import jax, jax.numpy as jnp
from jax import lax
import numpy as np

D_MODEL = 1024
BATCH = 8
SEQ = 2048
DEPTH = 2

CTX_LEN = 256
GRID_W = 64
N_Q_HEADS = 8
N_KV_HEADS = 2
HEAD_DIM = 64
ATTN_WIDTH = N_Q_HEADS * HEAD_DIM
KV_WIDTH = N_KV_HEADS * HEAD_DIM
Q_BLOCK = 128
ROPE_THETA = 10000.0
LRU_WIDTH = 512
LRU_BLOCKS = 8
LRU_BLOCK = LRU_WIDTH // LRU_BLOCKS
CONV_WIDTH = 4
LRU_C = 8.0
N_DIRS = 2
MIX_WIDTH = ATTN_WIDTH + LRU_WIDTH
IN_WIDTH = ATTN_WIDTH + 2 * KV_WIDTH + 2 * LRU_WIDTH
N_EXPERTS = 16
N_EXPERT_GROUPS = 4
EXPERTS_PER_GROUP = N_EXPERTS // N_EXPERT_GROUPS
TOP_K = 2
D_EXPERT = 512
N_MOD = 6
NORM_EPS = 1e-6

kernel_name = "hybrid_gqa_rglru_grouped_moe_dit"


def rms_norm(x, g):
    xf = x.astype(jnp.float32)
    y = xf * lax.rsqrt(jnp.mean(xf * xf, axis=-1, keepdims=True) + NORM_EPS)
    return (y * g.astype(jnp.float32)).astype(x.dtype)


def modulate(h, shift, scale):
    return h * (1 + scale) + shift


def axial_rope_tables(n_tokens):
    rows = n_tokens // GRID_W
    r, col = jnp.meshgrid(jnp.arange(rows), jnp.arange(GRID_W), indexing="ij")
    r = r.reshape(-1).astype(jnp.float32)
    col = col.reshape(-1).astype(jnp.float32)
    half = HEAD_DIM // 2
    inv = ROPE_THETA ** (-jnp.arange(0, half, 2, dtype=jnp.float32) / half)
    ang = jnp.concatenate([r[:, None] * inv, col[:, None] * inv], axis=-1)
    return jnp.cos(ang), jnp.sin(ang)


def apply_axial_rope(x, cos, sin):
    S = x.shape[1]
    quarter = HEAD_DIM // 4
    xr = x.reshape(x.shape[:-1] + (2, 2, quarter))
    x1, x2 = xr[..., 0, :], xr[..., 1, :]
    cs = cos.reshape(S, 1, 2, quarter).astype(x.dtype)
    sn = sin.reshape(S, 1, 2, quarter).astype(x.dtype)
    o1 = x1 * cs - x2 * sn
    o2 = x2 * cs + x1 * sn
    return jnp.stack([o1, o2], axis=-2).reshape(x.shape)


def blocked_attention(q, k, v):
    B, Tq = q.shape[:2]
    n_blk = Tq // Q_BLOCK
    grp = N_Q_HEADS // N_KV_HEADS
    scale = HEAD_DIM ** -0.5
    qb = q.reshape(B, n_blk, Q_BLOCK, N_KV_HEADS, grp, HEAD_DIM).transpose(1, 0, 2, 3, 4, 5)

    def one_block(q_blk):
        s = jnp.einsum("bqhgd,bkhd->bhgqk", q_blk, k).astype(jnp.float32) * scale
        p = jax.nn.softmax(s, axis=-1).astype(v.dtype)
        return jnp.einsum("bhgqk,bkhd->bqhgd", p, v)

    out = lax.map(one_block, qb)
    return out.transpose(1, 0, 2, 3, 4, 5).reshape(B, Tq, ATTN_WIDTH)


def centred_depthwise_conv(u, w, b):
    left = CONV_WIDTH // 2
    out = lax.conv_general_dilated(
        u, w[:, None, :].astype(u.dtype), window_strides=(1,),
        padding=[(left, CONV_WIDTH - 1 - left)],
        dimension_numbers=("NWC", "WIO", "NWC"), feature_group_count=u.shape[-1])
    return out + b


def linear_scan(a, b):
    def combine(left, right):
        a_l, b_l = left
        a_r, b_r = right
        return a_l * a_r, a_r * b_l + b_r
    _, h = lax.associative_scan(combine, (a, b), axis=1)
    return h


def rglru_direction(u, h0, w_a, b_a, w_x, b_x, lam, reverse):
    B, T, W = u.shape
    ub = u.reshape(B, T, LRU_BLOCKS, LRU_BLOCK)
    r = jax.nn.sigmoid(jnp.einsum("btnd,nde->btne", ub, w_a).reshape(B, T, W) + b_a)
    i = jax.nn.sigmoid(jnp.einsum("btnd,nde->btne", ub, w_x).reshape(B, T, W) + b_x)
    log_a = (-LRU_C * r.astype(jnp.float32)) * jax.nn.softplus(-lam.astype(jnp.float32))
    a = jnp.exp(log_a)
    b = jnp.sqrt(-jnp.expm1(2.0 * log_a)) * (i * u).astype(jnp.float32)
    if reverse:
        a, b = a[:, ::-1], b[:, ::-1]
    b = b.at[:, 0].add(a[:, 0] * h0)
    h = linear_scan(a, b)
    if reverse:
        h = h[:, ::-1]
    return h


def parallel_mixers(h, hc, p, cos, sin, last):
    B, S, _ = h.shape
    C = hc.shape[1]
    cuts = [ATTN_WIDTH, ATTN_WIDTH + KV_WIDTH, ATTN_WIDTH + 2 * KV_WIDTH,
            ATTN_WIDTH + 2 * KV_WIDTH + LRU_WIDTH]
    q, k, v, u, gb = jnp.split(h @ p["w_in"], cuts, axis=-1)
    qc, kc, vc, uc, gbc = jnp.split(hc @ p["w_in"], cuts, axis=-1)

    q = apply_axial_rope(rms_norm(q.reshape(B, S, N_Q_HEADS, HEAD_DIM), p["q_norm_g"]), cos, sin)
    k = apply_axial_rope(rms_norm(k.reshape(B, S, N_KV_HEADS, HEAD_DIM), p["k_norm_g"]), cos, sin)
    v = v.reshape(B, S, N_KV_HEADS, HEAD_DIM)
    kc = rms_norm(kc.reshape(B, C, N_KV_HEADS, HEAD_DIM), p["k_norm_g"])
    vc = vc.reshape(B, C, N_KV_HEADS, HEAD_DIM)
    k_all = jnp.concatenate([kc, k], axis=1)
    v_all = jnp.concatenate([vc, v], axis=1)
    attn = blocked_attention(q, k_all, v_all)

    u = centred_depthwise_conv(u, p["conv_w"], p["conv_b"])
    uc = centred_depthwise_conv(uc, p["conv_w"], p["conv_b"])
    zeros = jnp.zeros((B, LRU_WIDTH), jnp.float32)
    h_lat = 0.0
    h_ctx = 0.0
    for d, reverse in enumerate((False, True)):
        args = (p["lru_wa"][d], p["lru_ba"][d], p["lru_wx"][d], p["lru_bx"][d], p["lru_lambda"][d], reverse)
        hc_d = rglru_direction(uc, zeros, *args)
        h0 = hc_d[:, 0] if reverse else hc_d[:, -1]
        h_lat = h_lat + rglru_direction(u, h0, *args)
        h_ctx = h_ctx + hc_d
    rec = h_lat.astype(h.dtype) * jax.nn.gelu(gb, approximate=True)
    mix = jnp.concatenate([rms_norm(attn, p["attn_out_g"]), rms_norm(rec, p["lru_out_g"])], axis=-1)
    if last:
        return mix, None

    qc = rms_norm(qc.reshape(B, C, N_Q_HEADS, HEAD_DIM), p["q_norm_g"])
    attn_c = blocked_attention(qc, kc, vc)
    rec_c = h_ctx.astype(hc.dtype) * jax.nn.gelu(gbc, approximate=True)
    mix_c = jnp.concatenate([rms_norm(attn_c, p["attn_out_g"]), rms_norm(rec_c, p["lru_out_g"])], axis=-1)
    return mix, mix_c


def grouped_moe(h, router_w, router_b, w_gate, w_up, w_down):
    N = h.shape[0]
    scores = jax.nn.sigmoid(h.astype(jnp.float32) @ router_w.astype(jnp.float32))
    biased = scores + router_b.astype(jnp.float32)
    grouped = biased.reshape(N, N_EXPERT_GROUPS, EXPERTS_PER_GROUP)
    group_score = lax.top_k(grouped, TOP_K)[0].sum(-1)
    best_group = jnp.argmax(group_score, axis=-1)
    in_group = (jnp.arange(N_EXPERTS) // EXPERTS_PER_GROUP)[None, :] == best_group[:, None]
    masked = jnp.where(in_group, biased, -jnp.inf)
    _, top_idx = lax.top_k(masked, TOP_K)
    top_w = jnp.take_along_axis(scores, top_idx, axis=-1)
    top_w = top_w / jnp.sum(top_w, axis=-1, keepdims=True)
    combine = jnp.einsum("nk,nke->ne", top_w,
                         jax.nn.one_hot(top_idx, N_EXPERTS, dtype=jnp.float32)).astype(h.dtype)
    out = jnp.zeros_like(h)
    for e in range(N_EXPERTS):
        hid = jax.nn.silu(h @ w_gate[e]) * (h @ w_up[e])
        out = out + combine[:, e:e + 1] * (hid @ w_down[e])
    return out


def hybrid_layer(x, xc, mod, mod_c, p, router_w, router_b, cos, sin, last):
    B, S, D = x.shape
    C = xc.shape[1]
    sh1, sc1, g1, sh2, sc2, g2 = jnp.split(mod[:, None, :], N_MOD, axis=-1)
    csh1, csc1, cg1, csh2, csc2, cg2 = jnp.split(mod_c, N_MOD, axis=-1)

    h = modulate(rms_norm(x, p["norm1_g"]), sh1, sc1)
    hc = modulate(rms_norm(xc, p["norm1_g"]), csh1, csc1)
    mix, mix_c = parallel_mixers(h, hc, p, cos, sin, last)
    x = x + g1 * (mix @ p["w_out"])
    h2 = modulate(rms_norm(x, p["norm2_g"]), sh2, sc2)
    moe_w = (router_w, router_b, p["w_gate"], p["w_up"], p["w_down"])
    if last:
        y = grouped_moe(h2.reshape(B * S, D), *moe_w).reshape(B, S, D)
        return x + g2 * y, xc

    xc = xc + cg1 * (mix_c @ p["w_out"])
    hc2 = modulate(rms_norm(xc, p["norm2_g"]), csh2, csc2)
    tokens = jnp.concatenate([h2.reshape(B * S, D), hc2.reshape(B * C, D)], axis=0)
    y = grouped_moe(tokens, *moe_w)
    x = x + g2 * y[:B * S].reshape(B, S, D)
    xc = xc + cg2 * y[B * S:].reshape(B, C, D)
    return x, xc


def setup_inputs(seed: int = 0) -> dict:
    key = jax.random.key(seed)
    ks = jax.random.split(key, 32)
    f32 = jnp.float32
    D = D_MODEL

    def nrm(k, shape, scale):
        return jax.random.normal(k, shape, f32) * scale

    a_pow = jax.random.uniform(ks[16], (DEPTH, N_DIRS, LRU_WIDTH), f32, minval=0.9, maxval=0.999)
    a_base = a_pow ** (1.0 / LRU_C)
    lru_lambda = jnp.log(a_base) - jnp.log1p(-a_base)
    return {
        "x": nrm(ks[0], (BATCH, SEQ, D), 1.0),
        "c": nrm(ks[1], (BATCH, D), 1.0),
        "ctx": nrm(ks[2], (BATCH, CTX_LEN, D), 1.0),
        "c_ctx": nrm(ks[3], (D,), 1.0),
        "ada_w": nrm(ks[4], (DEPTH, D, N_MOD * D), 0.5 * D ** -0.5),
        "ada_b": nrm(ks[5], (DEPTH, N_MOD * D), 0.02),
        "norm1_g": 1.0 + nrm(ks[6], (DEPTH, D), 0.02),
        "w_in": nrm(ks[7], (DEPTH, D, IN_WIDTH), D ** -0.5),
        "q_norm_g": 1.0 + nrm(ks[8], (DEPTH, HEAD_DIM), 0.02),
        "k_norm_g": 1.0 + nrm(ks[9], (DEPTH, HEAD_DIM), 0.02),
        "conv_w": nrm(ks[10], (DEPTH, CONV_WIDTH, LRU_WIDTH), CONV_WIDTH ** -0.5),
        "conv_b": nrm(ks[11], (DEPTH, LRU_WIDTH), 0.02),
        "lru_wa": nrm(ks[12], (DEPTH, N_DIRS, LRU_BLOCKS, LRU_BLOCK, LRU_BLOCK), LRU_BLOCK ** -0.5),
        "lru_ba": nrm(ks[13], (DEPTH, N_DIRS, LRU_WIDTH), 0.1),
        "lru_wx": nrm(ks[14], (DEPTH, N_DIRS, LRU_BLOCKS, LRU_BLOCK, LRU_BLOCK), LRU_BLOCK ** -0.5),
        "lru_bx": nrm(ks[15], (DEPTH, N_DIRS, LRU_WIDTH), 0.1),
        "lru_lambda": lru_lambda,
        "attn_out_g": 1.0 + nrm(ks[17], (DEPTH, ATTN_WIDTH), 0.02),
        "lru_out_g": 1.0 + nrm(ks[18], (DEPTH, LRU_WIDTH), 0.02),
        "w_out": nrm(ks[19], (DEPTH, MIX_WIDTH, D), MIX_WIDTH ** -0.5),
        "norm2_g": 1.0 + nrm(ks[20], (DEPTH, D), 0.02),
        "router_w": nrm(ks[21], (D, N_EXPERTS), D ** -0.5),
        "router_b": nrm(ks[22], (N_EXPERTS,), 0.01),
        "exp_w_gate": nrm(ks[23], (DEPTH, N_EXPERTS, D, D_EXPERT), D ** -0.5),
        "exp_w_up": nrm(ks[24], (DEPTH, N_EXPERTS, D, D_EXPERT), D ** -0.5),
        "exp_w_down": nrm(ks[25], (DEPTH, N_EXPERTS, D_EXPERT, D), D_EXPERT ** -0.5),
        "final_g": 1.0 + nrm(ks[26], (D,), 0.02),
    }


def reference(x, c, ctx, c_ctx, ada_w, ada_b, norm1_g, w_in, q_norm_g, k_norm_g,
              conv_w, conv_b, lru_wa, lru_ba, lru_wx, lru_bx, lru_lambda,
              attn_out_g, lru_out_g, w_out, norm2_g, router_w, router_b,
              exp_w_gate, exp_w_up, exp_w_down, final_g):
    cos, sin = axial_rope_tables(x.shape[1])
    silu_c = jax.nn.silu(c)
    silu_cc = jax.nn.silu(c_ctx)
    xc = ctx
    for l in range(DEPTH):
        mod = silu_c @ ada_w[l] + ada_b[l]
        mod_c = silu_cc @ ada_w[l] + ada_b[l]
        p = {
            "norm1_g": norm1_g[l], "w_in": w_in[l], "q_norm_g": q_norm_g[l], "k_norm_g": k_norm_g[l],
            "conv_w": conv_w[l], "conv_b": conv_b[l], "lru_wa": lru_wa[l], "lru_ba": lru_ba[l],
            "lru_wx": lru_wx[l], "lru_bx": lru_bx[l], "lru_lambda": lru_lambda[l],
            "attn_out_g": attn_out_g[l], "lru_out_g": lru_out_g[l], "w_out": w_out[l],
            "norm2_g": norm2_g[l], "w_gate": exp_w_gate[l], "w_up": exp_w_up[l], "w_down": exp_w_down[l],
        }
        x, xc = hybrid_layer(x, xc, mod, mod_c, p, router_w, router_b, cos, sin, l == DEPTH - 1)
    return rms_norm(x, final_g)
```

```cpp
#include <hip/hip_runtime.h>
#include <stdint.h>
#include <cstdio>

#define DEV __device__ __forceinline__
typedef unsigned short bf16_t;

constexpr int D = 1024, NB = 8, S = 2048, CL = 256, TL = NB * S, TC = NB * CL, TT = TL + TC;
constexpr int INW = 1792, NE = 16, DE = 512;
constexpr float EPS = 1e-6f;

DEV float bf2f(bf16_t v) { return __uint_as_float(((unsigned)v) << 16); }
DEV bf16_t f2bf(float f) { unsigned u = __float_as_uint(f); u += 0x7fffu + ((u >> 16) & 1u); return (bf16_t)(u >> 16); }
DEV float bflo(unsigned w) { return __uint_as_float(w << 16); }
DEV float bfhi(unsigned w) { return __uint_as_float(w & 0xffff0000u); }
DEV unsigned pack2(float lo, float hi) { return (unsigned)f2bf(lo) | ((unsigned)f2bf(hi) << 16); }
DEV float wave_sum(float v) {
#pragma unroll
    for (int o = 32; o > 0; o >>= 1) v += __shfl_xor(v, o);
    return v;
}
DEV float sigmoidf_(float x) { return 1.f / (1.f + __expf(-x)); }
DEV float gelu_tanh(float x) {
    const float u = 0.7978845608028654f * (x + 0.044715f * x * x * x);
    const float e = __expf(2.f * u);
    const float th = 1.f - 2.f / (e + 1.f);
    return 0.5f * x * (1.f + th);
}
DEV int mod_row(int t) { return t < TL ? (t >> 11) : 8; }

struct P {
    const float *x, *c, *ctx, *c_ctx, *ada_w, *ada_b, *norm1_g, *w_in, *q_norm_g, *k_norm_g, *conv_w, *conv_b, *lru_wa, *lru_ba, *lru_wx, *lru_bx,
        *lru_lambda, *attn_out_g, *lru_out_g, *w_out, *norm2_g, *router_w, *router_b, *w_gate, *w_up, *w_down, *final_g;
    float* out;
    float *mod, *rope, *xres, *la, *lb, *tokw;
    bf16_t *xn, *q, *k, *v, *u, *gb, *att, *hdir, *hid, *y;
    int *cnt, *list;
};

DEV void phase_mod(const P& p, int bid, int nb, float* lds) {
    const int tid = threadIdx.x;
    float* sil = lds;
    bool have = false;
    for (int w = bid; w < 49; w += nb) {
        if (w == 48) {
            for (int i = tid; i < 1024; i += 256) {
                const int pos = i >> 4, f = i & 15;
                const float inv = exp2f(-(float)(2 * f) / 32.f * 13.287712379549449f);
                const float ang = (float)pos * inv;
                p.rope[i] = __cosf(ang); p.rope[1024 + i] = __sinf(ang);
            }
            if (tid < 32) p.cnt[tid] = 0;
            continue;
        }
        if (!have) {
            for (int i = tid; i < 9 * 1024; i += 256) {
                const int r = i >> 10, d = i & 1023;
                const float v = r < 8 ? p.c[r * 1024 + d] : p.c_ctx[d];
                sil[i] = v * sigmoidf_(v);
            }
            __syncthreads(); have = true;
        }
        const int gid = w * 256 + tid, l = gid / 6144, col = gid % 6144;
        const float* wp = p.ada_w + (size_t)l * 1024 * 6144 + col;
        float acc[9];
#pragma unroll
        for (int r = 0; r < 9; ++r) acc[r] = 0.f;
        for (int k = 0; k < 1024; ++k) {
            const float wv = wp[(size_t)k * 6144];
#pragma unroll
            for (int r = 0; r < 9; ++r) acc[r] += sil[r * 1024 + k] * wv;
        }
        const float bb = p.ada_b[l * 6144 + col];
#pragma unroll
        for (int r = 0; r < 9; ++r) p.mod[(size_t)(l * 9 + r) * 6144 + col] = acc[r] + bb;
    }
}

template <int MODE>
DEV void phase_rowA(const P& p, int l, int bid, int nb) {
    const int lane = threadIdx.x & 63, wv = threadIdx.x >> 6;
    const int nrows = (MODE == 2) ? TL : TT;
    for (int t = bid * 4 + wv; t < nrows; t += nb * 4) {
        const int mr = mod_row(t);
        float xv[16];
        if (MODE == 0) {
            const float* src = t < TL ? p.x + (size_t)t * D : p.ctx + (size_t)(t - TL) * D;
#pragma unroll
            for (int i = 0; i < 4; ++i) { const float4 v4 = *(const float4*)(src + i * 256 + lane * 4); xv[i * 4] = v4.x; xv[i * 4 + 1] = v4.y; xv[i * 4 + 2] = v4.z; xv[i * 4 + 3] = v4.w; }
        } else {
            const int lp = (MODE == 2) ? 1 : 0;
            const float* src = p.xres + (size_t)t * D;
            const float* g2 = p.mod + (size_t)(lp * 9 + mr) * 6144 + 5 * 1024;
            const bf16_t* y0 = p.y + (size_t)(2 * t) * D; const bf16_t* y1 = y0 + D;
#pragma unroll
            for (int i = 0; i < 4; ++i) {
                const int c0 = i * 256 + lane * 4;
                const float4 v4 = *(const float4*)(src + c0); const float4 g4 = *(const float4*)(g2 + c0);
                const uint2 a = *(const uint2*)(y0 + c0), b = *(const uint2*)(y1 + c0);
                xv[i * 4] = v4.x + g4.x * (bflo(a.x) + bflo(b.x)); xv[i * 4 + 1] = v4.y + g4.y * (bfhi(a.x) + bfhi(b.x));
                xv[i * 4 + 2] = v4.z + g4.z * (bflo(a.y) + bflo(b.y)); xv[i * 4 + 3] = v4.w + g4.w * (bfhi(a.y) + bfhi(b.y));
            }
            if (MODE == 1) {
#pragma unroll
                for (int i = 0; i < 4; ++i) *(float4*)(p.xres + (size_t)t * D + i * 256 + lane * 4) = make_float4(xv[i * 4], xv[i * 4 + 1], xv[i * 4 + 2], xv[i * 4 + 3]);
            }
        }
        float ss = 0.f;
#pragma unroll
        for (int i = 0; i < 16; ++i) ss += xv[i] * xv[i];
        ss = wave_sum(ss);
        const float rstd = rsqrtf(ss * (1.f / D) + EPS);
        if (MODE == 2) {
#pragma unroll
            for (int i = 0; i < 4; ++i) {
                const int c0 = i * 256 + lane * 4; const float4 g4 = *(const float4*)(p.final_g + c0);
                *(float4*)(p.out + (size_t)t * D + c0) = make_float4(xv[i * 4] * rstd * g4.x, xv[i * 4 + 1] * rstd * g4.y, xv[i * 4 + 2] * rstd * g4.z, xv[i * 4 + 3] * rstd * g4.w);
            }
        } else {
            const float* ng = p.norm1_g + l * D; const float* mm = p.mod + (size_t)(l * 9 + mr) * 6144;
#pragma unroll
            for (int i = 0; i < 4; ++i) {
                const int c0 = i * 256 + lane * 4;
                const float4 g4 = *(const float4*)(ng + c0), sh = *(const float4*)(mm + c0), sc = *(const float4*)(mm + 1024 + c0);
                const float o0 = xv[i * 4] * rstd * g4.x * (1.f + sc.x) + sh.x, o1 = xv[i * 4 + 1] * rstd * g4.y * (1.f + sc.y) + sh.y;
                const float o2 = xv[i * 4 + 2] * rstd * g4.z * (1.f + sc.z) + sh.z, o3 = xv[i * 4 + 3] * rstd * g4.w * (1.f + sc.w) + sh.w;
                *(uint2*)(p.xn + (size_t)t * D + c0) = make_uint2(pack2(o0, o1), pack2(o2, o3));
            }
        }
    }
}

DEV void gemm64(float (&acc)[4][4], const bf16_t* __restrict__ A, int lda, int arow_g, const float* __restrict__ W, int ldw, int K, float* As, float* Bs) {
    const int tid = threadIdx.x, tx = tid & 15, ty = tid >> 4;
    const int ar = tid >> 2, ak = (tid & 3) * 4;
    const int bk = tid >> 4, bc = (tid & 15) * 4;
#pragma unroll
    for (int i = 0; i < 4; ++i)
#pragma unroll
        for (int j = 0; j < 4; ++j) acc[i][j] = 0.f;
    for (int k0 = 0; k0 < K; k0 += 16) {
        float a0 = 0.f, a1 = 0.f, a2 = 0.f, a3 = 0.f;
        if (arow_g >= 0) { const uint2 raw = *(const uint2*)(A + (size_t)arow_g * lda + k0 + ak); a0 = bflo(raw.x); a1 = bfhi(raw.x); a2 = bflo(raw.y); a3 = bfhi(raw.y); }
        const float4 bv = *(const float4*)(W + (size_t)(k0 + bk) * ldw + bc);
        __syncthreads();
        As[(ak + 0) * 68 + ar] = a0; As[(ak + 1) * 68 + ar] = a1; As[(ak + 2) * 68 + ar] = a2; As[(ak + 3) * 68 + ar] = a3;
        *(float4*)&Bs[bk * 64 + bc] = bv;
        __syncthreads();
#pragma unroll
        for (int kk = 0; kk < 16; ++kk) {
            const float4 av = *(const float4*)&As[kk * 68 + ty * 4]; const float4 bb = *(const float4*)&Bs[kk * 64 + tx * 4];
            const float a_[4] = {av.x, av.y, av.z, av.w}, b_[4] = {bb.x, bb.y, bb.z, bb.w};
#pragma unroll
            for (int i = 0; i < 4; ++i)
#pragma unroll
                for (int j = 0; j < 4; ++j) acc[i][j] += a_[i] * b_[j];
        }
    }
    __syncthreads();
}

DEV void phase_gemm_in(const P& p, int l, int bid, int nb, float* lds) {
    float* As = lds; float* Bs = lds + 16 * 68; float* Ct = Bs + 16 * 64;
    const int tid = threadIdx.x, tx = tid & 15, ty = tid >> 4;
    const float* W = p.w_in + (size_t)l * D * INW;
    const int ntiles = (TT / 64) * 28;
    for (int w = bid; w < ntiles; w += nb) {
        const int mt = w / 28, nt = w % 28, m0 = mt * 64, n0 = nt * 64;
        if (l == 1 && m0 >= TL && (nt < 8 || nt >= 20)) continue;
        float acc[4][4];
        gemm64(acc, p.xn, D, m0 + (tid >> 2), W + n0, INW, D, As, Bs);
#pragma unroll
        for (int i = 0; i < 4; ++i)
#pragma unroll
            for (int j = 0; j < 4; ++j) Ct[(ty * 4 + i) * 65 + tx * 4 + j] = acc[i][j];
        __syncthreads();
        const int r = tid >> 2, sub = tid & 3, t = m0 + r;
        float vals[16];
#pragma unroll
        for (int j = 0; j < 16; ++j) vals[j] = Ct[r * 65 + sub * 16 + j];
        bf16_t* dst;
        if (nt < 10) {
            float ss = 0.f;
#pragma unroll
            for (int j = 0; j < 16; ++j) ss += vals[j] * vals[j];
            ss += __shfl_xor(ss, 1); ss += __shfl_xor(ss, 2);
            const float rstd = rsqrtf(ss * (1.f / 64.f) + EPS);
            const float* g = (nt < 8 ? p.q_norm_g : p.k_norm_g) + l * 64;
            const bool lat = t < TL;
            const int s = t & 2047, pos = (sub >> 1) ? (s & 63) : (s >> 6);
#pragma unroll
            for (int j = 0; j < 16; ++j) {
                const int d = sub * 16 + j, dp = d ^ 16;
                const float v = vals[j] * rstd * g[d];
                if (lat) {
                    const float pv = Ct[r * 65 + dp] * rstd * g[dp];
                    const float cs = p.rope[pos * 16 + j], sn = p.rope[1024 + pos * 16 + j];
                    vals[j] = (sub & 1) ? (v * cs + pv * sn) : (v * cs - pv * sn);
                } else vals[j] = v;
            }
            dst = nt < 8 ? p.q + (size_t)t * 512 + nt * 64 : p.k + (size_t)t * 128 + (nt - 8) * 64;
        } else if (nt < 12) dst = p.v + (size_t)t * 128 + (nt - 10) * 64;
        else if (nt < 20) dst = p.u + (size_t)t * 512 + (nt - 12) * 64;
        else dst = p.gb + (size_t)t * 512 + (nt - 20) * 64;
        uint4 o0, o1;
        o0.x = pack2(vals[0], vals[1]); o0.y = pack2(vals[2], vals[3]); o0.z = pack2(vals[4], vals[5]); o0.w = pack2(vals[6], vals[7]);
        o1.x = pack2(vals[8], vals[9]); o1.y = pack2(vals[10], vals[11]); o1.z = pack2(vals[12], vals[13]); o1.w = pack2(vals[14], vals[15]);
        *(uint4*)(dst + sub * 16) = o0; *(uint4*)(dst + sub * 16 + 8) = o1;
        __syncthreads();
    }
}

DEV void phase_attn(const P& p, int l, int bid, int nb) {
    const int tid = threadIdx.x;
    const int nitems = (l == 0) ? 512 + 64 : 512;
    for (int w = bid; w < nitems; w += nb) {
        int b, h, qrow, nkeys;
        if (w < 512) { b = w >> 6; h = (w >> 3) & 7; qrow = b * S + (w & 7) * 256 + tid; nkeys = CL + S; }
        else { const int w2 = w - 512; b = w2 >> 3; h = w2 & 7; qrow = TL + b * CL + tid; nkeys = CL; }
        const int kvh = h >> 2;
        float qv[64], o[64];
        const bf16_t* qp = p.q + (size_t)qrow * 512 + h * 64;
#pragma unroll
        for (int i = 0; i < 8; ++i) {
            const uint4 r4 = *(const uint4*)(qp + i * 8);
            qv[i * 8] = bflo(r4.x) * 0.125f; qv[i * 8 + 1] = bfhi(r4.x) * 0.125f; qv[i * 8 + 2] = bflo(r4.y) * 0.125f; qv[i * 8 + 3] = bfhi(r4.y) * 0.125f;
            qv[i * 8 + 4] = bflo(r4.z) * 0.125f; qv[i * 8 + 5] = bfhi(r4.z) * 0.125f; qv[i * 8 + 6] = bflo(r4.w) * 0.125f; qv[i * 8 + 7] = bfhi(r4.w) * 0.125f;
        }
#pragma unroll
        for (int i = 0; i < 64; ++i) o[i] = 0.f;
        float mx = -1e30f, den = 0.f;
        for (int j = 0; j < nkeys; ++j) {
            const int krow = j < CL ? TL + b * CL + j : b * S + (j - CL);
            const bf16_t* kp = p.k + (size_t)krow * 128 + kvh * 64; const bf16_t* vp = p.v + (size_t)krow * 128 + kvh * 64;
            float sc = 0.f;
#pragma unroll
            for (int i = 0; i < 8; ++i) {
                const uint4 r4 = *(const uint4*)(kp + i * 8);
                sc += qv[i * 8] * bflo(r4.x) + qv[i * 8 + 1] * bfhi(r4.x) + qv[i * 8 + 2] * bflo(r4.y) + qv[i * 8 + 3] * bfhi(r4.y)
                    + qv[i * 8 + 4] * bflo(r4.z) + qv[i * 8 + 5] * bfhi(r4.z) + qv[i * 8 + 6] * bflo(r4.w) + qv[i * 8 + 7] * bfhi(r4.w);
            }
            const float mn = fmaxf(mx, sc), corr = __expf(mx - mn), pe = __expf(sc - mn);
            den = den * corr + pe; mx = mn;
#pragma unroll
            for (int i = 0; i < 8; ++i) {
                const uint4 r4 = *(const uint4*)(vp + i * 8);
                o[i * 8] = o[i * 8] * corr + pe * bflo(r4.x); o[i * 8 + 1] = o[i * 8 + 1] * corr + pe * bfhi(r4.x);
                o[i * 8 + 2] = o[i * 8 + 2] * corr + pe * bflo(r4.y); o[i * 8 + 3] = o[i * 8 + 3] * corr + pe * bfhi(r4.y);
                o[i * 8 + 4] = o[i * 8 + 4] * corr + pe * bflo(r4.z); o[i * 8 + 5] = o[i * 8 + 5] * corr + pe * bfhi(r4.z);
                o[i * 8 + 6] = o[i * 8 + 6] * corr + pe * bflo(r4.w); o[i * 8 + 7] = o[i * 8 + 7] * corr + pe * bfhi(r4.w);
            }
        }
        const float inv = 1.f / den;
        bf16_t* op = p.att + (size_t)qrow * 512 + h * 64;
#pragma unroll
        for (int i = 0; i < 8; ++i) {
            uint4 r4; r4.x = pack2(o[i * 8] * inv, o[i * 8 + 1] * inv); r4.y = pack2(o[i * 8 + 2] * inv, o[i * 8 + 3] * inv);
            r4.z = pack2(o[i * 8 + 4] * inv, o[i * 8 + 5] * inv); r4.w = pack2(o[i * 8 + 6] * inv, o[i * 8 + 7] * inv);
            *(uint4*)(op + i * 8) = r4;
        }
    }
}

DEV void phase_lru_gates(const P& p, int ld, int bid, int nb, float* lds) {
    float* uc = lds;
    const int tid = threadIdx.x, l = ld & 15, d = ld >> 4;
    const float* cw = p.conv_w + l * 4 * 512; const float* cb = p.conv_b + l * 512;
    for (int w = bid; w < TT / 16; w += nb) {
        const int t0 = w * 16;
        const int seq0 = t0 < TL ? (t0 & ~2047) : TL + ((t0 - TL) & ~255);
        const int seqlen = t0 < TL ? S : CL;
        __syncthreads();
        for (int i = tid; i < 16 * 512; i += 256) {
            const int tt = i >> 9, ch = i & 511, t = t0 + tt;
            float acc = cb[ch];
#pragma unroll
            for (int j = 0; j < 4; ++j) { const int ts = t - 2 + j; if (ts >= seq0 && ts < seq0 + seqlen) acc += bf2f(p.u[(size_t)ts * 512 + ch]) * cw[j * 512 + ch]; }
            uc[i] = acc;
        }
        __syncthreads();
        for (int pass = 0; pass < 2; ++pass) {
            const int e = pass * 256 + tid, n = e >> 6, ee = e & 63;
            const float* wa = p.lru_wa + ((size_t)((l * 2 + d) * 8 + n) * 64) * 64 + ee;
            const float* wx = p.lru_wx + ((size_t)((l * 2 + d) * 8 + n) * 64) * 64 + ee;
            float ra[16], ri[16];
#pragma unroll
            for (int tt = 0; tt < 16; ++tt) { ra[tt] = 0.f; ri[tt] = 0.f; }
            for (int dd = 0; dd < 64; ++dd) {
                const float wav = wa[dd * 64], wxv = wx[dd * 64];
#pragma unroll
                for (int tt = 0; tt < 16; ++tt) { const float uv = uc[tt * 512 + n * 64 + dd]; ra[tt] += uv * wav; ri[tt] += uv * wxv; }
            }
            const int pi = (l * 2 + d) * 512 + e;
            const float ba = p.lru_ba[pi], bx = p.lru_bx[pi], lam = p.lru_lambda[pi];
            const float sp = (-lam > 20.f) ? -lam : log1pf(__expf(-lam));
#pragma unroll
            for (int tt = 0; tt < 16; ++tt) {
                const float r = sigmoidf_(ra[tt] + ba), ig = sigmoidf_(ri[tt] + bx);
                const float log_a = -8.f * r * sp;
                const float a = __expf(log_a);
                const float bm = sqrtf(fmaxf(1.f - __expf(2.f * log_a), 0.f)) * (ig * uc[tt * 512 + e]);
                const size_t o = ((size_t)t0 + tt) * 512 + e;
                p.la[o] = a; p.lb[o] = bm;
            }
        }
    }
}

DEV void phase_lru_scan(const P& p, int ld, int bid, int nb) {
    const int d = ld >> 4;
    for (int w = bid; w < 16; w += nb) {
        const int b = w >> 1, ch = (w & 1) * 256 + threadIdx.x;
        const float* la = p.la + ch; const float* lb = p.lb + ch;
        bf16_t* hd = p.hdir + (size_t)d * TT * 512 + ch;
        float h = 0.f;
        const int cbase = TL + b * CL, lbase = b * S;
        if (d == 0) {
#pragma unroll 8
            for (int i = 0; i < CL; ++i) { const size_t o = (size_t)(cbase + i) * 512; h = la[o] * h + lb[o]; hd[o] = f2bf(h); }
#pragma unroll 8
            for (int i = 0; i < S; ++i) { const size_t o = (size_t)(lbase + i) * 512; h = la[o] * h + lb[o]; hd[o] = f2bf(h); }
        } else {
#pragma unroll 8
            for (int i = CL - 1; i >= 0; --i) { const size_t o = (size_t)(cbase + i) * 512; h = la[o] * h + lb[o]; hd[o] = f2bf(h); }
#pragma unroll 8
            for (int i = S - 1; i >= 0; --i) { const size_t o = (size_t)(lbase + i) * 512; h = la[o] * h + lb[o]; hd[o] = f2bf(h); }
        }
    }
}

DEV void phase_mix(const P& p, int l, int bid, int nb) {
    const int lane = threadIdx.x & 63, wv = threadIdx.x >> 6;
    const int nrows = l == 0 ? TT : TL;
    for (int t = bid * 4 + wv; t < nrows; t += nb * 4) {
        const int c0 = lane * 8;
        const uint4 a4 = *(const uint4*)(p.att + (size_t)t * 512 + c0);
        const uint4 f4 = *(const uint4*)(p.hdir + (size_t)t * 512 + c0), b4 = *(const uint4*)(p.hdir + ((size_t)TT + t) * 512 + c0), g4 = *(const uint4*)(p.gb + (size_t)t * 512 + c0);
        float av[8] = {bflo(a4.x), bfhi(a4.x), bflo(a4.y), bfhi(a4.y), bflo(a4.z), bfhi(a4.z), bflo(a4.w), bfhi(a4.w)};
        const float fv[8] = {bflo(f4.x), bfhi(f4.x), bflo(f4.y), bfhi(f4.y), bflo(f4.z), bfhi(f4.z), bflo(f4.w), bfhi(f4.w)};
        const float bv[8] = {bflo(b4.x), bfhi(b4.x), bflo(b4.y), bfhi(b4.y), bflo(b4.z), bfhi(b4.z), bflo(b4.w), bfhi(b4.w)};
        const float gv[8] = {bflo(g4.x), bfhi(g4.x), bflo(g4.y), bfhi(g4.y), bflo(g4.z), bfhi(g4.z), bflo(g4.w), bfhi(g4.w)};
        float rv[8]; float sa = 0.f, sr = 0.f;
#pragma unroll
        for (int i = 0; i < 8; ++i) { rv[i] = (fv[i] + bv[i]) * gelu_tanh(gv[i]); sa += av[i] * av[i]; sr += rv[i] * rv[i]; }
        sa = wave_sum(sa); sr = wave_sum(sr);
        const float ra = rsqrtf(sa * (1.f / 512.f) + EPS), rr = rsqrtf(sr * (1.f / 512.f) + EPS);
        const float* ga = p.attn_out_g + l * 512 + c0; const float* gr = p.lru_out_g + l * 512 + c0;
#pragma unroll
        for (int i = 0; i < 8; ++i) { av[i] = av[i] * ra * ga[i]; rv[i] = rv[i] * rr * gr[i]; }
        uint4 o; o.x = pack2(av[0], av[1]); o.y = pack2(av[2], av[3]); o.z = pack2(av[4], av[5]); o.w = pack2(av[6], av[7]);
        *(uint4*)(p.xn + (size_t)t * D + c0) = o;
        o.x = pack2(rv[0], rv[1]); o.y = pack2(rv[2], rv[3]); o.z = pack2(rv[4], rv[5]); o.w = pack2(rv[6], rv[7]);
        *(uint4*)(p.xn + (size_t)t * D + 512 + c0) = o;
    }
}

DEV void phase_gemm_out(const P& p, int l, int bid, int nb, float* lds) {
    float* As = lds; float* Bs = lds + 16 * 68;
    const int tid = threadIdx.x, tx = tid & 15, ty = tid >> 4;
    const float* W = p.w_out + (size_t)l * D * D;
    const int ntiles = ((l == 0 ? TT : TL) / 64) * 16;
    for (int w = bid; w < ntiles; w += nb) {
        const int mt = w >> 4, nt = w & 15, m0 = mt * 64, n0 = nt * 64;
        float acc[4][4];
        gemm64(acc, p.xn, D, m0 + (tid >> 2), W + n0, D, D, As, Bs);
#pragma unroll
        for (int i = 0; i < 4; ++i) {
            const int t = m0 + ty * 4 + i, mr = mod_row(t), c0 = n0 + tx * 4;
            const float* res = (l == 0) ? (t < TL ? p.x + (size_t)t * D : p.ctx + (size_t)(t - TL) * D) : p.xres + (size_t)t * D;
            const float4 r4 = *(const float4*)(res + c0); const float4 g4 = *(const float4*)(p.mod + (size_t)(l * 9 + mr) * 6144 + 2048 + c0);
            *(float4*)(p.xres + (size_t)t * D + c0) = make_float4(r4.x + g4.x * acc[i][0], r4.y + g4.y * acc[i][1], r4.z + g4.z * acc[i][2], r4.w + g4.w * acc[i][3]);
        }
    }
}

DEV void phase_route(const P& p, int l, int bid, int nb) {
    const int lane = threadIdx.x & 63, wv = threadIdx.x >> 6;
    const int nrows = l == 0 ? TT : TL;
    for (int t = bid * 4 + wv; t < nrows; t += nb * 4) {
        const int mr = mod_row(t);
        const float* src = p.xres + (size_t)t * D;
        float xv[16];
#pragma unroll
        for (int i = 0; i < 4; ++i) { const float4 v4 = *(const float4*)(src + i * 256 + lane * 4); xv[i * 4] = v4.x; xv[i * 4 + 1] = v4.y; xv[i * 4 + 2] = v4.z; xv[i * 4 + 3] = v4.w; }
        float ss = 0.f;
#pragma unroll
        for (int i = 0; i < 16; ++i) ss += xv[i] * xv[i];
        ss = wave_sum(ss);
        const float rstd = rsqrtf(ss * (1.f / D) + EPS);
        const float* ng = p.norm2_g + l * D; const float* mm = p.mod + (size_t)(l * 9 + mr) * 6144;
        float lg[16];
#pragma unroll
        for (int e = 0; e < 16; ++e) lg[e] = 0.f;
#pragma unroll
        for (int i = 0; i < 4; ++i) {
            const int c0 = i * 256 + lane * 4;
            const float4 g4 = *(const float4*)(ng + c0), sh = *(const float4*)(mm + 3072 + c0), sc = *(const float4*)(mm + 4096 + c0);
            const float o0 = xv[i * 4] * rstd * g4.x * (1.f + sc.x) + sh.x, o1 = xv[i * 4 + 1] * rstd * g4.y * (1.f + sc.y) + sh.y;
            const float o2 = xv[i * 4 + 2] * rstd * g4.z * (1.f + sc.z) + sh.z, o3 = xv[i * 4 + 3] * rstd * g4.w * (1.f + sc.w) + sh.w;
            *(uint2*)(p.xn + (size_t)t * D + c0) = make_uint2(pack2(o0, o1), pack2(o2, o3));
            const float hv[4] = {o0, o1, o2, o3};
#pragma unroll
            for (int j = 0; j < 4; ++j) {
                const float4* rw = (const float4*)(p.router_w + (size_t)(c0 + j) * 16);
#pragma unroll
                for (int q4 = 0; q4 < 4; ++q4) { const float4 r4 = rw[q4]; lg[q4 * 4] += hv[j] * r4.x; lg[q4 * 4 + 1] += hv[j] * r4.y; lg[q4 * 4 + 2] += hv[j] * r4.z; lg[q4 * 4 + 3] += hv[j] * r4.w; }
            }
        }
        float sc_[16], bi[16];
#pragma unroll
        for (int e = 0; e < 16; ++e) { lg[e] = wave_sum(lg[e]); sc_[e] = 1.f / (1.f + expf(-lg[e])); bi[e] = sc_[e] + p.router_b[e]; }
        float gs[4];
#pragma unroll
        for (int g = 0; g < 4; ++g) {
            const float a = bi[g * 4], b = bi[g * 4 + 1], c = bi[g * 4 + 2], d = bi[g * 4 + 3];
            const float m1 = fmaxf(fmaxf(a, b), fmaxf(c, d));
            const float m2 = fmaxf(fmaxf(fminf(a, b), fminf(c, d)), fminf(fmaxf(a, b), fmaxf(c, d)));
            gs[g] = m1 + m2;
        }
        int bg = 0; float bgs = gs[0];
#pragma unroll
        for (int g = 1; g < 4; ++g) if (gs[g] > bgs) { bgs = gs[g]; bg = g; }
        float v0 = 0.f, v1 = 0.f, v2 = 0.f, v3 = 0.f, s0 = 0.f, s1 = 0.f, s2 = 0.f, s3 = 0.f;
#pragma unroll
        for (int g = 0; g < 4; ++g) if (bg == g) { v0 = bi[g * 4]; v1 = bi[g * 4 + 1]; v2 = bi[g * 4 + 2]; v3 = bi[g * 4 + 3]; s0 = sc_[g * 4]; s1 = sc_[g * 4 + 1]; s2 = sc_[g * 4 + 2]; s3 = sc_[g * 4 + 3]; }
        int i1 = 0; float b1 = v0, w1 = s0;
        if (v1 > b1) { b1 = v1; i1 = 1; w1 = s1; }
        if (v2 > b1) { b1 = v2; i1 = 2; w1 = s2; }
        if (v3 > b1) { b1 = v3; i1 = 3; w1 = s3; }
        int i2 = -1; float b2 = -1e30f, w2 = 0.f;
        if (i1 != 0 && v0 > b2) { b2 = v0; i2 = 0; w2 = s0; }
        if (i1 != 1 && v1 > b2) { b2 = v1; i2 = 1; w2 = s1; }
        if (i1 != 2 && v2 > b2) { b2 = v2; i2 = 2; w2 = s2; }
        if (i1 != 3 && v3 > b2) { b2 = v3; i2 = 3; w2 = s3; }
        if (lane == 0) {
            const float inv = 1.f / (w1 + w2);
            const int e1 = bg * 4 + i1, e2 = bg * 4 + i2;
            p.tokw[2 * t] = w1 * inv; p.tokw[2 * t + 1] = w2 * inv;
            const int p1 = atomicAdd(&p.cnt[l * 16 + e1], 1); p.list[e1 * TT + p1] = 2 * t;
            const int p2 = atomicAdd(&p.cnt[l * 16 + e2], 1); p.list[e2 * TT + p2] = 2 * t + 1;
        }
    }
}

DEV bool moe_tile(const int* cnt, int tile, int& e, int& r0, int& nvalid, int& coff) {
    int off = 0, tacc = 0;
#pragma unroll 1
    for (int i = 0; i < NE; ++i) {
        const int c = cnt[i], nt = (c + 63) >> 6;
        if (tile < tacc + nt) { e = i; r0 = (tile - tacc) * 64; nvalid = min(64, c - r0); coff = off + r0; return true; }
        tacc += nt; off += c;
    }
    return false;
}

DEV void phase_moe_up(const P& p, int l, int bid, int nb, float* lds) {
    float* As = lds; float* Bs = lds + 16 * 68;
    const int tid = threadIdx.x, tx = tid & 15, ty = tid >> 4;
    const int maxw = (2 * TT / 64 + NE) * 8;
    for (int w = bid; w < maxw; w += nb) {
        const int tile = w >> 3, nt = w & 7, n0 = nt * 64;
        int e, r0, nvalid, coff;
        if (!moe_tile(p.cnt + l * 16, tile, e, r0, nvalid, coff)) break;
        const int ar = tid >> 2;
        const int arow = ar < nvalid ? (p.list[e * TT + r0 + ar] >> 1) : -1;
        const float* Wg = p.w_gate + ((size_t)(l * NE + e) * D) * DE + n0; const float* Wu = p.w_up + ((size_t)(l * NE + e) * D) * DE + n0;
        float ag[4][4], au[4][4];
        gemm64(ag, p.xn, D, arow, Wg, DE, D, As, Bs);
        gemm64(au, p.xn, D, arow, Wu, DE, D, As, Bs);
#pragma unroll
        for (int i = 0; i < 4; ++i) {
            const int r = ty * 4 + i;
            if (r < nvalid) {
                float h[4];
#pragma unroll
                for (int j = 0; j < 4; ++j) { const float g = ag[i][j]; h[j] = g * sigmoidf_(g) * au[i][j]; }
                *(uint2*)(p.hid + (size_t)(coff + r) * DE + n0 + tx * 4) = make_uint2(pack2(h[0], h[1]), pack2(h[2], h[3]));
            }
        }
    }
}

DEV void phase_moe_down(const P& p, int l, int bid, int nb, float* lds) {
    float* As = lds; float* Bs = lds + 16 * 68;
    const int tid = threadIdx.x, tx = tid & 15, ty = tid >> 4;
    const int maxw = (2 * TT / 64 + NE) * 16;
    for (int w = bid; w < maxw; w += nb) {
        const int tile = w >> 4, nt = w & 15, n0 = nt * 64;
        int e, r0, nvalid, coff;
        if (!moe_tile(p.cnt + l * 16, tile, e, r0, nvalid, coff)) break;
        const int ar = tid >> 2;
        const int arow = ar < nvalid ? coff + ar : -1;
        const float* Wd = p.w_down + ((size_t)(l * NE + e) * DE) * D + n0;
        float acc[4][4];
        gemm64(acc, p.hid, DE, arow, Wd, D, DE, As, Bs);
#pragma unroll
        for (int i = 0; i < 4; ++i) {
            const int r = ty * 4 + i;
            if (r < nvalid) {
                const int pair = p.list[e * TT + r0 + r]; const float wt = p.tokw[pair];
                *(uint2*)(p.y + (size_t)pair * D + n0 + tx * 4) = make_uint2(pack2(wt * acc[i][0], wt * acc[i][1]), pack2(wt * acc[i][2], wt * acc[i][3]));
            }
        }
    }
}

enum { PH_MOD, PH_ROWA0, PH_ROWA1, PH_FINAL, PH_GEMM_IN, PH_ATTN, PH_LRU_G, PH_LRU_S, PH_MIX, PH_GEMM_OUT, PH_ROUTE, PH_MOE_UP, PH_MOE_DOWN };
template <int PH>
__global__ void __launch_bounds__(256) k_phase(P p, int l) {
    __shared__ __attribute__((aligned(16))) float lds[9 * 1024];
    const int bid = blockIdx.x, nb = gridDim.x;
    if (PH == PH_MOD) phase_mod(p, bid, nb, lds);
    if (PH == PH_ROWA0) phase_rowA<0>(p, l, bid, nb);
    if (PH == PH_ROWA1) phase_rowA<1>(p, l, bid, nb);
    if (PH == PH_FINAL) phase_rowA<2>(p, l, bid, nb);
    if (PH == PH_GEMM_IN) phase_gemm_in(p, l, bid, nb, lds);
    if (PH == PH_ATTN) phase_attn(p, l, bid, nb);
    if (PH == PH_LRU_G) phase_lru_gates(p, l, bid, nb, lds);
    if (PH == PH_LRU_S) phase_lru_scan(p, l, bid, nb);
    if (PH == PH_MIX) phase_mix(p, l, bid, nb);
    if (PH == PH_GEMM_OUT) phase_gemm_out(p, l, bid, nb, lds);
    if (PH == PH_ROUTE) phase_route(p, l, bid, nb);
    if (PH == PH_MOE_UP) phase_moe_up(p, l, bid, nb, lds);
    if (PH == PH_MOE_DOWN) phase_moe_down(p, l, bid, nb, lds);
}

extern "C" void kernel_launch(void* const* d_in, const int* in_sizes, int n_in, void* d_out, int out_size, void* d_ws, size_t ws_size, hipStream_t stream) {
    P p{};
    const float* const* in = (const float* const*)d_in;
    p.x = in[0]; p.c = in[1]; p.ctx = in[2]; p.c_ctx = in[3]; p.ada_w = in[4]; p.ada_b = in[5]; p.norm1_g = in[6]; p.w_in = in[7]; p.q_norm_g = in[8]; p.k_norm_g = in[9];
    p.conv_w = in[10]; p.conv_b = in[11]; p.lru_wa = in[12]; p.lru_ba = in[13]; p.lru_wx = in[14]; p.lru_bx = in[15]; p.lru_lambda = in[16]; p.attn_out_g = in[17];
    p.lru_out_g = in[18]; p.w_out = in[19]; p.norm2_g = in[20]; p.router_w = in[21]; p.router_b = in[22]; p.w_gate = in[23]; p.w_up = in[24]; p.w_down = in[25]; p.final_g = in[26];
    p.out = (float*)d_out;
    char* ws = (char*)d_ws; size_t off = 0;
    auto carve = [&](size_t bytes) { void* r = ws + off; off += (bytes + 255) & ~(size_t)255; return r; };
    p.mod = (float*)carve((size_t)2 * 9 * 6144 * 4);
    p.rope = (float*)carve(2048 * 4);
    p.cnt = (int*)carve(32 * 4);
    p.tokw = (float*)carve((size_t)2 * TT * 4);
    p.list = (int*)carve((size_t)NE * TT * 4);
    p.xres = (float*)carve((size_t)TT * D * 4);
    p.xn = (bf16_t*)carve((size_t)TT * D * 2);
    p.lb = (float*)p.xn;
    p.hid = (bf16_t*)carve((size_t)2 * TT * DE * 2);
    p.la = (float*)p.hid;
    p.q = (bf16_t*)carve((size_t)TT * 512 * 2);
    p.y = p.q;
    p.k = (bf16_t*)carve((size_t)TT * 128 * 2);
    p.v = (bf16_t*)carve((size_t)TT * 128 * 2);
    p.u = (bf16_t*)carve((size_t)TT * 512 * 2);
    p.gb = (bf16_t*)carve((size_t)TT * 512 * 2);
    p.att = (bf16_t*)carve((size_t)TT * 512 * 2);
    p.hdir = (bf16_t*)carve((size_t)2 * TT * 512 * 2);
    if (off > ws_size) { fprintf(stderr, "workspace too small: need %zu have %zu\n", off, ws_size); return; }
    const int G = 2048;
    k_phase<PH_MOD><<<49, 256, 0, stream>>>(p, 0);
    for (int l = 0; l < 2; ++l) {
        if (l == 0) k_phase<PH_ROWA0><<<G, 256, 0, stream>>>(p, l); else k_phase<PH_ROWA1><<<G, 256, 0, stream>>>(p, l);
        k_phase<PH_GEMM_IN><<<G, 256, 0, stream>>>(p, l);
        k_phase<PH_ATTN><<<576, 256, 0, stream>>>(p, l);
        for (int d = 0; d < 2; ++d) {
            k_phase<PH_LRU_G><<<1152, 256, 0, stream>>>(p, l | (d << 4));
            k_phase<PH_LRU_S><<<16, 256, 0, stream>>>(p, l | (d << 4));
        }
        k_phase<PH_MIX><<<G, 256, 0, stream>>>(p, l);
        k_phase<PH_GEMM_OUT><<<G, 256, 0, stream>>>(p, l);
        k_phase<PH_ROUTE><<<G, 256, 0, stream>>>(p, l);
        k_phase<PH_MOE_UP><<<G, 256, 0, stream>>>(p, l);
        k_phase<PH_MOE_DOWN><<<G, 256, 0, stream>>>(p, l);
    }
    k_phase<PH_FINAL><<<G, 256, 0, stream>>>(p, 1);
}
```

```cpp
#include <hip/hip_runtime.h>
#include <stdint.h>
#include <cstdio>

#define DEV __device__ __forceinline__
typedef unsigned short bf16_t;

constexpr int D = 1024, NB = 8, S = 2048, CL = 256, TL = NB * S, TC = NB * CL, TT = TL + TC;
constexpr int INW = 1792, NE = 16, DE = 512;
constexpr float EPS = 1e-6f;

DEV float bf2f(bf16_t v) { return __uint_as_float(((unsigned)v) << 16); }
DEV bf16_t f2bf(float f) { unsigned u = __float_as_uint(f); u += 0x7fffu + ((u >> 16) & 1u); return (bf16_t)(u >> 16); }
DEV float bflo(unsigned w) { return __uint_as_float(w << 16); }
DEV float bfhi(unsigned w) { return __uint_as_float(w & 0xffff0000u); }
DEV unsigned pack2(float lo, float hi) { return (unsigned)f2bf(lo) | ((unsigned)f2bf(hi) << 16); }
DEV float wave_sum(float v) {
#pragma unroll
    for (int o = 32; o > 0; o >>= 1) v += __shfl_xor(v, o);
    return v;
}
DEV float sigmoidf_(float x) { return 1.f / (1.f + __expf(-x)); }
DEV float gelu_tanh(float x) {
    const float u = 0.7978845608028654f * (x + 0.044715f * x * x * x);
    const float e = __expf(2.f * u);
    const float th = 1.f - 2.f / (e + 1.f);
    return 0.5f * x * (1.f + th);
}
DEV int otid() { int t = threadIdx.x; asm volatile("" : "+v"(t)); return t; }
DEV int mod_row(int t) { return t < TL ? (t >> 11) : 8; }

struct P {
    const float *x, *c, *ctx, *c_ctx, *ada_w, *ada_b, *norm1_g, *w_in, *q_norm_g, *k_norm_g, *conv_w, *conv_b, *lru_wa, *lru_ba, *lru_wx, *lru_bx,
        *lru_lambda, *attn_out_g, *lru_out_g, *w_out, *norm2_g, *router_w, *router_b, *w_gate, *w_up, *w_down, *final_g;
    float* out;
    float *mod, *rope, *xres, *la, *lb, *tokw;
    bf16_t *xn, *q, *k, *v, *u, *gb, *att, *hdir, *hid, *y;
    int *cnt, *list;
    unsigned* bar;
};

DEV void phase_mod(const P& p, int bid, int nb, float* lds) {
    const int tid = otid();
    float* sil = lds;
    bool have = false;
    for (int w = bid; w < 49; w += nb) {
        if (w == 48) {
            for (int i = tid; i < 1024; i += 256) {
                const int pos = i >> 4, f = i & 15;
                const float inv = exp2f(-(float)(2 * f) / 32.f * 13.287712379549449f);
                const float ang = (float)pos * inv;
                p.rope[i] = __cosf(ang); p.rope[1024 + i] = __sinf(ang);
            }
            if (tid < 32) p.cnt[tid] = 0;
            continue;
        }
        if (!have) {
            for (int i = tid; i < 9 * 1024; i += 256) {
                const int r = i >> 10, d = i & 1023;
                const float v = r < 8 ? p.c[r * 1024 + d] : p.c_ctx[d];
                sil[i] = v * sigmoidf_(v);
            }
            __syncthreads(); have = true;
        }
        const int gid = w * 256 + tid, l = gid / 6144, col = gid % 6144;
        const float* wp = p.ada_w + (size_t)l * 1024 * 6144 + col;
        float acc[9];
#pragma unroll
        for (int r = 0; r < 9; ++r) acc[r] = 0.f;
        for (int k = 0; k < 1024; ++k) {
            const float wv = wp[(size_t)k * 6144];
#pragma unroll
            for (int r = 0; r < 9; ++r) acc[r] += sil[r * 1024 + k] * wv;
        }
        const float bb = p.ada_b[l * 6144 + col];
#pragma unroll
        for (int r = 0; r < 9; ++r) p.mod[(size_t)(l * 9 + r) * 6144 + col] = acc[r] + bb;
    }
}

template <int MODE>
DEV void phase_rowA(const P& p, int l, int bid, int nb) {
    const int tid = otid(), lane = tid & 63, wv = tid >> 6;
    const int nrows = (MODE == 2) ? TL : TT;
    for (int t = bid * 4 + wv; t < nrows; t += nb * 4) {
        const int mr = mod_row(t);
        float xv[16];
        if (MODE == 0) {
            const float* src = t < TL ? p.x + (size_t)t * D : p.ctx + (size_t)(t - TL) * D;
#pragma unroll
            for (int i = 0; i < 4; ++i) { const float4 v4 = *(const float4*)(src + i * 256 + lane * 4); xv[i * 4] = v4.x; xv[i * 4 + 1] = v4.y; xv[i * 4 + 2] = v4.z; xv[i * 4 + 3] = v4.w; }
        } else {
            const int lp = (MODE == 2) ? 1 : 0;
            const float* src = p.xres + (size_t)t * D;
            const float* g2 = p.mod + (size_t)(lp * 9 + mr) * 6144 + 5 * 1024;
            const bf16_t* y0 = p.y + (size_t)(2 * t) * D; const bf16_t* y1 = y0 + D;
#pragma unroll
            for (int i = 0; i < 4; ++i) {
                const int c0 = i * 256 + lane * 4;
                const float4 v4 = *(const float4*)(src + c0); const float4 g4 = *(const float4*)(g2 + c0);
                const uint2 a = *(const uint2*)(y0 + c0), b = *(const uint2*)(y1 + c0);
                xv[i * 4] = v4.x + g4.x * (bflo(a.x) + bflo(b.x)); xv[i * 4 + 1] = v4.y + g4.y * (bfhi(a.x) + bfhi(b.x));
                xv[i * 4 + 2] = v4.z + g4.z * (bflo(a.y) + bflo(b.y)); xv[i * 4 + 3] = v4.w + g4.w * (bfhi(a.y) + bfhi(b.y));
            }
            if (MODE == 1) {
#pragma unroll
                for (int i = 0; i < 4; ++i) *(float4*)(p.xres + (size_t)t * D + i * 256 + lane * 4) = make_float4(xv[i * 4], xv[i * 4 + 1], xv[i * 4 + 2], xv[i * 4 + 3]);
            }
        }
        float ss = 0.f;
#pragma unroll
        for (int i = 0; i < 16; ++i) ss += xv[i] * xv[i];
        ss = wave_sum(ss);
        const float rstd = rsqrtf(ss * (1.f / D) + EPS);
        if (MODE == 2) {
#pragma unroll
            for (int i = 0; i < 4; ++i) {
                const int c0 = i * 256 + lane * 4; const float4 g4 = *(const float4*)(p.final_g + c0);
                *(float4*)(p.out + (size_t)t * D + c0) = make_float4(xv[i * 4] * rstd * g4.x, xv[i * 4 + 1] * rstd * g4.y, xv[i * 4 + 2] * rstd * g4.z, xv[i * 4 + 3] * rstd * g4.w);
            }
        } else {
            const float* ng = p.norm1_g + l * D; const float* mm = p.mod + (size_t)(l * 9 + mr) * 6144;
#pragma unroll
            for (int i = 0; i < 4; ++i) {
                const int c0 = i * 256 + lane * 4;
                const float4 g4 = *(const float4*)(ng + c0), sh = *(const float4*)(mm + c0), sc = *(const float4*)(mm + 1024 + c0);
                const float o0 = xv[i * 4] * rstd * g4.x * (1.f + sc.x) + sh.x, o1 = xv[i * 4 + 1] * rstd * g4.y * (1.f + sc.y) + sh.y;
                const float o2 = xv[i * 4 + 2] * rstd * g4.z * (1.f + sc.z) + sh.z, o3 = xv[i * 4 + 3] * rstd * g4.w * (1.f + sc.w) + sh.w;
                *(uint2*)(p.xn + (size_t)t * D + c0) = make_uint2(pack2(o0, o1), pack2(o2, o3));
            }
        }
    }
}

DEV void gemm64(float (&acc)[4][4], const bf16_t* __restrict__ A, int lda, int arow_g, const float* __restrict__ W, int ldw, int K, float* As, float* Bs) {
    const int tid = otid(), tx = tid & 15, ty = tid >> 4;
    const int ar = tid >> 2, ak = (tid & 3) * 4;
    const int bk = tid >> 4, bc = (tid & 15) * 4;
#pragma unroll
    for (int i = 0; i < 4; ++i)
#pragma unroll
        for (int j = 0; j < 4; ++j) acc[i][j] = 0.f;
    for (int k0 = 0; k0 < K; k0 += 16) {
        float a0 = 0.f, a1 = 0.f, a2 = 0.f, a3 = 0.f;
        if (arow_g >= 0) { const uint2 raw = *(const uint2*)(A + (size_t)arow_g * lda + k0 + ak); a0 = bflo(raw.x); a1 = bfhi(raw.x); a2 = bflo(raw.y); a3 = bfhi(raw.y); }
        const float4 bv = *(const float4*)(W + (size_t)(k0 + bk) * ldw + bc);
        __syncthreads();
        As[(ak + 0) * 68 + ar] = a0; As[(ak + 1) * 68 + ar] = a1; As[(ak + 2) * 68 + ar] = a2; As[(ak + 3) * 68 + ar] = a3;
        *(float4*)&Bs[bk * 64 + bc] = bv;
        __syncthreads();
#pragma unroll
        for (int kk = 0; kk < 16; ++kk) {
            const float4 av = *(const float4*)&As[kk * 68 + ty * 4]; const float4 bb = *(const float4*)&Bs[kk * 64 + tx * 4];
            const float a_[4] = {av.x, av.y, av.z, av.w}, b_[4] = {bb.x, bb.y, bb.z, bb.w};
#pragma unroll
            for (int i = 0; i < 4; ++i)
#pragma unroll
                for (int j = 0; j < 4; ++j) acc[i][j] += a_[i] * b_[j];
        }
    }
    __syncthreads();
}

DEV void phase_gemm_in(const P& p, int l, int bid, int nb, float* lds) {
    float* As = lds; float* Bs = lds + 16 * 68; float* Ct = Bs + 16 * 64;
    const int tid = otid(), tx = tid & 15, ty = tid >> 4;
    const float* W = p.w_in + (size_t)l * D * INW;
    const int ntiles = (TT / 64) * 28;
    for (int w = bid; w < ntiles; w += nb) {
        const int mt = w / 28, nt = w % 28, m0 = mt * 64, n0 = nt * 64;
        if (l == 1 && m0 >= TL && (nt < 8 || nt >= 20)) continue;
        float acc[4][4];
        gemm64(acc, p.xn, D, m0 + (tid >> 2), W + n0, INW, D, As, Bs);
#pragma unroll
        for (int i = 0; i < 4; ++i)
#pragma unroll
            for (int j = 0; j < 4; ++j) Ct[(ty * 4 + i) * 65 + tx * 4 + j] = acc[i][j];
        __syncthreads();
        const int r = tid >> 2, sub = tid & 3, t = m0 + r;
        float vals[16];
#pragma unroll
        for (int j = 0; j < 16; ++j) vals[j] = Ct[r * 65 + sub * 16 + j];
        bf16_t* dst;
        if (nt < 10) {
            float ss = 0.f;
#pragma unroll
            for (int j = 0; j < 16; ++j) ss += vals[j] * vals[j];
            ss += __shfl_xor(ss, 1); ss += __shfl_xor(ss, 2);
            const float rstd = rsqrtf(ss * (1.f / 64.f) + EPS);
            const float* g = (nt < 8 ? p.q_norm_g : p.k_norm_g) + l * 64;
            const bool lat = t < TL;
            const int s = t & 2047, pos = (sub >> 1) ? (s & 63) : (s >> 6);
#pragma unroll
            for (int j = 0; j < 16; ++j) {
                const int d = sub * 16 + j, dp = d ^ 16;
                const float v = vals[j] * rstd * g[d];
                if (lat) {
                    const float pv = Ct[r * 65 + dp] * rstd * g[dp];
                    const float cs = p.rope[pos * 16 + j], sn = p.rope[1024 + pos * 16 + j];
                    vals[j] = (sub & 1) ? (v * cs + pv * sn) : (v * cs - pv * sn);
                } else vals[j] = v;
            }
            dst = nt < 8 ? p.q + (size_t)t * 512 + nt * 64 : p.k + (size_t)t * 128 + (nt - 8) * 64;
        } else if (nt < 12) dst = p.v + (size_t)t * 128 + (nt - 10) * 64;
        else if (nt < 20) dst = p.u + (size_t)t * 512 + (nt - 12) * 64;
        else dst = p.gb + (size_t)t * 512 + (nt - 20) * 64;
        uint4 o0, o1;
        o0.x = pack2(vals[0], vals[1]); o0.y = pack2(vals[2], vals[3]); o0.z = pack2(vals[4], vals[5]); o0.w = pack2(vals[6], vals[7]);
        o1.x = pack2(vals[8], vals[9]); o1.y = pack2(vals[10], vals[11]); o1.z = pack2(vals[12], vals[13]); o1.w = pack2(vals[14], vals[15]);
        *(uint4*)(dst + sub * 16) = o0; *(uint4*)(dst + sub * 16 + 8) = o1;
        __syncthreads();
    }
}

DEV void phase_attn(const P& p, int l, int bid, int nb) {
    const int tid = otid();
    const int nitems = (l == 0) ? 512 + 64 : 512;
    for (int w = bid; w < nitems; w += nb) {
        int b, h, qrow, nkeys;
        if (w < 512) { b = w >> 6; h = (w >> 3) & 7; qrow = b * S + (w & 7) * 256 + tid; nkeys = CL + S; }
        else { const int w2 = w - 512; b = w2 >> 3; h = w2 & 7; qrow = TL + b * CL + tid; nkeys = CL; }
        const int kvh = h >> 2;
        float qv[64], o[64];
        const bf16_t* qp = p.q + (size_t)qrow * 512 + h * 64;
#pragma unroll
        for (int i = 0; i < 8; ++i) {
            const uint4 r4 = *(const uint4*)(qp + i * 8);
            qv[i * 8] = bflo(r4.x) * 0.125f; qv[i * 8 + 1] = bfhi(r4.x) * 0.125f; qv[i * 8 + 2] = bflo(r4.y) * 0.125f; qv[i * 8 + 3] = bfhi(r4.y) * 0.125f;
            qv[i * 8 + 4] = bflo(r4.z) * 0.125f; qv[i * 8 + 5] = bfhi(r4.z) * 0.125f; qv[i * 8 + 6] = bflo(r4.w) * 0.125f; qv[i * 8 + 7] = bfhi(r4.w) * 0.125f;
        }
#pragma unroll
        for (int i = 0; i < 64; ++i) o[i] = 0.f;
        float mx = -1e30f, den = 0.f;
        for (int j = 0; j < nkeys; ++j) {
            const int krow = j < CL ? TL + b * CL + j : b * S + (j - CL);
            const bf16_t* kp = p.k + (size_t)krow * 128 + kvh * 64; const bf16_t* vp = p.v + (size_t)krow * 128 + kvh * 64;
            float sc = 0.f;
#pragma unroll
            for (int i = 0; i < 8; ++i) {
                const uint4 r4 = *(const uint4*)(kp + i * 8);
                sc += qv[i * 8] * bflo(r4.x) + qv[i * 8 + 1] * bfhi(r4.x) + qv[i * 8 + 2] * bflo(r4.y) + qv[i * 8 + 3] * bfhi(r4.y)
                    + qv[i * 8 + 4] * bflo(r4.z) + qv[i * 8 + 5] * bfhi(r4.z) + qv[i * 8 + 6] * bflo(r4.w) + qv[i * 8 + 7] * bfhi(r4.w);
            }
            const float mn = fmaxf(mx, sc), corr = __expf(mx - mn), pe = __expf(sc - mn);
            den = den * corr + pe; mx = mn;
#pragma unroll
            for (int i = 0; i < 8; ++i) {
                const uint4 r4 = *(const uint4*)(vp + i * 8);
                o[i * 8] = o[i * 8] * corr + pe * bflo(r4.x); o[i * 8 + 1] = o[i * 8 + 1] * corr + pe * bfhi(r4.x);
                o[i * 8 + 2] = o[i * 8 + 2] * corr + pe * bflo(r4.y); o[i * 8 + 3] = o[i * 8 + 3] * corr + pe * bfhi(r4.y);
                o[i * 8 + 4] = o[i * 8 + 4] * corr + pe * bflo(r4.z); o[i * 8 + 5] = o[i * 8 + 5] * corr + pe * bfhi(r4.z);
                o[i * 8 + 6] = o[i * 8 + 6] * corr + pe * bflo(r4.w); o[i * 8 + 7] = o[i * 8 + 7] * corr + pe * bfhi(r4.w);
            }
        }
        const float inv = 1.f / den;
        bf16_t* op = p.att + (size_t)qrow * 512 + h * 64;
#pragma unroll
        for (int i = 0; i < 8; ++i) {
            uint4 r4; r4.x = pack2(o[i * 8] * inv, o[i * 8 + 1] * inv); r4.y = pack2(o[i * 8 + 2] * inv, o[i * 8 + 3] * inv);
            r4.z = pack2(o[i * 8 + 4] * inv, o[i * 8 + 5] * inv); r4.w = pack2(o[i * 8 + 6] * inv, o[i * 8 + 7] * inv);
            *(uint4*)(op + i * 8) = r4;
        }
    }
}

DEV void phase_lru_gates(const P& p, int ld, int bid, int nb, float* lds) {
    float* uc = lds;
    const int tid = otid(), l = ld & 15, d = ld >> 4;
    const float* cw = p.conv_w + l * 4 * 512; const float* cb = p.conv_b + l * 512;
    for (int w = bid; w < TT / 16; w += nb) {
        const int t0 = w * 16;
        const int seq0 = t0 < TL ? (t0 & ~2047) : TL + ((t0 - TL) & ~255);
        const int seqlen = t0 < TL ? S : CL;
        __syncthreads();
        for (int i = tid; i < 16 * 512; i += 256) {
            const int tt = i >> 9, ch = i & 511, t = t0 + tt;
            float acc = cb[ch];
#pragma unroll
            for (int j = 0; j < 4; ++j) { const int ts = t - 2 + j; if (ts >= seq0 && ts < seq0 + seqlen) acc += bf2f(p.u[(size_t)ts * 512 + ch]) * cw[j * 512 + ch]; }
            uc[i] = acc;
        }
        __syncthreads();
        for (int pass = 0; pass < 2; ++pass) {
            const int e = pass * 256 + tid, n = e >> 6, ee = e & 63;
            const float* wa = p.lru_wa + ((size_t)((l * 2 + d) * 8 + n) * 64) * 64 + ee;
            const float* wx = p.lru_wx + ((size_t)((l * 2 + d) * 8 + n) * 64) * 64 + ee;
            float ra[16], ri[16];
#pragma unroll
            for (int tt = 0; tt < 16; ++tt) { ra[tt] = 0.f; ri[tt] = 0.f; }
            for (int dd = 0; dd < 64; ++dd) {
                const float wav = wa[dd * 64], wxv = wx[dd * 64];
#pragma unroll
                for (int tt = 0; tt < 16; ++tt) { const float uv = uc[tt * 512 + n * 64 + dd]; ra[tt] += uv * wav; ri[tt] += uv * wxv; }
            }
            const int pi = (l * 2 + d) * 512 + e;
            const float ba = p.lru_ba[pi], bx = p.lru_bx[pi], lam = p.lru_lambda[pi];
            const float sp = (-lam > 20.f) ? -lam : log1pf(__expf(-lam));
#pragma unroll
            for (int tt = 0; tt < 16; ++tt) {
                const float r = sigmoidf_(ra[tt] + ba), ig = sigmoidf_(ri[tt] + bx);
                const float log_a = -8.f * r * sp;
                const float a = __expf(log_a);
                const float bm = sqrtf(fmaxf(1.f - __expf(2.f * log_a), 0.f)) * (ig * uc[tt * 512 + e]);
                const size_t o = ((size_t)t0 + tt) * 512 + e;
                p.la[o] = a; p.lb[o] = bm;
            }
        }
    }
}

DEV void phase_lru_scan(const P& p, int ld, int bid, int nb) {
    const int d = ld >> 4, tid = otid();
    for (int w = bid; w < 16; w += nb) {
        const int b = w >> 1, ch = (w & 1) * 256 + tid;
        const float* la = p.la + ch; const float* lb = p.lb + ch;
        bf16_t* hd = p.hdir + (size_t)d * TT * 512 + ch;
        float h = 0.f;
        const int cbase = TL + b * CL, lbase = b * S;
        if (d == 0) {
#pragma unroll 8
            for (int i = 0; i < CL; ++i) { const size_t o = (size_t)(cbase + i) * 512; h = la[o] * h + lb[o]; hd[o] = f2bf(h); }
#pragma unroll 8
            for (int i = 0; i < S; ++i) { const size_t o = (size_t)(lbase + i) * 512; h = la[o] * h + lb[o]; hd[o] = f2bf(h); }
        } else {
#pragma unroll 8
            for (int i = CL - 1; i >= 0; --i) { const size_t o = (size_t)(cbase + i) * 512; h = la[o] * h + lb[o]; hd[o] = f2bf(h); }
#pragma unroll 8
            for (int i = S - 1; i >= 0; --i) { const size_t o = (size_t)(lbase + i) * 512; h = la[o] * h + lb[o]; hd[o] = f2bf(h); }
        }
    }
}

DEV void phase_mix(const P& p, int l, int bid, int nb) {
    const int tid = otid(), lane = tid & 63, wv = tid >> 6;
    const int nrows = l == 0 ? TT : TL;
    for (int t = bid * 4 + wv; t < nrows; t += nb * 4) {
        const int c0 = lane * 8;
        const uint4 a4 = *(const uint4*)(p.att + (size_t)t * 512 + c0);
        const uint4 f4 = *(const uint4*)(p.hdir + (size_t)t * 512 + c0), b4 = *(const uint4*)(p.hdir + ((size_t)TT + t) * 512 + c0), g4 = *(const uint4*)(p.gb + (size_t)t * 512 + c0);
        float av[8] = {bflo(a4.x), bfhi(a4.x), bflo(a4.y), bfhi(a4.y), bflo(a4.z), bfhi(a4.z), bflo(a4.w), bfhi(a4.w)};
        const float fv[8] = {bflo(f4.x), bfhi(f4.x), bflo(f4.y), bfhi(f4.y), bflo(f4.z), bfhi(f4.z), bflo(f4.w), bfhi(f4.w)};
        const float bv[8] = {bflo(b4.x), bfhi(b4.x), bflo(b4.y), bfhi(b4.y), bflo(b4.z), bfhi(b4.z), bflo(b4.w), bfhi(b4.w)};
        const float gv[8] = {bflo(g4.x), bfhi(g4.x), bflo(g4.y), bfhi(g4.y), bflo(g4.z), bfhi(g4.z), bflo(g4.w), bfhi(g4.w)};
        float rv[8]; float sa = 0.f, sr = 0.f;
#pragma unroll
        for (int i = 0; i < 8; ++i) { rv[i] = (fv[i] + bv[i]) * gelu_tanh(gv[i]); sa += av[i] * av[i]; sr += rv[i] * rv[i]; }
        sa = wave_sum(sa); sr = wave_sum(sr);
        const float ra = rsqrtf(sa * (1.f / 512.f) + EPS), rr = rsqrtf(sr * (1.f / 512.f) + EPS);
        const float* ga = p.attn_out_g + l * 512 + c0; const float* gr = p.lru_out_g + l * 512 + c0;
#pragma unroll
        for (int i = 0; i < 8; ++i) { av[i] = av[i] * ra * ga[i]; rv[i] = rv[i] * rr * gr[i]; }
        uint4 o; o.x = pack2(av[0], av[1]); o.y = pack2(av[2], av[3]); o.z = pack2(av[4], av[5]); o.w = pack2(av[6], av[7]);
        *(uint4*)(p.xn + (size_t)t * D + c0) = o;
        o.x = pack2(rv[0], rv[1]); o.y = pack2(rv[2], rv[3]); o.z = pack2(rv[4], rv[5]); o.w = pack2(rv[6], rv[7]);
        *(uint4*)(p.xn + (size_t)t * D + 512 + c0) = o;
    }
}

DEV void phase_gemm_out(const P& p, int l, int bid, int nb, float* lds) {
    float* As = lds; float* Bs = lds + 16 * 68;
    const int tid = otid(), tx = tid & 15, ty = tid >> 4;
    const float* W = p.w_out + (size_t)l * D * D;
    const int ntiles = ((l == 0 ? TT : TL) / 64) * 16;
    for (int w = bid; w < ntiles; w += nb) {
        const int mt = w >> 4, nt = w & 15, m0 = mt * 64, n0 = nt * 64;
        float acc[4][4];
        gemm64(acc, p.xn, D, m0 + (tid >> 2), W + n0, D, D, As, Bs);
#pragma unroll
        for (int i = 0; i < 4; ++i) {
            const int t = m0 + ty * 4 + i, mr = mod_row(t), c0 = n0 + tx * 4;
            const float* res = (l == 0) ? (t < TL ? p.x + (size_t)t * D : p.ctx + (size_t)(t - TL) * D) : p.xres + (size_t)t * D;
            const float4 r4 = *(const float4*)(res + c0); const float4 g4 = *(const float4*)(p.mod + (size_t)(l * 9 + mr) * 6144 + 2048 + c0);
            *(float4*)(p.xres + (size_t)t * D + c0) = make_float4(r4.x + g4.x * acc[i][0], r4.y + g4.y * acc[i][1], r4.z + g4.z * acc[i][2], r4.w + g4.w * acc[i][3]);
        }
    }
}

DEV void phase_route(const P& p, int l, int bid, int nb) {
    const int tid = otid(), lane = tid & 63, wv = tid >> 6;
    const int nrows = l == 0 ? TT : TL;
    for (int t = bid * 4 + wv; t < nrows; t += nb * 4) {
        const int mr = mod_row(t);
        const float* src = p.xres + (size_t)t * D;
        float xv[16];
#pragma unroll
        for (int i = 0; i < 4; ++i) { const float4 v4 = *(const float4*)(src + i * 256 + lane * 4); xv[i * 4] = v4.x; xv[i * 4 + 1] = v4.y; xv[i * 4 + 2] = v4.z; xv[i * 4 + 3] = v4.w; }
        float ss = 0.f;
#pragma unroll
        for (int i = 0; i < 16; ++i) ss += xv[i] * xv[i];
        ss = wave_sum(ss);
        const float rstd = rsqrtf(ss * (1.f / D) + EPS);
        const float* ng = p.norm2_g + l * D; const float* mm = p.mod + (size_t)(l * 9 + mr) * 6144;
        float lg[16];
#pragma unroll
        for (int e = 0; e < 16; ++e) lg[e] = 0.f;
#pragma unroll
        for (int i = 0; i < 4; ++i) {
            const int c0 = i * 256 + lane * 4;
            const float4 g4 = *(const float4*)(ng + c0), sh = *(const float4*)(mm + 3072 + c0), sc = *(const float4*)(mm + 4096 + c0);
            const float o0 = xv[i * 4] * rstd * g4.x * (1.f + sc.x) + sh.x, o1 = xv[i * 4 + 1] * rstd * g4.y * (1.f + sc.y) + sh.y;
            const float o2 = xv[i * 4 + 2] * rstd * g4.z * (1.f + sc.z) + sh.z, o3 = xv[i * 4 + 3] * rstd * g4.w * (1.f + sc.w) + sh.w;
            *(uint2*)(p.xn + (size_t)t * D + c0) = make_uint2(pack2(o0, o1), pack2(o2, o3));
            const float hv[4] = {o0, o1, o2, o3};
#pragma unroll
            for (int j = 0; j < 4; ++j) {
                const float4* rw = (const float4*)(p.router_w + (size_t)(c0 + j) * 16);
#pragma unroll
                for (int q4 = 0; q4 < 4; ++q4) { const float4 r4 = rw[q4]; lg[q4 * 4] += hv[j] * r4.x; lg[q4 * 4 + 1] += hv[j] * r4.y; lg[q4 * 4 + 2] += hv[j] * r4.z; lg[q4 * 4 + 3] += hv[j] * r4.w; }
            }
        }
        float sc_[16], bi[16];
#pragma unroll
        for (int e = 0; e < 16; ++e) { lg[e] = wave_sum(lg[e]); sc_[e] = 1.f / (1.f + expf(-lg[e])); bi[e] = sc_[e] + p.router_b[e]; }
        float gs[4];
#pragma unroll
        for (int g = 0; g < 4; ++g) {
            const float a = bi[g * 4], b = bi[g * 4 + 1], c = bi[g * 4 + 2], d = bi[g * 4 + 3];
            const float m1 = fmaxf(fmaxf(a, b), fmaxf(c, d));
            const float m2 = fmaxf(fmaxf(fminf(a, b), fminf(c, d)), fminf(fmaxf(a, b), fmaxf(c, d)));
            gs[g] = m1 + m2;
        }
        int bg = 0; float bgs = gs[0];
#pragma unroll
        for (int g = 1; g < 4; ++g) if (gs[g] > bgs) { bgs = gs[g]; bg = g; }
        float v0 = 0.f, v1 = 0.f, v2 = 0.f, v3 = 0.f, s0 = 0.f, s1 = 0.f, s2 = 0.f, s3 = 0.f;
#pragma unroll
        for (int g = 0; g < 4; ++g) if (bg == g) { v0 = bi[g * 4]; v1 = bi[g * 4 + 1]; v2 = bi[g * 4 + 2]; v3 = bi[g * 4 + 3]; s0 = sc_[g * 4]; s1 = sc_[g * 4 + 1]; s2 = sc_[g * 4 + 2]; s3 = sc_[g * 4 + 3]; }
        int i1 = 0; float b1 = v0, w1 = s0;
        if (v1 > b1) { b1 = v1; i1 = 1; w1 = s1; }
        if (v2 > b1) { b1 = v2; i1 = 2; w1 = s2; }
        if (v3 > b1) { b1 = v3; i1 = 3; w1 = s3; }
        int i2 = -1; float b2 = -1e30f, w2 = 0.f;
        if (i1 != 0 && v0 > b2) { b2 = v0; i2 = 0; w2 = s0; }
        if (i1 != 1 && v1 > b2) { b2 = v1; i2 = 1; w2 = s1; }
        if (i1 != 2 && v2 > b2) { b2 = v2; i2 = 2; w2 = s2; }
        if (i1 != 3 && v3 > b2) { b2 = v3; i2 = 3; w2 = s3; }
        if (lane == 0) {
            const float inv = 1.f / (w1 + w2);
            const int e1 = bg * 4 + i1, e2 = bg * 4 + i2;
            p.tokw[2 * t] = w1 * inv; p.tokw[2 * t + 1] = w2 * inv;
            const int p1 = atomicAdd(&p.cnt[l * 16 + e1], 1); p.list[e1 * TT + p1] = 2 * t;
            const int p2 = atomicAdd(&p.cnt[l * 16 + e2], 1); p.list[e2 * TT + p2] = 2 * t + 1;
        }
    }
}

DEV bool moe_tile(const int* cnt, int tile, int& e, int& r0, int& nvalid, int& coff) {
    int off = 0, tacc = 0;
#pragma unroll 1
    for (int i = 0; i < NE; ++i) {
        const int c = cnt[i], nt = (c + 63) >> 6;
        if (tile < tacc + nt) { e = i; r0 = (tile - tacc) * 64; nvalid = min(64, c - r0); coff = off + r0; return true; }
        tacc += nt; off += c;
    }
    return false;
}

DEV void phase_moe_up(const P& p, int l, int bid, int nb, float* lds) {
    float* As = lds; float* Bs = lds + 16 * 68;
    const int tid = otid(), tx = tid & 15, ty = tid >> 4;
    const int maxw = (2 * TT / 64 + NE) * 8;
    for (int w = bid; w < maxw; w += nb) {
        const int tile = w >> 3, nt = w & 7, n0 = nt * 64;
        int e, r0, nvalid, coff;
        if (!moe_tile(p.cnt + l * 16, tile, e, r0, nvalid, coff)) break;
        const int ar = tid >> 2;
        const int arow = ar < nvalid ? (p.list[e * TT + r0 + ar] >> 1) : -1;
        const float* Wg = p.w_gate + ((size_t)(l * NE + e) * D) * DE + n0; const float* Wu = p.w_up + ((size_t)(l * NE + e) * D) * DE + n0;
        float ag[4][4], au[4][4];
        gemm64(ag, p.xn, D, arow, Wg, DE, D, As, Bs);
        gemm64(au, p.xn, D, arow, Wu, DE, D, As, Bs);
#pragma unroll
        for (int i = 0; i < 4; ++i) {
            const int r = ty * 4 + i;
            if (r < nvalid) {
                float h[4];
#pragma unroll
                for (int j = 0; j < 4; ++j) { const float g = ag[i][j]; h[j] = g * sigmoidf_(g) * au[i][j]; }
                *(uint2*)(p.hid + (size_t)(coff + r) * DE + n0 + tx * 4) = make_uint2(pack2(h[0], h[1]), pack2(h[2], h[3]));
            }
        }
    }
}

DEV void phase_moe_down(const P& p, int l, int bid, int nb, float* lds) {
    float* As = lds; float* Bs = lds + 16 * 68;
    const int tid = otid(), tx = tid & 15, ty = tid >> 4;
    const int maxw = (2 * TT / 64 + NE) * 16;
    for (int w = bid; w < maxw; w += nb) {
        const int tile = w >> 4, nt = w & 15, n0 = nt * 64;
        int e, r0, nvalid, coff;
        if (!moe_tile(p.cnt + l * 16, tile, e, r0, nvalid, coff)) break;
        const int ar = tid >> 2;
        const int arow = ar < nvalid ? coff + ar : -1;
        const float* Wd = p.w_down + ((size_t)(l * NE + e) * DE) * D + n0;
        float acc[4][4];
        gemm64(acc, p.hid, DE, arow, Wd, D, DE, As, Bs);
#pragma unroll
        for (int i = 0; i < 4; ++i) {
            const int r = ty * 4 + i;
            if (r < nvalid) {
                const int pair = p.list[e * TT + r0 + r]; const float wt = p.tokw[pair];
                *(uint2*)(p.y + (size_t)pair * D + n0 + tx * 4) = make_uint2(pack2(wt * acc[i][0], wt * acc[i][1]), pack2(wt * acc[i][2], wt * acc[i][3]));
            }
        }
    }
}


#define XB_TMO      128
#define XB_XCNT(j)  (256  + 64 * (j))
#define XB_XSUB(j)  (1280 + 64 * (j))
#define XB_XGEN(j)  (2304 + 64 * (j))
#define XB_TOP      3328
#define XB_TOPGEN   3392
#define XCD_BAR_WORDS 3456
#define XB_SPIN_CAP (1u << 20)
#define LAS __attribute__((address_space(3)))
DEV unsigned xb_ld(unsigned* p) { return __hip_atomic_load(p, __ATOMIC_RELAXED, __HIP_MEMORY_SCOPE_AGENT); }
DEV unsigned xb_add(unsigned* p, unsigned v) { return __hip_atomic_fetch_add(p, v, __ATOMIC_RELAXED, __HIP_MEMORY_SCOPE_AGENT); }
DEV unsigned xb_xcc_id() { return (unsigned)__builtin_amdgcn_s_getreg((3 << 11) | 20) & 0xFu; }
#define XB_SPIN(cond, bar) do { unsigned _sp = 0; while (cond) { __builtin_amdgcn_s_sleep(1); \
    if ((++_sp & 255u) == 0u) { if (xb_ld(&(bar)[XB_TMO])) break; if (_sp > XB_SPIN_CAP) { atomicAdd(&(bar)[XB_TMO], 1u); break; } } } } while (0)
struct XcdBarrier { unsigned* bar; unsigned x; volatile LAS unsigned* st; };
DEV XcdBarrier xcd_barrier_post(unsigned* bar, volatile LAS unsigned* st) {
    XcdBarrier b; b.bar = bar; b.x = xb_xcc_id(); b.st = st;
    if (threadIdx.x == 0) (void)xb_add(&bar[XB_XCNT(b.x)], 1u);
    return b;
}
DEV void xcd_barrier_complete(unsigned* bar, unsigned x, unsigned& nloc, unsigned& nx) {
    const unsigned G = gridDim.x * gridDim.y * gridDim.z;
    unsigned sum, cnt, mine, sp = 0u;
    for (;;) {
        sum = 0u; cnt = 0u; mine = 0u;
#pragma unroll
        for (unsigned j = 0; j < 16; ++j) { const unsigned c = xb_ld(&bar[XB_XCNT(j)]); sum += c; cnt += (c > 0u) ? 1u : 0u; mine = (j == x) ? c : mine; }
        if (sum == G) break;
        __builtin_amdgcn_s_sleep(1);
        if ((++sp & 255u) == 0u) { if (xb_ld(&bar[XB_TMO])) break; if (sp > XB_SPIN_CAP) { atomicAdd(&bar[XB_TMO], 1u); break; } }
    }
    nloc = mine > 0u ? mine : 1u; nx = cnt > 0u ? cnt : 1u;
}
DEV void xcd_barrier(const XcdBarrier& b) {
    asm volatile("s_waitcnt vmcnt(0)" ::: "memory");
    __syncthreads();
    if (threadIdx.x == 0) {
        unsigned* bar = b.bar;
        __builtin_amdgcn_s_waitcnt(0);
        unsigned nloc = b.st[0], nx = b.st[1];
        if (nloc == 0u) { xcd_barrier_complete(bar, b.x, nloc, nx); b.st[0] = nloc; b.st[1] = nx; }
        const unsigned old = xb_add(&bar[XB_XSUB(b.x)], 1u);
        const unsigned gen = old / nloc;
        if (old + 1u == (gen + 1u) * nloc) {
            __builtin_amdgcn_fence(__ATOMIC_RELEASE, "agent");
            asm volatile("s_waitcnt vmcnt(0)" ::: "memory");
            const unsigned og = xb_add(&bar[XB_TOP], 1u);
            const unsigned tg = og / nx;
            if (og + 1u == (tg + 1u) * nx) xb_add(&bar[XB_TOPGEN], 1u);
            else XB_SPIN(xb_ld(&bar[XB_TOPGEN]) == tg, bar);
            __builtin_amdgcn_fence(__ATOMIC_ACQUIRE, "agent");
            xb_add(&bar[XB_XGEN(b.x)], 1u);
            asm volatile("s_waitcnt vmcnt(0)" ::: "memory");
        } else {
            XB_SPIN(xb_ld(&bar[XB_XGEN(b.x)]) == gen, bar);
            __builtin_amdgcn_fence(__ATOMIC_ACQUIRE, "agent");
            asm volatile("s_waitcnt vmcnt(0)" ::: "memory");
        }
    }
    __syncthreads();
}

__global__ void __launch_bounds__(256, 2) fwd_megakernel(P p) {
    __shared__ __attribute__((aligned(16))) float lds_all[4 + 9 * 1024];
    float* lds = lds_all + 4;
    if (threadIdx.x < 4) lds_all[threadIdx.x] = 0.f;
    __syncthreads();
    XcdBarrier gb = xcd_barrier_post(p.bar, (volatile LAS unsigned*)lds_all);
    const int bid = blockIdx.x, nb = gridDim.x;
    phase_mod(p, bid, nb, lds);
    xcd_barrier(gb);
    for (int l = 0; l < 2; ++l) {
        if (l == 0) phase_rowA<0>(p, l, bid, nb); else phase_rowA<1>(p, l, bid, nb);
        xcd_barrier(gb);
        phase_gemm_in(p, l, bid, nb, lds);
        xcd_barrier(gb);
        phase_attn(p, l, bid, nb);
        for (int d = 0; d < 2; ++d) {
            phase_lru_gates(p, l | (d << 4), bid, nb, lds);
            xcd_barrier(gb);
            phase_lru_scan(p, l | (d << 4), bid, nb);
            xcd_barrier(gb);
        }
        phase_mix(p, l, bid, nb);
        xcd_barrier(gb);
        phase_gemm_out(p, l, bid, nb, lds);
        xcd_barrier(gb);
        phase_route(p, l, bid, nb);
        xcd_barrier(gb);
        phase_moe_up(p, l, bid, nb, lds);
        xcd_barrier(gb);
        phase_moe_down(p, l, bid, nb, lds);
        xcd_barrier(gb);
    }
    phase_rowA<2>(p, 1, bid, nb);
}

extern "C" void kernel_launch(void* const* d_in, const int* in_sizes, int n_in, void* d_out, int out_size, void* d_ws, size_t ws_size, hipStream_t stream) {
    P p{};
    const float* const* in = (const float* const*)d_in;
    p.x = in[0]; p.c = in[1]; p.ctx = in[2]; p.c_ctx = in[3]; p.ada_w = in[4]; p.ada_b = in[5]; p.norm1_g = in[6]; p.w_in = in[7]; p.q_norm_g = in[8]; p.k_norm_g = in[9];
    p.conv_w = in[10]; p.conv_b = in[11]; p.lru_wa = in[12]; p.lru_ba = in[13]; p.lru_wx = in[14]; p.lru_bx = in[15]; p.lru_lambda = in[16]; p.attn_out_g = in[17];
    p.lru_out_g = in[18]; p.w_out = in[19]; p.norm2_g = in[20]; p.router_w = in[21]; p.router_b = in[22]; p.w_gate = in[23]; p.w_up = in[24]; p.w_down = in[25]; p.final_g = in[26];
    p.out = (float*)d_out;
    char* ws = (char*)d_ws; size_t off = 0;
    auto carve = [&](size_t bytes) { void* r = ws + off; off += (bytes + 255) & ~(size_t)255; return r; };
    p.bar = (unsigned*)carve(XCD_BAR_WORDS * 4);
    p.mod = (float*)carve((size_t)2 * 9 * 6144 * 4);
    p.rope = (float*)carve(2048 * 4);
    p.cnt = (int*)carve(32 * 4);
    p.tokw = (float*)carve((size_t)2 * TT * 4);
    p.list = (int*)carve((size_t)NE * TT * 4);
    p.xres = (float*)carve((size_t)TT * D * 4);
    p.xn = (bf16_t*)carve((size_t)TT * D * 2);
    p.lb = (float*)p.xn;
    p.hid = (bf16_t*)carve((size_t)2 * TT * DE * 2);
    p.la = (float*)p.hid;
    p.q = (bf16_t*)carve((size_t)TT * 512 * 2);
    p.y = p.q;
    p.k = (bf16_t*)carve((size_t)TT * 128 * 2);
    p.v = (bf16_t*)carve((size_t)TT * 128 * 2);
    p.u = (bf16_t*)carve((size_t)TT * 512 * 2);
    p.gb = (bf16_t*)carve((size_t)TT * 512 * 2);
    p.att = (bf16_t*)carve((size_t)TT * 512 * 2);
    p.hdir = (bf16_t*)carve((size_t)2 * TT * 512 * 2);
    if (off > ws_size) { fprintf(stderr, "workspace too small: need %zu have %zu\n", off, ws_size); return; }
    static int grid_blocks = 0;
    if (!grid_blocks) {
        int dev = 0, cus = 0, per_cu = 0;
        hipGetDevice(&dev);
        hipDeviceGetAttribute(&cus, hipDeviceAttributeMultiprocessorCount, dev);
        hipOccupancyMaxActiveBlocksPerMultiprocessor(&per_cu, fwd_megakernel, 256, 0);
        if (per_cu > 2) per_cu = 2;
        if (per_cu < 1) per_cu = 1;
        grid_blocks = cus * per_cu;
    }
    hipMemsetAsync(p.bar, 0, XCD_BAR_WORDS * 4, stream);
    void* args[] = {&p};
    hipError_t e = hipLaunchCooperativeKernel((void*)fwd_megakernel, dim3(grid_blocks), dim3(256), args, 0, stream);
    if (e != hipSuccess) fprintf(stderr, "cooperative launch failed: %s (grid %d)\n", hipGetErrorString(e), grid_blocks);
}
```

```cpp
#include <hip/hip_runtime.h>
#include <stdint.h>
#include <cstdio>

#define DEV __device__ __forceinline__
#define LAS __attribute__((address_space(3)))
typedef unsigned short bf16_t;
typedef short bf16x8 __attribute__((ext_vector_type(8)));
typedef float f32x4 __attribute__((ext_vector_type(4)));
typedef unsigned u32x4 __attribute__((ext_vector_type(4)));
typedef unsigned u32x2 __attribute__((ext_vector_type(2)));
typedef int i32x2 __attribute__((ext_vector_type(2)));

constexpr int D = 1024, NB = 8, S = 2048, CL = 256, TL = NB * S, TC = NB * CL, TT = TL + TC, KVS = CL + S;
constexpr int INW = 1792, NE = 16, DE = 512;
constexpr float EPS = 1e-6f;
constexpr int NTHR = 512;
constexpr int RING_BYTES = 131072, MISC_OFF = RING_BYTES, LDS_BYTES = 147456;
constexpr int MAXPANELS = 2 * TT / 256 + NE;
constexpr int MISC_ROPE = 64, MISC_PTAB = 64 + 8192;

DEV float bf2f(bf16_t v) { return __uint_as_float(((unsigned)v) << 16); }
DEV unsigned f2bf(float f) { unsigned u = __float_as_uint(f); return (u + 0x7fffu + ((u >> 16) & 1u)) >> 16; }
DEV float bflo(unsigned w) { return __uint_as_float(w << 16); }
DEV float bfhi(unsigned w) { return __uint_as_float(w & 0xffff0000u); }
DEV unsigned pack2(float lo, float hi) { return f2bf(lo) | (f2bf(hi) << 16); }
DEV float wave_sum(float v) {
#pragma unroll
    for (int o = 32; o > 0; o >>= 1) v += __shfl_xor(v, o);
    return v;
}
DEV float sigmoidf_(float x) { return 1.f / (1.f + __expf(-x)); }
DEV float gelu_tanh(float x) {
    const float u = 0.7978845608028654f * (x + 0.044715f * x * x * x);
    const float e = __expf(2.f * u);
    const float th = 1.f - 2.f / (e + 1.f);
    return 0.5f * x * (1.f + th);
}
DEV int otid() { int t = threadIdx.x; asm volatile("" : "+v"(t)); return t; }
DEV int mod_row(int t) { return t < TL ? (t >> 11) : 8; }
DEV int kv_row(int t) { return t < TL ? (t >> 11) * KVS + CL + (t & 2047) : ((t - TL) >> 8) * KVS + ((t - TL) & 255); }

struct P {
    const float *x, *c, *ctx, *c_ctx, *ada_w, *ada_b, *norm1_g, *w_in, *q_norm_g, *k_norm_g, *conv_w, *conv_b, *lru_wa, *lru_ba, *lru_wx, *lru_bx,
        *lru_lambda, *attn_out_g, *lru_out_g, *w_out, *norm2_g, *router_w, *router_b, *w_gate, *w_up, *w_down, *final_g;
    float* out;
    float *mod, *xres, *la, *lb, *tokw;
    bf16_t *xn, *q, *k, *v, *u, *gb, *hdir, *hid, *y;
    bf16_t *wt_in, *wt_out, *wt_gu, *wt_d;
    int *cnt, *list;
    unsigned* bar;
};

#define XB_TMO      128
#define XB_XCNT(j)  (256  + 64 * (j))
#define XB_XSUB(j)  (1280 + 64 * (j))
#define XB_XGEN(j)  (2304 + 64 * (j))
#define XB_TOP      3328
#define XB_TOPGEN   3392
#define XCD_BAR_WORDS 3456
#define XB_SPIN_CAP (1u << 20)
DEV unsigned xb_ld(unsigned* p) { return __hip_atomic_load(p, __ATOMIC_RELAXED, __HIP_MEMORY_SCOPE_AGENT); }
DEV unsigned xb_add(unsigned* p, unsigned v) { return __hip_atomic_fetch_add(p, v, __ATOMIC_RELAXED, __HIP_MEMORY_SCOPE_AGENT); }
DEV unsigned xb_xcc_id() { return (unsigned)__builtin_amdgcn_s_getreg((3 << 11) | 20) & 0xFu; }
#define XB_SPIN(cond, bar) do { unsigned _sp = 0; while (cond) { __builtin_amdgcn_s_sleep(1); \
    if ((++_sp & 255u) == 0u) { if (xb_ld(&(bar)[XB_TMO])) break; if (_sp > XB_SPIN_CAP) { atomicAdd(&(bar)[XB_TMO], 1u); break; } } } } while (0)
struct XcdBarrier { unsigned* bar; unsigned x; volatile LAS unsigned* st; };
DEV XcdBarrier xcd_barrier_post(unsigned* bar, volatile LAS unsigned* st) {
    XcdBarrier b; b.bar = bar; b.x = xb_xcc_id(); b.st = st;
    if (threadIdx.x == 0) (void)xb_add(&bar[XB_XCNT(b.x)], 1u);
    return b;
}
DEV void xcd_barrier_complete(unsigned* bar, unsigned x, unsigned& nloc, unsigned& nx) {
    const unsigned G = gridDim.x * gridDim.y * gridDim.z;
    unsigned sum, cnt, mine, sp = 0u;
    for (;;) {
        sum = 0u; cnt = 0u; mine = 0u;
#pragma unroll
        for (unsigned j = 0; j < 16; ++j) { const unsigned c = xb_ld(&bar[XB_XCNT(j)]); sum += c; cnt += (c > 0u) ? 1u : 0u; mine = (j == x) ? c : mine; }
        if (sum == G) break;
        __builtin_amdgcn_s_sleep(1);
        if ((++sp & 255u) == 0u) { if (xb_ld(&bar[XB_TMO])) break; if (sp > XB_SPIN_CAP) { atomicAdd(&bar[XB_TMO], 1u); break; } }
    }
    nloc = mine > 0u ? mine : 1u; nx = cnt > 0u ? cnt : 1u;
}
DEV void xcd_barrier(const XcdBarrier& b) {
    asm volatile("s_waitcnt vmcnt(0)" ::: "memory");
    __syncthreads();
    if (threadIdx.x == 0) {
        unsigned* bar = b.bar;
        __builtin_amdgcn_s_waitcnt(0);
        unsigned nloc = b.st[0], nx = b.st[1];
        if (nloc == 0u) { xcd_barrier_complete(bar, b.x, nloc, nx); b.st[0] = nloc; b.st[1] = nx; }
        const unsigned old = xb_add(&bar[XB_XSUB(b.x)], 1u);
        const unsigned gen = old / nloc;
        if (old + 1u == (gen + 1u) * nloc) {
            __builtin_amdgcn_fence(__ATOMIC_RELEASE, "agent");
            asm volatile("s_waitcnt vmcnt(0)" ::: "memory");
            const unsigned og = xb_add(&bar[XB_TOP], 1u);
            const unsigned tg = og / nx;
            if (og + 1u == (tg + 1u) * nx) xb_add(&bar[XB_TOPGEN], 1u);
            else XB_SPIN(xb_ld(&bar[XB_TOPGEN]) == tg, bar);
            __builtin_amdgcn_fence(__ATOMIC_ACQUIRE, "agent");
            xb_add(&bar[XB_XGEN(b.x)], 1u);
            asm volatile("s_waitcnt vmcnt(0)" ::: "memory");
        } else {
            XB_SPIN(xb_ld(&bar[XB_XGEN(b.x)]) == gen, bar);
            __builtin_amdgcn_fence(__ATOMIC_ACQUIRE, "agent");
            asm volatile("s_waitcnt vmcnt(0)" ::: "memory");
        }
    }
    __syncthreads();
}

namespace pg8 {
constexpr int BM = 256, BK = 64, HALF = 128, HTB = HALF * BK * 2, STAGE_BYTES = 8 * HTB;
DEV int lds_byte(int r, int c) { const int st = (r >> 4) * 2 + (c >> 5), rr = r & 15, cc = c & 31, ob = rr * 64 + cc * 2; return st * 1024 + (ob ^ (((ob >> 9) & 1) << 5)); }
DEV void stage_rc(int b, int& R, int& C) { const int st = b / 1024, sb = b % 1024, swz = sb ^ (((sb >> 9) & 1) << 5); R = (st >> 1) * 16 + swz / 64; C = (st & 1) * 32 + (swz % 64) / 2; }
DEV int perm32(int rho) { const int n = rho >> 4, i = rho & 15; return 8 * (i >> 2) + 4 * n + (i & 3); }
struct Unit { int pm, pn; };

template <class Epi, class G, class Sched, bool ALIGN_EPI>
DEV void gemm_phase(LAS unsigned char* lds, const G& g, const Sched& S, const Epi& E, const int tid) {
    const int wid = __builtin_amdgcn_readfirstlane(tid >> 6), lane = tid & 63, wr = wid >> 2, wc = wid & 3, fr = lane & 15, fq = lane >> 4;
    const int K = g.K, nt = K / BK;
    int sR[2], sC[2]; unsigned voffB[2];
#pragma unroll
    for (int i = 0; i < 2; ++i) { stage_rc(tid * 16 + i * 8192, sR[i], sC[i]); const int Rb = Epi::PERM ? ((sR[i] & ~31) + perm32(sR[i] & 31)) : sR[i];
        voffB[i] = (unsigned)(Rb * K + sC[i]) * 2u; }
    const size_t kstep = (size_t)(BK * 2);
    const size_t hstep = (size_t)HALF * K * 2;
    const unsigned ldsw = (unsigned)wid * 1024u;
    const int aoff = lds_byte(wr * 64 + fr, fq * 8), boff = lds_byte(wc * 32 + fr, fq * 8);
#define PG8_SA(b, h) (((b) * 2 + (h)) * HTB)
#define PG8_SB(b, h) ((4 + (b) * 2 + (h)) * HTB)
#define PG8_STAGE(bufoff, gbase, voff) do { _Pragma("unroll") for (int _i = 0; _i < 2; ++_i) \
        __builtin_amdgcn_global_load_lds((const unsigned*)((const char*)(gbase) + (voff)[_i]), (LAS unsigned*)(lds + (bufoff) + ldsw + _i * 8192), 16, 0, 0); } while (0)
#define PG8_LDA(dst, b, h) do { _Pragma("unroll") for (int m = 0; m < 4; ++m) _Pragma("unroll") for (int k = 0; k < 2; ++k) dst[m][k] = *(const LAS bf16x8*)(lds + PG8_SA(b, h) + aoff + m * 2048 + k * 1024); } while (0)
#define PG8_LDB(dst, b, h) do { _Pragma("unroll") for (int n = 0; n < 2; ++n) _Pragma("unroll") for (int k = 0; k < 2; ++k) dst[n][k] = *(const LAS bf16x8*)(lds + PG8_SB(b, h) + boff + n * 2048 + k * 1024); } while (0)
#define PG8_MMA(ai, bj, At, Bt) do { __builtin_amdgcn_s_setprio(1); _Pragma("unroll") for (int m = 0; m < 4; ++m) _Pragma("unroll") for (int n = 0; n < 2; ++n) _Pragma("unroll") for (int k = 0; k < 2; ++k) \
        acc[ai][bj][m][n] = __builtin_amdgcn_mfma_f32_16x16x32_bf16(Bt[n][k], At[m][k], acc[ai][bj][m][n], 0, 0, 0); __builtin_amdgcn_s_setprio(0); } while (0)
#define PG8_WAIT_V(n) asm volatile("s_waitcnt vmcnt(" #n ")" ::: "memory")
#define PG8_WAIT_L(n) asm volatile("s_waitcnt lgkmcnt(" #n ")" ::: "memory")
#define PG8_BAR __builtin_amdgcn_s_barrier()
#define PG8_SCHED __builtin_amdgcn_sched_barrier(0)
    Unit cur, nxt; int ui = 0;
    if (!S.next(0, cur)) return;
    f32x4 acc[2][2][4][2];
#pragma unroll
    for (int a = 0; a < 2; ++a)
#pragma unroll
        for (int b = 0; b < 2; ++b)
#pragma unroll
            for (int m = 0; m < 4; ++m)
#pragma unroll
                for (int n = 0; n < 2; ++n) acc[a][b][m][n] = (f32x4){0.f, 0.f, 0.f, 0.f};
    bf16x8 At[4][2], B0[2][2], B1[2][2];
    unsigned oc[2][2], on[2][2];
#pragma unroll
    for (int h = 0; h < 2; ++h)
#pragma unroll
        for (int i = 0; i < 2; ++i) oc[h][i] = g.a_off(cur, h, sR[i], sC[i]);
    const char* cA = g.a_base(cur); const char* cB = g.b_base(cur);
    PG8_STAGE(PG8_SB(0, 0), cB, voffB); PG8_STAGE(PG8_SB(0, 1), cB + hstep, voffB); PG8_STAGE(PG8_SA(0, 0), cA, oc[0]); PG8_STAGE(PG8_SA(0, 1), cA, oc[1]);
    if (wr == 1) PG8_BAR;
    PG8_WAIT_V(2); PG8_BAR;
    PG8_STAGE(PG8_SB(1, 0), cB + kstep, voffB); PG8_STAGE(PG8_SA(1, 0), cA + kstep, oc[0]); PG8_STAGE(PG8_SB(1, 1), cB + hstep + kstep, voffB);
    PG8_WAIT_V(6); PG8_BAR;
    for (;;) {
        const bool has_next = S.next(ui + 1, nxt);
#pragma unroll
        for (int h = 0; h < 2; ++h)
#pragma unroll
            for (int i = 0; i < 2; ++i) on[h][i] = has_next ? g.a_off(nxt, h, sR[i], sC[i]) : oc[h][i];
        const char* nA = has_next ? g.a_base(nxt) : cA; const char* nB = has_next ? g.b_base(nxt) : cB;
        for (int t = 0; t < nt; t += 2) {
            const bool last = (t == nt - 2);
            const char* a1 = cA + (size_t)(t + 1) * kstep;
            const char* a2 = last ? nA : cA + (size_t)(t + 2) * kstep; const char* b2 = last ? nB : cB + (size_t)(t + 2) * kstep;
            const char* a3 = a2 + kstep; const char* b3 = b2 + kstep;
            unsigned o2[2][2];
#pragma unroll
            for (int h = 0; h < 2; ++h)
#pragma unroll
                for (int i = 0; i < 2; ++i) o2[h][i] = last ? on[h][i] : oc[h][i];
            PG8_LDB(B0, 0, 0); PG8_LDB(B1, 0, 1); PG8_SCHED; PG8_LDA(At, 0, 0); PG8_STAGE(PG8_SA(1, 1), a1, oc[1]);
            PG8_WAIT_V(8); PG8_WAIT_L(0); PG8_BAR; PG8_MMA(0, 0, At, B0); PG8_MMA(0, 1, At, B1); PG8_BAR; PG8_SCHED;
            PG8_LDA(At, 0, 1); PG8_STAGE(PG8_SB(0, 0), b2, voffB); PG8_STAGE(PG8_SB(0, 1), b2 + hstep, voffB); PG8_STAGE(PG8_SA(0, 0), a2, o2[0]);
            PG8_WAIT_V(8); PG8_WAIT_L(0); PG8_BAR; PG8_MMA(1, 0, At, B0); PG8_MMA(1, 1, At, B1); PG8_BAR; PG8_SCHED;
            PG8_LDB(B0, 1, 0); PG8_LDB(B1, 1, 1); PG8_SCHED; PG8_LDA(At, 1, 0); PG8_STAGE(PG8_SA(0, 1), a2, o2[1]);
            PG8_WAIT_V(8); PG8_WAIT_L(0); PG8_BAR; PG8_MMA(0, 0, At, B0); PG8_MMA(0, 1, At, B1); PG8_BAR; PG8_SCHED;
            PG8_LDA(At, 1, 1); PG8_STAGE(PG8_SB(1, 0), b3, voffB); PG8_STAGE(PG8_SB(1, 1), b3 + hstep, voffB); PG8_STAGE(PG8_SA(1, 0), a3, o2[0]);
            PG8_WAIT_V(8); PG8_WAIT_L(0); PG8_BAR; PG8_MMA(1, 0, At, B0); PG8_MMA(1, 1, At, B1); PG8_BAR; PG8_SCHED;
        }
        if (ALIGN_EPI) { if (wr == 0) PG8_BAR; }
        E(acc, cur, wr, wc, fr, fq);
        if (!has_next) break;
#pragma unroll
        for (int a = 0; a < 2; ++a)
#pragma unroll
            for (int b = 0; b < 2; ++b)
#pragma unroll
                for (int m = 0; m < 4; ++m)
#pragma unroll
                    for (int n = 0; n < 2; ++n) acc[a][b][m][n] = (f32x4){0.f, 0.f, 0.f, 0.f};
        cur = nxt; cA = nA; cB = nB; ++ui;
#pragma unroll
        for (int h = 0; h < 2; ++h)
#pragma unroll
            for (int i = 0; i < 2; ++i) oc[h][i] = on[h][i];
        if (ALIGN_EPI) { if (wr == 1) PG8_BAR; }
    }
    PG8_WAIT_V(0);
    if (!ALIGN_EPI) { if (wr == 0) PG8_BAR; }
    PG8_BAR;
#undef PG8_SA
#undef PG8_SB
#undef PG8_STAGE
#undef PG8_LDA
#undef PG8_LDB
#undef PG8_MMA
#undef PG8_WAIT_V
#undef PG8_WAIT_L
#undef PG8_BAR
#undef PG8_SCHED
}

struct GemmPlain {
    const bf16_t* A; const bf16_t* Bt; int K;
    DEV const char* a_base(const Unit& u) const { return (const char*)A + (size_t)u.pm * (256 * K * 2); }
    DEV const char* b_base(const Unit& u) const { return (const char*)Bt + (size_t)u.pn * (256 * K * 2); }
    DEV unsigned a_off(const Unit&, int h, int R, int C) const { return (unsigned)((h * 128 + R) * K + C) * 2u; }
};
struct RowMajorOrder {
    int nN, nunits, G, c;
    DEV bool next(int i, Unit& u) const { const int L = i * G + c; if (L >= nunits) return false; u.pm = L / nN; u.pn = L - u.pm * nN; return true; }
};
}

template <class RowMap>
DEV void transpose_item(const float* W, int K, int N, bf16_t* WT, LAS float* scr, int item, int lane, const RowMap& rm) {
    const int nblk = N / 32, kb = item / nblk, nbk = item % nblk, k0 = 64 * kb, n0 = 32 * nbk;
#pragma unroll 8
    for (int i = 0; i < 32; ++i) { const int kk = 2 * i + (lane >> 5); scr[kk * 33 + (lane & 31)] = W[(size_t)(k0 + kk) * N + n0 + (lane & 31)]; }
    asm volatile("s_waitcnt lgkmcnt(0)" ::: "memory");
    const int c = lane & 7;
#pragma unroll
    for (int j = 0; j < 4; ++j) { const int n = (lane >> 3) + 8 * j; const LAS float* s = scr + (8 * c) * 33 + n;
        u32x4 o; o.x = pack2(s[0 * 33], s[1 * 33]); o.y = pack2(s[2 * 33], s[3 * 33]); o.z = pack2(s[4 * 33], s[5 * 33]); o.w = pack2(s[6 * 33], s[7 * 33]);
        *(u32x4*)(WT + (size_t)rm(n0 + n) * K + k0 + 8 * c) = o; }
    asm volatile("s_waitcnt lgkmcnt(0)" ::: "memory");
}
struct MapId { DEV int operator()(int n) const { return n; } };
struct MapIn { DEV int operator()(int n) const { return (n & ~255) | ((n & 32) << 2) | ((n & 192) >> 1) | (n & 31); } };
template <int NSEL> struct MapGU { DEV int operator()(int h) const { return ((h >> 7) << 8) | (((h >> 6) & 1) << 7) | (((h >> 4) & 3) << 5) | (((h >> 2) & 3) << 3) | (NSEL << 2) | (h & 3); } };

constexpr int IT_IN = (D / 64) * (INW / 32), IT_OUT = (D / 64) * (D / 32), IT_G = (D / 64) * (DE / 32), IT_D = (DE / 64) * (D / 32), IT_EXP = 2 * IT_G + IT_D;
DEV void convert_experts(const P& p, int l, int gw, int ngw, LAS float* scr, int lane) {
    for (int it = gw; it < NE * IT_EXP; it += ngw) {
        const int e = it / IT_EXP; int r = it - e * IT_EXP;
        const size_t le = (size_t)(l * NE + e);
        if (r < IT_G) { transpose_item(p.w_gate + le * D * DE, D, DE, p.wt_gu + (size_t)e * D * D, scr, r, lane, MapGU<0>()); continue; } r -= IT_G;
        if (r < IT_G) { transpose_item(p.w_up + le * D * DE, D, DE, p.wt_gu + (size_t)e * D * D, scr, r, lane, MapGU<1>()); continue; } r -= IT_G;
        transpose_item(p.w_down + le * DE * D, DE, D, p.wt_d + (size_t)e * D * DE, scr, r, lane, MapId());
    }
}
DEV void phase_prologue(const P& p, int bid, int nb, LAS unsigned char* lds) {
    const int tid = otid(), lane = tid & 63, wv = tid >> 6;
    {
        LAS float* sil = (LAS float*)lds;
        LAS float* red = (LAS float*)(lds + 9 * 1024 * 4);
        bool have = false;
        for (int w = bid; w < 2 * 96; w += nb) {
            if (!have) {
                for (int i = tid; i < 9 * 1024; i += NTHR) { const int r = i >> 10, d = i & 1023; const float v = r < 8 ? p.c[r * 1024 + d] : p.c_ctx[d]; sil[i] = v * sigmoidf_(v); }
                have = true;
            }
            __syncthreads();
            const int l = w / 96, col0 = (w % 96) * 64, kq = tid >> 4, c4 = (tid & 15) * 4;
            const float* wp = p.ada_w + (size_t)l * 1024 * 6144 + col0 + c4;
            float acc[9][4];
#pragma unroll
            for (int r = 0; r < 9; ++r)
#pragma unroll
                for (int j = 0; j < 4; ++j) acc[r][j] = 0.f;
#pragma unroll 4
            for (int i = 0; i < 32; ++i) {
                const int k = kq + 32 * i;
                const float4 w4 = *(const float4*)(wp + (size_t)k * 6144);
#pragma unroll
                for (int r = 0; r < 9; ++r) { const float sv = sil[r * 1024 + k]; acc[r][0] += sv * w4.x; acc[r][1] += sv * w4.y; acc[r][2] += sv * w4.z; acc[r][3] += sv * w4.w; }
            }
#pragma unroll
            for (int r = 0; r < 9; ++r)
#pragma unroll
                for (int j = 0; j < 4; ++j) red[(kq * 64 + c4 + j) * 9 + r] = acc[r][j];
            __syncthreads();
            for (int o = tid; o < 64 * 9; o += NTHR) {
                const int cc = o / 9, r = o - cc * 9; float s = 0.f;
#pragma unroll 8
                for (int g = 0; g < 32; ++g) s += red[(g * 64 + cc) * 9 + r];
                p.mod[(size_t)(l * 9 + r) * 6144 + col0 + cc] = s + p.ada_b[l * 6144 + col0 + cc];
            }
        }
        __syncthreads();
    }
    {
        LAS float* scr = (LAS float*)(lds + wv * 16384);
        const int gw = bid * 8 + wv, ngw = nb * 8;
        for (int it = gw; it < 2 * (IT_IN + IT_OUT); it += ngw) {
            const int l = it / (IT_IN + IT_OUT); int r = it - l * (IT_IN + IT_OUT);
            if (r < IT_IN) transpose_item(p.w_in + (size_t)l * D * INW, D, INW, p.wt_in + (size_t)l * INW * D, scr, r, lane, MapIn());
            else transpose_item(p.w_out + (size_t)l * D * D, D, D, p.wt_out + (size_t)l * D * D, scr, r - IT_IN, lane, MapId());
        }
        convert_experts(p, 0, gw, ngw, scr, lane);
    }
}

template <int MODE>
DEV void phase_rowA(const P& p, int l, int bid, int nb) {
    const int tid = otid(), lane = tid & 63, wv = tid >> 6;
    const int nrows = (MODE == 2) ? TL : TT;
    for (int t = bid * 8 + wv; t < nrows; t += nb * 8) {
        const int mr = mod_row(t);
        float xv[16];
        if (MODE == 0) {
            const float* src = t < TL ? p.x + (size_t)t * D : p.ctx + (size_t)(t - TL) * D;
#pragma unroll
            for (int i = 0; i < 4; ++i) { const float4 v4 = *(const float4*)(src + i * 256 + lane * 4); xv[i * 4] = v4.x; xv[i * 4 + 1] = v4.y; xv[i * 4 + 2] = v4.z; xv[i * 4 + 3] = v4.w; }
        } else {
            const int lp = (MODE == 2) ? 1 : 0;
            const float* src = p.xres + (size_t)t * D;
            const float* g2 = p.mod + (size_t)(lp * 9 + mr) * 6144 + 5 * 1024;
            const bf16_t* y0 = p.y + (size_t)(2 * t) * D; const bf16_t* y1 = y0 + D;
#pragma unroll
            for (int i = 0; i < 4; ++i) {
                const int c0 = i * 256 + lane * 4;
                const float4 v4 = *(const float4*)(src + c0); const float4 g4 = *(const float4*)(g2 + c0);
                const uint2 a = *(const uint2*)(y0 + c0), b = *(const uint2*)(y1 + c0);
                xv[i * 4] = v4.x + g4.x * (bflo(a.x) + bflo(b.x)); xv[i * 4 + 1] = v4.y + g4.y * (bfhi(a.x) + bfhi(b.x));
                xv[i * 4 + 2] = v4.z + g4.z * (bflo(a.y) + bflo(b.y)); xv[i * 4 + 3] = v4.w + g4.w * (bfhi(a.y) + bfhi(b.y));
            }
            if (MODE == 1) {
#pragma unroll
                for (int i = 0; i < 4; ++i) *(float4*)(p.xres + (size_t)t * D + i * 256 + lane * 4) = make_float4(xv[i * 4], xv[i * 4 + 1], xv[i * 4 + 2], xv[i * 4 + 3]);
            }
        }
        float ss = 0.f;
#pragma unroll
        for (int i = 0; i < 16; ++i) ss += xv[i] * xv[i];
        ss = wave_sum(ss);
        const float rstd = rsqrtf(ss * (1.f / D) + EPS);
        if (MODE == 2) {
#pragma unroll
            for (int i = 0; i < 4; ++i) {
                const int c0 = i * 256 + lane * 4; const float4 g4 = *(const float4*)(p.final_g + c0);
                *(float4*)(p.out + (size_t)t * D + c0) = make_float4(xv[i * 4] * rstd * g4.x, xv[i * 4 + 1] * rstd * g4.y, xv[i * 4 + 2] * rstd * g4.z, xv[i * 4 + 3] * rstd * g4.w);
            }
        } else {
            const float* ng = p.norm1_g + l * D; const float* mm = p.mod + (size_t)(l * 9 + mr) * 6144;
#pragma unroll
            for (int i = 0; i < 4; ++i) {
                const int c0 = i * 256 + lane * 4;
                const float4 g4 = *(const float4*)(ng + c0), sh = *(const float4*)(mm + c0), sc = *(const float4*)(mm + 1024 + c0);
                const float o0 = xv[i * 4] * rstd * g4.x * (1.f + sc.x) + sh.x, o1 = xv[i * 4 + 1] * rstd * g4.y * (1.f + sc.y) + sh.y;
                const float o2 = xv[i * 4 + 2] * rstd * g4.z * (1.f + sc.z) + sh.z, o3 = xv[i * 4 + 3] * rstd * g4.w * (1.f + sc.w) + sh.w;
                *(uint2*)(p.xn + (size_t)t * D + c0) = make_uint2(pack2(o0, o1), pack2(o2, o3));
            }
        }
    }
}

struct EpiIn {
    static constexpr bool PERM = true;
    const P* pp; int l; const LAS float* rope;
    DEV void operator()(const f32x4 (&acc)[2][2][4][2], const pg8::Unit& u, int wr, int wc, int fr, int fq) const {
        const P& p = *pp;
        const int pn = u.pn;
        const bool lat = u.pm < TL / 256;
        const bool is_qk = (pn < 2) || (pn == 2 && wc < 2);
        bf16_t* dst; int ld; bool kvmap = false;
        if (pn < 2) { dst = p.q + (pn * 4 + wc) * 64; ld = 512; }
        else if (pn == 2) { dst = (wc < 2 ? p.k + wc * 64 : p.v + (wc - 2) * 64); ld = 128; kvmap = true; }
        else if (pn < 5) { dst = p.u + (pn - 3) * 256 + wc * 64; ld = 512; }
        else { dst = p.gb + (pn - 5) * 256 + wc * 64; ld = 512; }
        float gq[2][2][4];
#pragma unroll
        for (int bj = 0; bj < 2; ++bj)
#pragma unroll
            for (int n = 0; n < 2; ++n)
#pragma unroll
                for (int j = 0; j < 4; ++j) gq[bj][n][j] = 1.f;
        if (is_qk) {
            const float* g = (pn < 2 ? p.q_norm_g : p.k_norm_g) + l * 64;
#pragma unroll
            for (int bj = 0; bj < 2; ++bj)
#pragma unroll
                for (int n = 0; n < 2; ++n) { const float4 g4 = *(const float4*)(g + 32 * bj + 8 * fq + 4 * n); gq[bj][n][0] = g4.x; gq[bj][n][1] = g4.y; gq[bj][n][2] = g4.z; gq[bj][n][3] = g4.w; }
        }
#pragma unroll
        for (int ai = 0; ai < 2; ++ai)
#pragma unroll
            for (int m = 0; m < 4; ++m) {
                const int t = u.pm * 256 + ai * 128 + wr * 64 + m * 16 + fr;
                float v[2][2][4];
#pragma unroll
                for (int bj = 0; bj < 2; ++bj)
#pragma unroll
                    for (int n = 0; n < 2; ++n)
#pragma unroll
                        for (int j = 0; j < 4; ++j) v[bj][n][j] = acc[ai][bj][m][n][j];
                if (is_qk) {
                    float ss = 0.f;
#pragma unroll
                    for (int bj = 0; bj < 2; ++bj)
#pragma unroll
                        for (int n = 0; n < 2; ++n)
#pragma unroll
                            for (int j = 0; j < 4; ++j) ss += v[bj][n][j] * v[bj][n][j];
                    ss += __shfl_xor(ss, 16); ss += __shfl_xor(ss, 32);
                    const float rstd = rsqrtf(ss * (1.f / 64.f) + EPS);
                    const int s = t & 2047;
#pragma unroll
                    for (int bj = 0; bj < 2; ++bj) {
                        const int pos = bj ? (s & 63) : (s >> 6);
#pragma unroll
                        for (int n = 0; n < 2; ++n) {
                            float cs4[4] = {1.f, 1.f, 1.f, 1.f}, sn4[4] = {0.f, 0.f, 0.f, 0.f};
                            if (lat) {
                                const int f0 = 8 * (fq & 1) + 4 * n;
                                const f32x4 c4 = *(const LAS f32x4*)(rope + pos * 16 + f0), s4 = *(const LAS f32x4*)(rope + 1024 + pos * 16 + f0);
                                cs4[0] = c4.x; cs4[1] = c4.y; cs4[2] = c4.z; cs4[3] = c4.w; sn4[0] = s4.x; sn4[1] = s4.y; sn4[2] = s4.z; sn4[3] = s4.w;
                            }
#pragma unroll
                            for (int j = 0; j < 4; ++j) {
                                const float w = v[bj][n][j] * gq[bj][n][j];
                                const float pw = __shfl_xor(w, 32);
                                const float o = (fq & 2) ? (w * cs4[j] + pw * sn4[j]) : (w * cs4[j] - pw * sn4[j]);
                                v[bj][n][j] = o * rstd;
                            }
                        }
                    }
                }
                bf16_t* rowp = dst + (size_t)(kvmap ? kv_row(t) : t) * ld;
#pragma unroll
                for (int bj = 0; bj < 2; ++bj) {
                    u32x4 w; w.x = pack2(v[bj][0][0], v[bj][0][1]); w.y = pack2(v[bj][0][2], v[bj][0][3]); w.z = pack2(v[bj][1][0], v[bj][1][1]); w.w = pack2(v[bj][1][2], v[bj][1][3]);
                    *(u32x4*)(rowp + 32 * bj + 8 * fq) = w;
                }
            }
    }
};
struct EpiOut {
    static constexpr bool PERM = false;
    const P* pp; int l;
    DEV void operator()(const f32x4 (&acc)[2][2][4][2], const pg8::Unit& u, int wr, int wc, int fr, int fq) const {
        const P& p = *pp;
        const int col0 = u.pn * 256 + wc * 32 + 4 * fq;
        const int mr = u.pm < TL / 256 ? (u.pm >> 3) : 8;
        const float* g1 = p.mod + (size_t)(l * 9 + mr) * 6144 + 2048 + col0;
        f32x4 gv[2][2];
#pragma unroll
        for (int bj = 0; bj < 2; ++bj)
#pragma unroll
            for (int n = 0; n < 2; ++n) gv[bj][n] = *(const f32x4*)(g1 + bj * 128 + n * 16);
#pragma unroll
        for (int ai = 0; ai < 2; ++ai)
#pragma unroll
            for (int m = 0; m < 4; ++m) {
                const int t = u.pm * 256 + ai * 128 + wr * 64 + m * 16 + fr;
                const float* res = (l == 0) ? (t < TL ? p.x + (size_t)t * D : p.ctx + (size_t)(t - TL) * D) : p.xres + (size_t)t * D;
                float* o = p.xres + (size_t)t * D + col0;
#pragma unroll
                for (int bj = 0; bj < 2; ++bj)
#pragma unroll
                    for (int n = 0; n < 2; ++n) { const f32x4 r4 = *(const f32x4*)(res + col0 + bj * 128 + n * 16); *(f32x4*)(o + bj * 128 + n * 16) = r4 + gv[bj][n] * acc[ai][bj][m][n]; }
            }
    }
};
struct MoeUpDesc {
    const bf16_t* A; const bf16_t* Bt; int K; const LAS i32x2* ptab; const int* cnt; const int* list;
    DEV const char* a_base(const pg8::Unit&) const { return (const char*)A; }
    DEV const char* b_base(const pg8::Unit& u) const { const int e = ptab[u.pm].x; return (const char*)Bt + ((size_t)e * D + (size_t)u.pn * 256) * (D * 2); }
    DEV unsigned a_off(const pg8::Unit& u, int h, int R, int C) const {
        const i32x2 pe = ptab[u.pm]; const int pos = pe.y + h * 128 + R;
        const int tok = pos < cnt[pe.x] ? (list[pe.x * TT + pos] >> 1) : 0;
        return (unsigned)(tok * D + C) * 2u;
    }
};
struct MoeDownDesc {
    const bf16_t* A; const bf16_t* Bt; int K; const LAS i32x2* ptab;
    DEV const char* a_base(const pg8::Unit& u) const { return (const char*)A + (size_t)u.pm * (256 * DE * 2); }
    DEV const char* b_base(const pg8::Unit& u) const { const int e = ptab[u.pm].x; return (const char*)Bt + ((size_t)e * D + (size_t)u.pn * 256) * (DE * 2); }
    DEV unsigned a_off(const pg8::Unit&, int h, int R, int C) const { return (unsigned)((h * 128 + R) * DE + C) * 2u; }
};
struct EpiMoeUp {
    static constexpr bool PERM = true;
    bf16_t* hid;
    DEV void operator()(const f32x4 (&acc)[2][2][4][2], const pg8::Unit& u, int wr, int wc, int fr, int fq) const {
#pragma unroll
        for (int ai = 0; ai < 2; ++ai)
#pragma unroll
            for (int m = 0; m < 4; ++m) {
                bf16_t* rowp = hid + (size_t)(u.pm * 256 + ai * 128 + wr * 64 + m * 16 + fr) * DE + u.pn * 128 + wc * 16 + fq * 4;
#pragma unroll
                for (int bj = 0; bj < 2; ++bj) {
                    const f32x4 g = acc[ai][bj][m][0], up = acc[ai][bj][m][1];
                    float h[4];
#pragma unroll
                    for (int j = 0; j < 4; ++j) h[j] = g[j] * sigmoidf_(g[j]) * up[j];
                    *(u32x2*)(rowp + bj * 64) = (u32x2){pack2(h[0], h[1]), pack2(h[2], h[3])};
                }
            }
    }
};
struct EpiMoeDown {
    static constexpr bool PERM = true;
    bf16_t* y; const float* tokw; const LAS i32x2* ptab; const int* cnt; const int* list;
    DEV void operator()(const f32x4 (&acc)[2][2][4][2], const pg8::Unit& u, int wr, int wc, int fr, int fq) const {
        const i32x2 pe = ptab[u.pm]; const int ce = cnt[pe.x];
#pragma unroll
        for (int ai = 0; ai < 2; ++ai)
#pragma unroll
            for (int m = 0; m < 4; ++m) {
                const int pos = pe.y + ai * 128 + wr * 64 + m * 16 + fr;
                if (pos < ce) {
                    const int pair = list[pe.x * TT + pos]; const float wt = tokw[pair];
                    bf16_t* rowp = y + (size_t)pair * D + u.pn * 256 + wc * 32 + 8 * fq;
#pragma unroll
                    for (int bj = 0; bj < 2; ++bj) {
                        const f32x4 a0 = acc[ai][bj][m][0] * wt, a1 = acc[ai][bj][m][1] * wt;
                        *(u32x4*)(rowp + bj * 128) = (u32x4){pack2(a0[0], a0[1]), pack2(a0[2], a0[3]), pack2(a1[0], a1[1]), pack2(a1[2], a1[3])};
                    }
                }
            }
    }
};
DEV int moe_build_ptab(const int* cnt, LAS i32x2* ptab, int tid) {
    __syncthreads();
    if (tid < 64) {
        const int c = tid < NE ? cnt[tid] : 0;
        const int npan = (c + 255) >> 8;
        int incl = npan;
#pragma unroll
        for (int o = 1; o < 16; o <<= 1) { const int v = __shfl_up(incl, o); if (tid >= o) incl += v; }
        int base = incl - npan;
#pragma unroll 1
        for (int r0 = 0; r0 < c; r0 += 256) { ptab[base] = (i32x2){tid, r0}; ++base; }
        if (tid == NE - 1) ptab[MAXPANELS] = (i32x2){incl, 0};
    }
    __syncthreads();
    return ptab[MAXPANELS].x;
}

DEV void phase_attn(const P& p, int l, int bid, int nb) {
    const int tid = otid();
    const int nitems = (l == 0) ? 256 + 64 : 256;
    for (int w = bid; w < nitems; w += nb) {
        int b, h, qrow, nkeys; bool active = true;
        if (w < 256) { b = w >> 5; h = (w >> 2) & 7; qrow = b * S + (w & 3) * 512 + tid; nkeys = CL + S; }
        else { const int w2 = w - 256; b = w2 >> 3; h = w2 & 7; qrow = TL + b * CL + (tid & 255); nkeys = CL; active = tid < 256; }
        if (!active) continue;
        const int kvh = h >> 2;
        float qv[64], o[64];
        bf16_t* qp = p.q + (size_t)qrow * 512 + h * 64;
#pragma unroll
        for (int i = 0; i < 8; ++i) {
            const uint4 r4 = *(const uint4*)(qp + i * 8);
            qv[i * 8] = bflo(r4.x) * 0.125f; qv[i * 8 + 1] = bfhi(r4.x) * 0.125f; qv[i * 8 + 2] = bflo(r4.y) * 0.125f; qv[i * 8 + 3] = bfhi(r4.y) * 0.125f;
            qv[i * 8 + 4] = bflo(r4.z) * 0.125f; qv[i * 8 + 5] = bfhi(r4.z) * 0.125f; qv[i * 8 + 6] = bflo(r4.w) * 0.125f; qv[i * 8 + 7] = bfhi(r4.w) * 0.125f;
        }
#pragma unroll
        for (int i = 0; i < 64; ++i) o[i] = 0.f;
        float mx = -1e30f, den = 0.f;
        const bf16_t* kb = p.k + (size_t)b * KVS * 128 + kvh * 64; const bf16_t* vb = p.v + (size_t)b * KVS * 128 + kvh * 64;
        for (int j = 0; j < nkeys; ++j) {
            const bf16_t* kp = kb + (size_t)j * 128; const bf16_t* vp = vb + (size_t)j * 128;
            float sc = 0.f;
#pragma unroll
            for (int i = 0; i < 8; ++i) {
                const uint4 r4 = *(const uint4*)(kp + i * 8);
                sc += qv[i * 8] * bflo(r4.x) + qv[i * 8 + 1] * bfhi(r4.x) + qv[i * 8 + 2] * bflo(r4.y) + qv[i * 8 + 3] * bfhi(r4.y)
                    + qv[i * 8 + 4] * bflo(r4.z) + qv[i * 8 + 5] * bfhi(r4.z) + qv[i * 8 + 6] * bflo(r4.w) + qv[i * 8 + 7] * bfhi(r4.w);
            }
            const float mn = fmaxf(mx, sc), corr = __expf(mx - mn), pe = __expf(sc - mn);
            den = den * corr + pe; mx = mn;
#pragma unroll
            for (int i = 0; i < 8; ++i) {
                const uint4 r4 = *(const uint4*)(vp + i * 8);
                o[i * 8] = o[i * 8] * corr + pe * bflo(r4.x); o[i * 8 + 1] = o[i * 8 + 1] * corr + pe * bfhi(r4.x);
                o[i * 8 + 2] = o[i * 8 + 2] * corr + pe * bflo(r4.y); o[i * 8 + 3] = o[i * 8 + 3] * corr + pe * bfhi(r4.y);
                o[i * 8 + 4] = o[i * 8 + 4] * corr + pe * bflo(r4.z); o[i * 8 + 5] = o[i * 8 + 5] * corr + pe * bfhi(r4.z);
                o[i * 8 + 6] = o[i * 8 + 6] * corr + pe * bflo(r4.w); o[i * 8 + 7] = o[i * 8 + 7] * corr + pe * bfhi(r4.w);
            }
        }
        const float inv = 1.f / den;
#pragma unroll
        for (int i = 0; i < 8; ++i) {
            uint4 r4; r4.x = pack2(o[i * 8] * inv, o[i * 8 + 1] * inv); r4.y = pack2(o[i * 8 + 2] * inv, o[i * 8 + 3] * inv);
            r4.z = pack2(o[i * 8 + 4] * inv, o[i * 8 + 5] * inv); r4.w = pack2(o[i * 8 + 6] * inv, o[i * 8 + 7] * inv);
            *(uint4*)(qp + i * 8) = r4;
        }
    }
}

DEV void phase_lru_gates(const P& p, int l, int d, int bid, int nb, LAS unsigned char* lds) {
    LAS float* uc = (LAS float*)lds;
    const int tid = otid();
    const float* cw = p.conv_w + l * 4 * 512; const float* cb = p.conv_b + l * 512;
    for (int w = bid; w < TT / 16; w += nb) {
        const int t0 = w * 16;
        const int seq0 = t0 < TL ? (t0 & ~2047) : TL + ((t0 - TL) & ~255);
        const int seqlen = t0 < TL ? S : CL;
        __syncthreads();
        for (int i = tid; i < 16 * 512; i += NTHR) {
            const int tt = i >> 9, ch = i & 511, t = t0 + tt;
            float acc = cb[ch];
#pragma unroll
            for (int j = 0; j < 4; ++j) { const int ts = t - 2 + j; if (ts >= seq0 && ts < seq0 + seqlen) acc += bf2f(p.u[(size_t)ts * 512 + ch]) * cw[j * 512 + ch]; }
            uc[i] = acc;
        }
        __syncthreads();
        {
            const int e = tid, n = e >> 6, ee = e & 63;
            const float* wa = p.lru_wa + ((size_t)((l * 2 + d) * 8 + n) * 64) * 64 + ee;
            const float* wx = p.lru_wx + ((size_t)((l * 2 + d) * 8 + n) * 64) * 64 + ee;
            float ra[16], ri[16];
#pragma unroll
            for (int tt = 0; tt < 16; ++tt) { ra[tt] = 0.f; ri[tt] = 0.f; }
            for (int dd = 0; dd < 64; ++dd) {
                const float wav = wa[dd * 64], wxv = wx[dd * 64];
#pragma unroll
                for (int tt = 0; tt < 16; ++tt) { const float uv = uc[tt * 512 + n * 64 + dd]; ra[tt] += uv * wav; ri[tt] += uv * wxv; }
            }
            const int pi = (l * 2 + d) * 512 + e;
            const float ba = p.lru_ba[pi], bx = p.lru_bx[pi], lam = p.lru_lambda[pi];
            const float sp = (-lam > 20.f) ? -lam : log1pf(__expf(-lam));
#pragma unroll
            for (int tt = 0; tt < 16; ++tt) {
                const float r = sigmoidf_(ra[tt] + ba), ig = sigmoidf_(ri[tt] + bx);
                const float log_a = -8.f * r * sp;
                const float a = __expf(log_a);
                const float bm = sqrtf(fmaxf(1.f - __expf(2.f * log_a), 0.f)) * (ig * uc[tt * 512 + e]);
                const size_t o = ((size_t)t0 + tt) * 512 + e;
                p.la[o] = a; p.lb[o] = bm;
            }
        }
    }
}
DEV void phase_lru_scan(const P& p, int d, int bid, int nb) {
    const int tid = otid();
    for (int w = bid; w < 8; w += nb) {
        const int b = w, ch = tid;
        const float* la = p.la + ch; const float* lb = p.lb + ch;
        bf16_t* hd = p.hdir + (size_t)d * TT * 512 + ch;
        float h = 0.f;
        const int cbase = TL + b * CL, lbase = b * S;
        if (d == 0) {
#pragma unroll 8
            for (int i = 0; i < CL; ++i) { const size_t o = (size_t)(cbase + i) * 512; h = la[o] * h + lb[o]; hd[o] = (bf16_t)f2bf(h); }
#pragma unroll 8
            for (int i = 0; i < S; ++i) { const size_t o = (size_t)(lbase + i) * 512; h = la[o] * h + lb[o]; hd[o] = (bf16_t)f2bf(h); }
        } else {
#pragma unroll 8
            for (int i = CL - 1; i >= 0; --i) { const size_t o = (size_t)(cbase + i) * 512; h = la[o] * h + lb[o]; hd[o] = (bf16_t)f2bf(h); }
#pragma unroll 8
            for (int i = S - 1; i >= 0; --i) { const size_t o = (size_t)(lbase + i) * 512; h = la[o] * h + lb[o]; hd[o] = (bf16_t)f2bf(h); }
        }
    }
}

DEV void phase_mix(const P& p, int l, int bid, int nb) {
    const int tid = otid(), lane = tid & 63, wv = tid >> 6;
    const int nrows = l == 0 ? TT : TL;
    for (int t = bid * 8 + wv; t < nrows; t += nb * 8) {
        const int c0 = lane * 8;
        const uint4 a4 = *(const uint4*)(p.q + (size_t)t * 512 + c0);
        const uint4 f4 = *(const uint4*)(p.hdir + (size_t)t * 512 + c0), b4 = *(const uint4*)(p.hdir + ((size_t)TT + t) * 512 + c0), g4 = *(const uint4*)(p.gb + (size_t)t * 512 + c0);
        float av[8] = {bflo(a4.x), bfhi(a4.x), bflo(a4.y), bfhi(a4.y), bflo(a4.z), bfhi(a4.z), bflo(a4.w), bfhi(a4.w)};
        const float fv[8] = {bflo(f4.x), bfhi(f4.x), bflo(f4.y), bfhi(f4.y), bflo(f4.z), bfhi(f4.z), bflo(f4.w), bfhi(f4.w)};
        const float bv[8] = {bflo(b4.x), bfhi(b4.x), bflo(b4.y), bfhi(b4.y), bflo(b4.z), bfhi(b4.z), bflo(b4.w), bfhi(b4.w)};
        const float gv[8] = {bflo(g4.x), bfhi(g4.x), bflo(g4.y), bfhi(g4.y), bflo(g4.z), bfhi(g4.z), bflo(g4.w), bfhi(g4.w)};
        float rv[8]; float sa = 0.f, sr = 0.f;
#pragma unroll
        for (int i = 0; i < 8; ++i) { rv[i] = (fv[i] + bv[i]) * gelu_tanh(gv[i]); sa += av[i] * av[i]; sr += rv[i] * rv[i]; }
        sa = wave_sum(sa); sr = wave_sum(sr);
        const float ra = rsqrtf(sa * (1.f / 512.f) + EPS), rr = rsqrtf(sr * (1.f / 512.f) + EPS);
        const float* ga = p.attn_out_g + l * 512 + c0; const float* gr = p.lru_out_g + l * 512 + c0;
#pragma unroll
        for (int i = 0; i < 8; ++i) { av[i] = av[i] * ra * ga[i]; rv[i] = rv[i] * rr * gr[i]; }
        uint4 o; o.x = pack2(av[0], av[1]); o.y = pack2(av[2], av[3]); o.z = pack2(av[4], av[5]); o.w = pack2(av[6], av[7]);
        *(uint4*)(p.xn + (size_t)t * D + c0) = o;
        o.x = pack2(rv[0], rv[1]); o.y = pack2(rv[2], rv[3]); o.z = pack2(rv[4], rv[5]); o.w = pack2(rv[6], rv[7]);
        *(uint4*)(p.xn + (size_t)t * D + 512 + c0) = o;
    }
}

DEV void phase_route(const P& p, int l, int bid, int nb) {
    const int tid = otid(), lane = tid & 63, wv = tid >> 6;
    const int nrows = l == 0 ? TT : TL;
    for (int t = bid * 8 + wv; t < nrows; t += nb * 8) {
        const int mr = mod_row(t);
        const float* src = p.xres + (size_t)t * D;
        float xv[16];
#pragma unroll
        for (int i = 0; i < 4; ++i) { const float4 v4 = *(const float4*)(src + i * 256 + lane * 4); xv[i * 4] = v4.x; xv[i * 4 + 1] = v4.y; xv[i * 4 + 2] = v4.z; xv[i * 4 + 3] = v4.w; }
        float ss = 0.f;
#pragma unroll
        for (int i = 0; i < 16; ++i) ss += xv[i] * xv[i];
        ss = wave_sum(ss);
        const float rstd = rsqrtf(ss * (1.f / D) + EPS);
        const float* ng = p.norm2_g + l * D; const float* mm = p.mod + (size_t)(l * 9 + mr) * 6144;
        float lg[16];
#pragma unroll
        for (int e = 0; e < 16; ++e) lg[e] = 0.f;
#pragma unroll
        for (int i = 0; i < 4; ++i) {
            const int c0 = i * 256 + lane * 4;
            const float4 g4 = *(const float4*)(ng + c0), sh = *(const float4*)(mm + 3072 + c0), sc = *(const float4*)(mm + 4096 + c0);
            const float o0 = xv[i * 4] * rstd * g4.x * (1.f + sc.x) + sh.x, o1 = xv[i * 4 + 1] * rstd * g4.y * (1.f + sc.y) + sh.y;
            const float o2 = xv[i * 4 + 2] * rstd * g4.z * (1.f + sc.z) + sh.z, o3 = xv[i * 4 + 3] * rstd * g4.w * (1.f + sc.w) + sh.w;
            *(uint2*)(p.xn + (size_t)t * D + c0) = make_uint2(pack2(o0, o1), pack2(o2, o3));
            const float hv[4] = {o0, o1, o2, o3};
#pragma unroll
            for (int j = 0; j < 4; ++j) {
                const float4* rw = (const float4*)(p.router_w + (size_t)(c0 + j) * 16);
#pragma unroll
                for (int q4 = 0; q4 < 4; ++q4) { const float4 r4 = rw[q4]; lg[q4 * 4] += hv[j] * r4.x; lg[q4 * 4 + 1] += hv[j] * r4.y; lg[q4 * 4 + 2] += hv[j] * r4.z; lg[q4 * 4 + 3] += hv[j] * r4.w; }
            }
        }
        float sc_[16], bi[16];
#pragma unroll
        for (int e = 0; e < 16; ++e) { lg[e] = wave_sum(lg[e]); sc_[e] = 1.f / (1.f + expf(-lg[e])); bi[e] = sc_[e] + p.router_b[e]; }
        float gs[4];
#pragma unroll
        for (int g = 0; g < 4; ++g) {
            const float a = bi[g * 4], b = bi[g * 4 + 1], c = bi[g * 4 + 2], d = bi[g * 4 + 3];
            const float m1 = fmaxf(fmaxf(a, b), fmaxf(c, d));
            const float m2 = fmaxf(fmaxf(fminf(a, b), fminf(c, d)), fminf(fmaxf(a, b), fmaxf(c, d)));
            gs[g] = m1 + m2;
        }
        int bg = 0; float bgs = gs[0];
#pragma unroll
        for (int g = 1; g < 4; ++g) if (gs[g] > bgs) { bgs = gs[g]; bg = g; }
        float v0 = 0.f, v1 = 0.f, v2 = 0.f, v3 = 0.f, s0 = 0.f, s1 = 0.f, s2 = 0.f, s3 = 0.f;
#pragma unroll
        for (int g = 0; g < 4; ++g) if (bg == g) { v0 = bi[g * 4]; v1 = bi[g * 4 + 1]; v2 = bi[g * 4 + 2]; v3 = bi[g * 4 + 3]; s0 = sc_[g * 4]; s1 = sc_[g * 4 + 1]; s2 = sc_[g * 4 + 2]; s3 = sc_[g * 4 + 3]; }
        int i1 = 0; float b1 = v0, w1 = s0;
        if (v1 > b1) { b1 = v1; i1 = 1; w1 = s1; }
        if (v2 > b1) { b1 = v2; i1 = 2; w1 = s2; }
        if (v3 > b1) { b1 = v3; i1 = 3; w1 = s3; }
        int i2 = -1; float b2 = -1e30f, w2 = 0.f;
        if (i1 != 0 && v0 > b2) { b2 = v0; i2 = 0; w2 = s0; }
        if (i1 != 1 && v1 > b2) { b2 = v1; i2 = 1; w2 = s1; }
        if (i1 != 2 && v2 > b2) { b2 = v2; i2 = 2; w2 = s2; }
        if (i1 != 3 && v3 > b2) { b2 = v3; i2 = 3; w2 = s3; }
        if (lane == 0) {
            const float inv = 1.f / (w1 + w2);
            const int e1 = bg * 4 + i1, e2 = bg * 4 + i2;
            p.tokw[2 * t] = w1 * inv; p.tokw[2 * t + 1] = w2 * inv;
            const int p1 = atomicAdd(&p.cnt[l * 16 + e1], 1); p.list[e1 * TT + p1] = 2 * t;
            const int p2 = atomicAdd(&p.cnt[l * 16 + e2], 1); p.list[e2 * TT + p2] = 2 * t + 1;
        }
    }
}

__global__ void __launch_bounds__(NTHR, 2) fwd_megakernel(P p) {
    extern __shared__ __attribute__((aligned(16))) unsigned char lds_raw[];
    LAS unsigned char* lds = (LAS unsigned char*)lds_raw;
    volatile LAS unsigned* misc = (volatile LAS unsigned*)(lds + MISC_OFF);
    if (threadIdx.x < 16) misc[threadIdx.x] = 0u;
    __syncthreads();
    XcdBarrier gbar = xcd_barrier_post(p.bar, misc);
    const int bid = blockIdx.x, nb = gridDim.x;
    LAS float* rope_l = (LAS float*)(lds + MISC_OFF + MISC_ROPE);
    LAS i32x2* ptab = (LAS i32x2*)(lds + MISC_OFF + MISC_PTAB);
    {
        const int tid = otid();
        for (int i = tid; i < 1024; i += NTHR) {
            const int pos = i >> 4, f = i & 15;
            const float inv = exp2f(-(float)(2 * f) / 32.f * 13.287712379549449f);
            const float ang = (float)pos * inv;
            rope_l[i] = __cosf(ang); rope_l[1024 + i] = __sinf(ang);
        }
    }
    phase_prologue(p, bid, nb, lds);
    xcd_barrier(gbar);
#pragma unroll
    for (int l = 0; l < 2; ++l) {
        if (l == 0) phase_rowA<0>(p, l, bid, nb);
        else {
            phase_rowA<1>(p, l, bid, nb);
            const int tid = otid();
            convert_experts(p, 1, bid * 8 + (tid >> 6), nb * 8, (LAS float*)(lds + (tid >> 6) * 16384), tid & 63);
        }
        xcd_barrier(gbar);
        {
            const int tid = otid();
            pg8::GemmPlain g{p.xn, p.wt_in + (size_t)l * INW * D, D};
            pg8::RowMajorOrder so{7, (TT / 256) * 7, nb, bid};
            EpiIn E{&p, l, rope_l};
            pg8::gemm_phase<EpiIn, pg8::GemmPlain, pg8::RowMajorOrder, true>(lds, g, so, E, tid);
        }
        xcd_barrier(gbar);
        phase_attn(p, l, bid, nb);
        for (int d = 0; d < 2; ++d) {
            phase_lru_gates(p, l, d, bid, nb, lds);
            xcd_barrier(gbar);
            phase_lru_scan(p, d, bid, nb);
            xcd_barrier(gbar);
        }
        phase_mix(p, l, bid, nb);
        xcd_barrier(gbar);
        {
            const int tid = otid();
            pg8::GemmPlain g{p.xn, p.wt_out + (size_t)l * D * D, D};
            pg8::RowMajorOrder so{4, ((l == 0 ? TT : TL) / 256) * 4, nb, bid};
            EpiOut E{&p, l};
            pg8::gemm_phase<EpiOut, pg8::GemmPlain, pg8::RowMajorOrder, true>(lds, g, so, E, tid);
        }
        xcd_barrier(gbar);
        phase_route(p, l, bid, nb);
        xcd_barrier(gbar);
        {
            const int tid = otid();
            const int np = moe_build_ptab(p.cnt + l * 16, ptab, tid);
            MoeUpDesc g{p.xn, p.wt_gu, D, ptab, p.cnt + l * 16, p.list};
            pg8::RowMajorOrder so{4, np * 4, nb, bid};
            EpiMoeUp E{p.hid};
            pg8::gemm_phase<EpiMoeUp, MoeUpDesc, pg8::RowMajorOrder, true>(lds, g, so, E, tid);
        }
        xcd_barrier(gbar);
        {
            const int tid = otid();
            const int np = ptab[MAXPANELS].x;
            MoeDownDesc g{p.hid, p.wt_d, DE, ptab};
            pg8::RowMajorOrder so{4, np * 4, nb, bid};
            EpiMoeDown E{p.y, p.tokw, ptab, p.cnt + l * 16, p.list};
            pg8::gemm_phase<EpiMoeDown, MoeDownDesc, pg8::RowMajorOrder, true>(lds, g, so, E, tid);
        }
        xcd_barrier(gbar);
    }
    phase_rowA<2>(p, 1, bid, nb);
}

extern "C" void kernel_launch(void* const* d_in, const int* in_sizes, int n_in, void* d_out, int out_size, void* d_ws, size_t ws_size, hipStream_t stream) {
    P p{};
    const float* const* in = (const float* const*)d_in;
    p.x = in[0]; p.c = in[1]; p.ctx = in[2]; p.c_ctx = in[3]; p.ada_w = in[4]; p.ada_b = in[5]; p.norm1_g = in[6]; p.w_in = in[7]; p.q_norm_g = in[8]; p.k_norm_g = in[9];
    p.conv_w = in[10]; p.conv_b = in[11]; p.lru_wa = in[12]; p.lru_ba = in[13]; p.lru_wx = in[14]; p.lru_bx = in[15]; p.lru_lambda = in[16]; p.attn_out_g = in[17];
    p.lru_out_g = in[18]; p.w_out = in[19]; p.norm2_g = in[20]; p.router_w = in[21]; p.router_b = in[22]; p.w_gate = in[23]; p.w_up = in[24]; p.w_down = in[25]; p.final_g = in[26];
    p.out = (float*)d_out;
    char* ws = (char*)d_ws; size_t off = 0;
    auto carve = [&](size_t bytes) { void* r = ws + off; off += (bytes + 255) & ~(size_t)255; return r; };
    p.bar = (unsigned*)carve(XCD_BAR_WORDS * 4);
    p.cnt = (int*)carve(32 * 4);
    const size_t ctl_bytes = off;
    p.mod = (float*)carve((size_t)2 * 9 * 6144 * 4);
    p.tokw = (float*)carve((size_t)2 * TT * 4);
    p.list = (int*)carve((size_t)NE * TT * 4);
    p.wt_in = (bf16_t*)carve((size_t)2 * INW * D * 2);
    p.wt_out = (bf16_t*)carve((size_t)2 * D * D * 2);
    p.wt_gu = (bf16_t*)carve((size_t)NE * D * D * 2);
    p.wt_d = (bf16_t*)carve((size_t)NE * D * DE * 2);
    p.xres = (float*)carve((size_t)TT * D * 4);
    p.xn = (bf16_t*)carve((size_t)TT * D * 2);
    p.lb = (float*)p.xn;
    p.hid = (bf16_t*)carve((size_t)MAXPANELS * 256 * DE * 2);
    p.la = (float*)p.hid;
    p.q = (bf16_t*)carve((size_t)TT * 512 * 2);
    p.y = p.q;
    p.k = (bf16_t*)carve((size_t)TT * 128 * 2);
    p.v = (bf16_t*)carve((size_t)TT * 128 * 2);
    p.u = (bf16_t*)carve((size_t)TT * 512 * 2);
    p.gb = (bf16_t*)carve((size_t)TT * 512 * 2);
    p.hdir = (bf16_t*)carve((size_t)2 * TT * 512 * 2);
    if (off > ws_size) { fprintf(stderr, "workspace too small: need %zu have %zu\n", off, ws_size); return; }
    static int grid_blocks = 0;
    if (!grid_blocks) {
        int dev = 0, cus = 0;
        (void)hipGetDevice(&dev);
        (void)hipDeviceGetAttribute(&cus, hipDeviceAttributeMultiprocessorCount, dev);
        if (hipFuncSetAttribute((const void*)fwd_megakernel, hipFuncAttributeMaxDynamicSharedMemorySize, LDS_BYTES) != hipSuccess) { fprintf(stderr, "hipFuncSetAttribute failed\n"); grid_blocks = -1; return; }
        grid_blocks = cus > 0 ? cus : 256;
    }
    if (grid_blocks < 0) return;
    (void)hipMemsetAsync(ws, 0, ctl_bytes, stream);
    hipLaunchKernelGGL(fwd_megakernel, dim3(grid_blocks), dim3(NTHR), LDS_BYTES, stream, p);
}
```

```cpp
#include <hip/hip_runtime.h>
#include <stdint.h>
#include <cstdio>

#define DEV __device__ __forceinline__
#define LAS __attribute__((address_space(3)))
typedef unsigned short bf16_t;
typedef short bf16x8 __attribute__((ext_vector_type(8)));
typedef float f32x4 __attribute__((ext_vector_type(4)));
typedef unsigned u32x4 __attribute__((ext_vector_type(4)));
typedef unsigned u32x2 __attribute__((ext_vector_type(2)));
typedef int i32x2 __attribute__((ext_vector_type(2)));

constexpr int D = 1024, NB = 8, S = 2048, CL = 256, TL = NB * S, TC = NB * CL, TT = TL + TC, KVS = CL + S;
constexpr int INW = 1792, NE = 16, DE = 512;
constexpr float EPS = 1e-6f;
constexpr int NTHR = 512;
constexpr int RING_BYTES = 131072, MISC_OFF = RING_BYTES, LDS_BYTES = 147456;
constexpr int MAXPANELS = 2 * TT / 256 + NE;
constexpr int MISC_ROPE = 64, MISC_PTAB = 64 + 8192;

DEV float bf2f(bf16_t v) { return __uint_as_float(((unsigned)v) << 16); }
DEV unsigned f2bf(float f) { unsigned u = __float_as_uint(f); return (u + 0x7fffu + ((u >> 16) & 1u)) >> 16; }
DEV float bflo(unsigned w) { return __uint_as_float(w << 16); }
DEV float bfhi(unsigned w) { return __uint_as_float(w & 0xffff0000u); }
DEV unsigned pack2(float lo, float hi) { return f2bf(lo) | (f2bf(hi) << 16); }
DEV float wave_sum(float v) {
#pragma unroll
    for (int o = 32; o > 0; o >>= 1) v += __shfl_xor(v, o);
    return v;
}
DEV float sigmoidf_(float x) { return 1.f / (1.f + __expf(-x)); }
DEV float gelu_tanh(float x) {
    const float u = 0.7978845608028654f * (x + 0.044715f * x * x * x);
    const float e = __expf(2.f * u);
    const float th = 1.f - 2.f / (e + 1.f);
    return 0.5f * x * (1.f + th);
}
constexpr float attn_body_C2 = 0.125f * 1.4426950408889634f;
DEV int otid() { int t = threadIdx.x; asm volatile("" : "+v"(t)); return t; }
DEV int mod_row(int t) { return t < TL ? (t >> 11) : 8; }
DEV int kv_row(int t) { return t < TL ? (t >> 11) * KVS + CL + (t & 2047) : ((t - TL) >> 8) * KVS + ((t - TL) & 255); }

struct P {
    const float *x, *c, *ctx, *c_ctx, *ada_w, *ada_b, *norm1_g, *w_in, *q_norm_g, *k_norm_g, *conv_w, *conv_b, *lru_wa, *lru_ba, *lru_wx, *lru_bx,
        *lru_lambda, *attn_out_g, *lru_out_g, *w_out, *norm2_g, *router_w, *router_b, *w_gate, *w_up, *w_down, *final_g;
    float* out;
    float *mod, *xres, *tokw;
    bf16_t *xn, *q, *k, *v, *u, *gb, *hdir, *hid, *y;
    bf16_t *wt_in, *wt_out, *wt_gu, *wt_d;
    int *cnt, *list, *qctr;
    unsigned* bar;
};

#define XB_TMO      128
#define XB_XCNT(j)  (256  + 64 * (j))
#define XB_XSUB(j)  (1280 + 64 * (j))
#define XB_XGEN(j)  (2304 + 64 * (j))
#define XB_TOP      3328
#define XB_TOPGEN   3392
#define XCD_BAR_WORDS 3456
#define XB_SPIN_CAP (1u << 20)
DEV unsigned xb_ld(unsigned* p) { return __hip_atomic_load(p, __ATOMIC_RELAXED, __HIP_MEMORY_SCOPE_AGENT); }
DEV unsigned xb_add(unsigned* p, unsigned v) { return __hip_atomic_fetch_add(p, v, __ATOMIC_RELAXED, __HIP_MEMORY_SCOPE_AGENT); }
DEV unsigned xb_xcc_id() { return (unsigned)__builtin_amdgcn_s_getreg((3 << 11) | 20) & 0xFu; }
#define XB_SPIN(cond, bar) do { unsigned _sp = 0; while (cond) { __builtin_amdgcn_s_sleep(1); \
    if ((++_sp & 255u) == 0u) { if (xb_ld(&(bar)[XB_TMO])) break; if (_sp > XB_SPIN_CAP) { atomicAdd(&(bar)[XB_TMO], 1u); break; } } } } while (0)
struct XcdBarrier { unsigned* bar; unsigned x; volatile LAS unsigned* st; };
DEV XcdBarrier xcd_barrier_post(unsigned* bar, volatile LAS unsigned* st) {
    XcdBarrier b; b.bar = bar; b.x = xb_xcc_id(); b.st = st;
    if (threadIdx.x == 0) { (void)xb_add(&bar[XB_XCNT(b.x)], 1u); st[2] = b.x; }
    return b;
}
DEV void xcd_barrier_complete(unsigned* bar, unsigned x, unsigned& nloc, unsigned& nx) {
    const unsigned G = gridDim.x * gridDim.y * gridDim.z;
    unsigned sum, cnt, mine, sp = 0u;
    for (;;) {
        sum = 0u; cnt = 0u; mine = 0u;
#pragma unroll
        for (unsigned j = 0; j < 16; ++j) { const unsigned c = xb_ld(&bar[XB_XCNT(j)]); sum += c; cnt += (c > 0u) ? 1u : 0u; mine = (j == x) ? c : mine; }
        if (sum == G) break;
        __builtin_amdgcn_s_sleep(1);
        if ((++sp & 255u) == 0u) { if (xb_ld(&bar[XB_TMO])) break; if (sp > XB_SPIN_CAP) { atomicAdd(&bar[XB_TMO], 1u); break; } }
    }
    nloc = mine > 0u ? mine : 1u; nx = cnt > 0u ? cnt : 1u;
}
DEV void xcd_barrier(const XcdBarrier& b) {
    asm volatile("s_waitcnt vmcnt(0)" ::: "memory");
    __syncthreads();
    if (threadIdx.x == 0) {
        unsigned* bar = b.bar;
        __builtin_amdgcn_s_waitcnt(0);
        unsigned nloc = b.st[0], nx = b.st[1]; const unsigned bx = b.st[2];
        if (nloc == 0u) { xcd_barrier_complete(bar, bx, nloc, nx); b.st[0] = nloc; b.st[1] = nx; }
        const unsigned old = xb_add(&bar[XB_XSUB(bx)], 1u);
        const unsigned gen = old / nloc;
        if (old + 1u == (gen + 1u) * nloc) {
            __builtin_amdgcn_fence(__ATOMIC_RELEASE, "agent");
            asm volatile("s_waitcnt vmcnt(0)" ::: "memory");
            const unsigned og = xb_add(&bar[XB_TOP], 1u);
            const unsigned tg = og / nx;
            if (og + 1u == (tg + 1u) * nx) xb_add(&bar[XB_TOPGEN], 1u);
            else XB_SPIN(xb_ld(&bar[XB_TOPGEN]) == tg, bar);
            __builtin_amdgcn_fence(__ATOMIC_ACQUIRE, "agent");
            xb_add(&bar[XB_XGEN(bx)], 1u);
            asm volatile("s_waitcnt vmcnt(0)" ::: "memory");
        } else {
            XB_SPIN(xb_ld(&bar[XB_XGEN(bx)]) == gen, bar);
            __builtin_amdgcn_fence(__ATOMIC_ACQUIRE, "agent");
            asm volatile("s_waitcnt vmcnt(0)" ::: "memory");
        }
    }
    __syncthreads();
}

namespace pg8 {
constexpr int BM = 256, BK = 64, HALF = 128, HTB = HALF * BK * 2, STAGE_BYTES = 8 * HTB;
DEV int lds_byte(int r, int c) { const int st = (r >> 4) * 2 + (c >> 5), rr = r & 15, cc = c & 31, ob = rr * 64 + cc * 2; return st * 1024 + (ob ^ (((ob >> 9) & 1) << 5)); }
DEV void stage_rc(int b, int& R, int& C) { const int st = b / 1024, sb = b % 1024, swz = sb ^ (((sb >> 9) & 1) << 5); R = (st >> 1) * 16 + swz / 64; C = (st & 1) * 32 + (swz % 64) / 2; }
DEV int perm32(int rho) { const int n = rho >> 4, i = rho & 15; return 8 * (i >> 2) + 4 * n + (i & 3); }
struct Unit { int pm, pn; };

template <class Epi, class G, class Sched, bool ALIGN_EPI>
DEV void gemm_phase(LAS unsigned char* lds, const G& g, const Sched& S, const Epi& E, const int tid) {
    const int wid = __builtin_amdgcn_readfirstlane(tid >> 6), lane = tid & 63, wr = wid >> 2, wc = wid & 3, fr = lane & 15, fq = lane >> 4;
    const int K = g.K, nt = K / BK;
    int sR[2], sC[2]; unsigned voffB[2];
#pragma unroll
    for (int i = 0; i < 2; ++i) { stage_rc(tid * 16 + i * 8192, sR[i], sC[i]); const int Rb = Epi::PERM ? ((sR[i] & ~31) + perm32(sR[i] & 31)) : sR[i];
        voffB[i] = (unsigned)(Rb * K + sC[i]) * 2u; }
    const size_t kstep = (size_t)(BK * 2);
    const size_t hstep = (size_t)HALF * K * 2;
    const unsigned ldsw = (unsigned)wid * 1024u;
    const int aoff = lds_byte(wr * 64 + fr, fq * 8), boff = lds_byte(wc * 32 + fr, fq * 8);
#define PG8_SA(b, h) (((b) * 2 + (h)) * HTB)
#define PG8_SB(b, h) ((4 + (b) * 2 + (h)) * HTB)
#define PG8_STAGE(bufoff, gbase, voff) do { _Pragma("unroll") for (int _i = 0; _i < 2; ++_i) \
        __builtin_amdgcn_global_load_lds((const unsigned*)((const char*)(gbase) + (voff)[_i]), (LAS unsigned*)(lds + (bufoff) + ldsw + _i * 8192), 16, 0, 0); } while (0)
#define PG8_LDA(dst, b, h) do { _Pragma("unroll") for (int m = 0; m < 4; ++m) _Pragma("unroll") for (int k = 0; k < 2; ++k) dst[m][k] = *(const LAS bf16x8*)(lds + PG8_SA(b, h) + aoff + m * 2048 + k * 1024); } while (0)
#define PG8_LDB(dst, b, h) do { _Pragma("unroll") for (int n = 0; n < 2; ++n) _Pragma("unroll") for (int k = 0; k < 2; ++k) dst[n][k] = *(const LAS bf16x8*)(lds + PG8_SB(b, h) + boff + n * 2048 + k * 1024); } while (0)
#define PG8_MMA(ai, bj, At, Bt) do { __builtin_amdgcn_s_setprio(1); _Pragma("unroll") for (int m = 0; m < 4; ++m) _Pragma("unroll") for (int n = 0; n < 2; ++n) _Pragma("unroll") for (int k = 0; k < 2; ++k) \
        acc[ai][bj][m][n] = __builtin_amdgcn_mfma_f32_16x16x32_bf16(Bt[n][k], At[m][k], acc[ai][bj][m][n], 0, 0, 0); __builtin_amdgcn_s_setprio(0); } while (0)
#define PG8_WAIT_V(n) asm volatile("s_waitcnt vmcnt(" #n ")" ::: "memory")
#define PG8_WAIT_L(n) asm volatile("s_waitcnt lgkmcnt(" #n ")" ::: "memory")
#define PG8_BAR __builtin_amdgcn_s_barrier()
#define PG8_SCHED __builtin_amdgcn_sched_barrier(0)
    Unit cur, nxt; int ui = 0;
    if (!S.next(0, cur)) return;
    f32x4 acc[2][2][4][2];
#pragma unroll
    for (int a = 0; a < 2; ++a)
#pragma unroll
        for (int b = 0; b < 2; ++b)
#pragma unroll
            for (int m = 0; m < 4; ++m)
#pragma unroll
                for (int n = 0; n < 2; ++n) acc[a][b][m][n] = (f32x4){0.f, 0.f, 0.f, 0.f};
    bf16x8 At[4][2], B0[2][2], B1[2][2];
    unsigned oc[2][2], on[2][2];
#pragma unroll
    for (int h = 0; h < 2; ++h)
#pragma unroll
        for (int i = 0; i < 2; ++i) oc[h][i] = g.a_off(cur, h, sR[i], sC[i]);
    const char* cA = g.a_base(cur); const char* cB = g.b_base(cur);
    PG8_STAGE(PG8_SB(0, 0), cB, voffB); PG8_STAGE(PG8_SB(0, 1), cB + hstep, voffB); PG8_STAGE(PG8_SA(0, 0), cA, oc[0]); PG8_STAGE(PG8_SA(0, 1), cA, oc[1]);
    if (wr == 1) PG8_BAR;
    PG8_WAIT_V(2); PG8_BAR;
    PG8_STAGE(PG8_SB(1, 0), cB + kstep, voffB); PG8_STAGE(PG8_SA(1, 0), cA + kstep, oc[0]); PG8_STAGE(PG8_SB(1, 1), cB + hstep + kstep, voffB);
    PG8_WAIT_V(6); PG8_BAR;
    for (;;) {
        const bool has_next = S.next(ui + 1, nxt);
#pragma unroll
        for (int h = 0; h < 2; ++h)
#pragma unroll
            for (int i = 0; i < 2; ++i) on[h][i] = has_next ? g.a_off(nxt, h, sR[i], sC[i]) : oc[h][i];
        const char* nA = has_next ? g.a_base(nxt) : cA; const char* nB = has_next ? g.b_base(nxt) : cB;
        for (int t = 0; t < nt; t += 2) {
            const bool last = (t == nt - 2);
            const char* a1 = cA + (size_t)(t + 1) * kstep;
            const char* a2 = last ? nA : cA + (size_t)(t + 2) * kstep; const char* b2 = last ? nB : cB + (size_t)(t + 2) * kstep;
            const char* a3 = a2 + kstep; const char* b3 = b2 + kstep;
            unsigned o2[2][2];
#pragma unroll
            for (int h = 0; h < 2; ++h)
#pragma unroll
                for (int i = 0; i < 2; ++i) o2[h][i] = last ? on[h][i] : oc[h][i];
            PG8_LDB(B0, 0, 0); PG8_LDB(B1, 0, 1); PG8_SCHED; PG8_LDA(At, 0, 0); PG8_STAGE(PG8_SA(1, 1), a1, oc[1]);
            PG8_WAIT_V(8); PG8_WAIT_L(0); PG8_BAR; PG8_MMA(0, 0, At, B0); PG8_MMA(0, 1, At, B1); PG8_BAR; PG8_SCHED;
            PG8_LDA(At, 0, 1); PG8_STAGE(PG8_SB(0, 0), b2, voffB); PG8_STAGE(PG8_SB(0, 1), b2 + hstep, voffB); PG8_STAGE(PG8_SA(0, 0), a2, o2[0]);
            PG8_WAIT_V(8); PG8_WAIT_L(0); PG8_BAR; PG8_MMA(1, 0, At, B0); PG8_MMA(1, 1, At, B1); PG8_BAR; PG8_SCHED;
            PG8_LDB(B0, 1, 0); PG8_LDB(B1, 1, 1); PG8_SCHED; PG8_LDA(At, 1, 0); PG8_STAGE(PG8_SA(0, 1), a2, o2[1]);
            PG8_WAIT_V(8); PG8_WAIT_L(0); PG8_BAR; PG8_MMA(0, 0, At, B0); PG8_MMA(0, 1, At, B1); PG8_BAR; PG8_SCHED;
            PG8_LDA(At, 1, 1); PG8_STAGE(PG8_SB(1, 0), b3, voffB); PG8_STAGE(PG8_SB(1, 1), b3 + hstep, voffB); PG8_STAGE(PG8_SA(1, 0), a3, o2[0]);
            PG8_WAIT_V(8); PG8_WAIT_L(0); PG8_BAR; PG8_MMA(1, 0, At, B0); PG8_MMA(1, 1, At, B1); PG8_BAR; PG8_SCHED;
        }
        if (ALIGN_EPI) { if (wr == 0) PG8_BAR; }
        E(acc, cur, wr, wc, fr, fq);
        if (!has_next) break;
#pragma unroll
        for (int a = 0; a < 2; ++a)
#pragma unroll
            for (int b = 0; b < 2; ++b)
#pragma unroll
                for (int m = 0; m < 4; ++m)
#pragma unroll
                    for (int n = 0; n < 2; ++n) acc[a][b][m][n] = (f32x4){0.f, 0.f, 0.f, 0.f};
        cur = nxt; cA = nA; cB = nB; ++ui;
#pragma unroll
        for (int h = 0; h < 2; ++h)
#pragma unroll
            for (int i = 0; i < 2; ++i) oc[h][i] = on[h][i];
        if (ALIGN_EPI) { if (wr == 1) PG8_BAR; }
    }
    PG8_WAIT_V(0);
    if (!ALIGN_EPI) { if (wr == 0) PG8_BAR; }
    PG8_BAR;
#undef PG8_SA
#undef PG8_SB
#undef PG8_STAGE
#undef PG8_LDA
#undef PG8_LDB
#undef PG8_MMA
#undef PG8_WAIT_V
#undef PG8_WAIT_L
#undef PG8_BAR
#undef PG8_SCHED
}

struct GemmPlain {
    const bf16_t* A; const bf16_t* Bt; int K;
    DEV const char* a_base(const Unit& u) const { return (const char*)A + (size_t)u.pm * (256 * K * 2); }
    DEV const char* b_base(const Unit& u) const { return (const char*)Bt + (size_t)u.pn * (256 * K * 2); }
    DEV unsigned a_off(const Unit&, int h, int R, int C) const { return (unsigned)((h * 128 + R) * K + C) * 2u; }
};
struct RowMajorOrder {
    int nN, nunits, G, c;
    DEV bool next(int i, Unit& u) const { const int L = i * G + c; if (L >= nunits) return false; u.pm = L / nN; u.pn = L - u.pm * nN; return true; }
};
}

template <class RowMap>
DEV void transpose_item(const float* W, int K, int N, bf16_t* WT, LAS float* scr, int item, int lane, const RowMap& rm) {
    const int nblk = N / 32, kb = item / nblk, nbk = item % nblk, k0 = 64 * kb, n0 = 32 * nbk;
#pragma unroll 8
    for (int i = 0; i < 32; ++i) { const int kk = 2 * i + (lane >> 5); scr[kk * 33 + (lane & 31)] = W[(size_t)(k0 + kk) * N + n0 + (lane & 31)]; }
    asm volatile("s_waitcnt lgkmcnt(0)" ::: "memory");
    const int c = lane & 7;
#pragma unroll
    for (int j = 0; j < 4; ++j) { const int n = (lane >> 3) + 8 * j; const LAS float* s = scr + (8 * c) * 33 + n;
        u32x4 o; o.x = pack2(s[0 * 33], s[1 * 33]); o.y = pack2(s[2 * 33], s[3 * 33]); o.z = pack2(s[4 * 33], s[5 * 33]); o.w = pack2(s[6 * 33], s[7 * 33]);
        *(u32x4*)(WT + (size_t)rm(n0 + n) * K + k0 + 8 * c) = o; }
    asm volatile("s_waitcnt lgkmcnt(0)" ::: "memory");
}
struct MapId { DEV int operator()(int n) const { return n; } };
struct MapIn { DEV int operator()(int n) const { return (n & ~255) | ((n & 32) << 2) | ((n & 192) >> 1) | (n & 31); } };
template <int NSEL> struct MapGU { DEV int operator()(int h) const { return ((h >> 7) << 8) | (((h >> 6) & 1) << 7) | (((h >> 4) & 3) << 5) | (((h >> 2) & 3) << 3) | (NSEL << 2) | (h & 3); } };

constexpr int IT_IN = (D / 64) * (INW / 32), IT_OUT = (D / 64) * (D / 32), IT_G = (D / 64) * (DE / 32), IT_D = (DE / 64) * (D / 32), IT_EXP = 2 * IT_G + IT_D;
DEV void convert_experts(const P& p, int l, int gw, int ngw, LAS float* scr, int lane) {
    for (int it = gw; it < NE * IT_EXP; it += ngw) {
        const int e = it / IT_EXP; int r = it - e * IT_EXP;
        const size_t le = (size_t)(l * NE + e);
        if (r < IT_G) { transpose_item(p.w_gate + le * D * DE, D, DE, p.wt_gu + (size_t)e * D * D, scr, r, lane, MapGU<0>()); continue; } r -= IT_G;
        if (r < IT_G) { transpose_item(p.w_up + le * D * DE, D, DE, p.wt_gu + (size_t)e * D * D, scr, r, lane, MapGU<1>()); continue; } r -= IT_G;
        transpose_item(p.w_down + le * DE * D, DE, D, p.wt_d + (size_t)e * D * DE, scr, r, lane, MapId());
    }
}
DEV void phase_prologue(const P& p, int bid, int nb, LAS unsigned char* lds) {
    const int tid = otid(), lane = tid & 63, wv = tid >> 6;
    {
        LAS float* sil = (LAS float*)lds;
        LAS float* red = (LAS float*)(lds + 9 * 1024 * 4);
        bool have = false;
        for (int w = bid; w < 2 * 96; w += nb) {
            if (!have) {
                for (int i = tid; i < 9 * 1024; i += NTHR) { const int r = i >> 10, d = i & 1023; const float v = r < 8 ? p.c[r * 1024 + d] : p.c_ctx[d]; sil[i] = v * sigmoidf_(v); }
                have = true;
            }
            __syncthreads();
            const int l = w / 96, col0 = (w % 96) * 64, kq = tid >> 4, c4 = (tid & 15) * 4;
            const float* wp = p.ada_w + (size_t)l * 1024 * 6144 + col0 + c4;
            float acc[9][4];
#pragma unroll
            for (int r = 0; r < 9; ++r)
#pragma unroll
                for (int j = 0; j < 4; ++j) acc[r][j] = 0.f;
#pragma unroll 4
            for (int i = 0; i < 32; ++i) {
                const int k = kq + 32 * i;
                const float4 w4 = *(const float4*)(wp + (size_t)k * 6144);
#pragma unroll
                for (int r = 0; r < 9; ++r) { const float sv = sil[r * 1024 + k]; acc[r][0] += sv * w4.x; acc[r][1] += sv * w4.y; acc[r][2] += sv * w4.z; acc[r][3] += sv * w4.w; }
            }
#pragma unroll
            for (int r = 0; r < 9; ++r)
#pragma unroll
                for (int j = 0; j < 4; ++j) red[(kq * 64 + c4 + j) * 9 + r] = acc[r][j];
            __syncthreads();
            for (int o = tid; o < 64 * 9; o += NTHR) {
                const int cc = o / 9, r = o - cc * 9; float s = 0.f;
#pragma unroll 8
                for (int g = 0; g < 32; ++g) s += red[(g * 64 + cc) * 9 + r];
                p.mod[(size_t)(l * 9 + r) * 6144 + col0 + cc] = s + p.ada_b[l * 6144 + col0 + cc];
            }
        }
        __syncthreads();
    }
    {
        LAS float* scr = (LAS float*)(lds + wv * 16384);
        const int gw = bid * 8 + wv, ngw = nb * 8;
        for (int it = gw; it < 2 * (IT_IN + IT_OUT); it += ngw) {
            const int l = it / (IT_IN + IT_OUT); int r = it - l * (IT_IN + IT_OUT);
            if (r < IT_IN) transpose_item(p.w_in + (size_t)l * D * INW, D, INW, p.wt_in + (size_t)l * INW * D, scr, r, lane, MapIn());
            else transpose_item(p.w_out + (size_t)l * D * D, D, D, p.wt_out + (size_t)l * D * D, scr, r - IT_IN, lane, MapId());
        }
        convert_experts(p, 0, gw, ngw, scr, lane);
    }
}

template <int MODE>
DEV void phase_rowA(const P& p, int l, int bid, int nb) {
    const int tid = otid(), lane = tid & 63, wv = tid >> 6;
    const int nrows = (MODE == 2) ? TL : TT;
    for (int t = bid * 8 + wv; t < nrows; t += nb * 8) {
        const int mr = mod_row(t);
        float xv[16];
        if (MODE == 0) {
            const float* src = t < TL ? p.x + (size_t)t * D : p.ctx + (size_t)(t - TL) * D;
#pragma unroll
            for (int i = 0; i < 4; ++i) { const float4 v4 = *(const float4*)(src + i * 256 + lane * 4); xv[i * 4] = v4.x; xv[i * 4 + 1] = v4.y; xv[i * 4 + 2] = v4.z; xv[i * 4 + 3] = v4.w; }
        } else {
            const int lp = (MODE == 2) ? 1 : 0;
            const float* src = p.xres + (size_t)t * D;
            const float* g2 = p.mod + (size_t)(lp * 9 + mr) * 6144 + 5 * 1024;
            const bf16_t* y0 = p.y + (size_t)(2 * t) * D; const bf16_t* y1 = y0 + D;
#pragma unroll
            for (int i = 0; i < 4; ++i) {
                const int c0 = i * 256 + lane * 4;
                const float4 v4 = *(const float4*)(src + c0); const float4 g4 = *(const float4*)(g2 + c0);
                const uint2 a = *(const uint2*)(y0 + c0), b = *(const uint2*)(y1 + c0);
                xv[i * 4] = v4.x + g4.x * (bflo(a.x) + bflo(b.x)); xv[i * 4 + 1] = v4.y + g4.y * (bfhi(a.x) + bfhi(b.x));
                xv[i * 4 + 2] = v4.z + g4.z * (bflo(a.y) + bflo(b.y)); xv[i * 4 + 3] = v4.w + g4.w * (bfhi(a.y) + bfhi(b.y));
            }
            if (MODE == 1) {
#pragma unroll
                for (int i = 0; i < 4; ++i) *(float4*)(p.xres + (size_t)t * D + i * 256 + lane * 4) = make_float4(xv[i * 4], xv[i * 4 + 1], xv[i * 4 + 2], xv[i * 4 + 3]);
            }
        }
        float ss = 0.f;
#pragma unroll
        for (int i = 0; i < 16; ++i) ss += xv[i] * xv[i];
        ss = wave_sum(ss);
        const float rstd = rsqrtf(ss * (1.f / D) + EPS);
        if (MODE == 2) {
#pragma unroll
            for (int i = 0; i < 4; ++i) {
                const int c0 = i * 256 + lane * 4; const float4 g4 = *(const float4*)(p.final_g + c0);
                *(float4*)(p.out + (size_t)t * D + c0) = make_float4(xv[i * 4] * rstd * g4.x, xv[i * 4 + 1] * rstd * g4.y, xv[i * 4 + 2] * rstd * g4.z, xv[i * 4 + 3] * rstd * g4.w);
            }
        } else {
            const float* ng = p.norm1_g + l * D; const float* mm = p.mod + (size_t)(l * 9 + mr) * 6144;
#pragma unroll
            for (int i = 0; i < 4; ++i) {
                const int c0 = i * 256 + lane * 4;
                const float4 g4 = *(const float4*)(ng + c0), sh = *(const float4*)(mm + c0), sc = *(const float4*)(mm + 1024 + c0);
                const float o0 = xv[i * 4] * rstd * g4.x * (1.f + sc.x) + sh.x, o1 = xv[i * 4 + 1] * rstd * g4.y * (1.f + sc.y) + sh.y;
                const float o2 = xv[i * 4 + 2] * rstd * g4.z * (1.f + sc.z) + sh.z, o3 = xv[i * 4 + 3] * rstd * g4.w * (1.f + sc.w) + sh.w;
                *(uint2*)(p.xn + (size_t)t * D + c0) = make_uint2(pack2(o0, o1), pack2(o2, o3));
            }
        }
    }
}

struct EpiIn {
    static constexpr bool PERM = true;
    const P* pp; int l; const LAS float* rope;
    DEV void operator()(const f32x4 (&acc)[2][2][4][2], const pg8::Unit& u, int wr, int wc, int fr, int fq) const {
        const P& p = *pp;
        const int pn = u.pn;
        const bool lat = u.pm < TL / 256;
        const bool is_qk = (pn < 2) || (pn == 2 && wc < 2);
        const float qs = pn < 2 ? attn_body_C2 : 1.f;
        bf16_t* dst; int ld; bool kvmap = false;
        if (pn < 2) { dst = p.q + (pn * 4 + wc) * 64; ld = 512; }
        else if (pn == 2) { dst = (wc < 2 ? p.k + wc * 64 : p.v + (wc - 2) * 64); ld = 128; kvmap = true; }
        else if (pn < 5) { dst = p.u + (pn - 3) * 256 + wc * 64; ld = 512; }
        else { dst = p.gb + (pn - 5) * 256 + wc * 64; ld = 512; }
        float gq[2][2][4];
#pragma unroll
        for (int bj = 0; bj < 2; ++bj)
#pragma unroll
            for (int n = 0; n < 2; ++n)
#pragma unroll
                for (int j = 0; j < 4; ++j) gq[bj][n][j] = 1.f;
        if (is_qk) {
            const float* g = (pn < 2 ? p.q_norm_g : p.k_norm_g) + l * 64;
#pragma unroll
            for (int bj = 0; bj < 2; ++bj)
#pragma unroll
                for (int n = 0; n < 2; ++n) { const float4 g4 = *(const float4*)(g + 32 * bj + 8 * fq + 4 * n); gq[bj][n][0] = g4.x; gq[bj][n][1] = g4.y; gq[bj][n][2] = g4.z; gq[bj][n][3] = g4.w; }
        }
#pragma unroll
        for (int ai = 0; ai < 2; ++ai)
#pragma unroll
            for (int m = 0; m < 4; ++m) {
                const int t = u.pm * 256 + ai * 128 + wr * 64 + m * 16 + fr;
                float v[2][2][4];
#pragma unroll
                for (int bj = 0; bj < 2; ++bj)
#pragma unroll
                    for (int n = 0; n < 2; ++n)
#pragma unroll
                        for (int j = 0; j < 4; ++j) v[bj][n][j] = acc[ai][bj][m][n][j];
                if (is_qk) {
                    float ss = 0.f;
#pragma unroll
                    for (int bj = 0; bj < 2; ++bj)
#pragma unroll
                        for (int n = 0; n < 2; ++n)
#pragma unroll
                            for (int j = 0; j < 4; ++j) ss += v[bj][n][j] * v[bj][n][j];
                    ss += __shfl_xor(ss, 16); ss += __shfl_xor(ss, 32);
                    const float rstd = rsqrtf(ss * (1.f / 64.f) + EPS);
                    const int s = t & 2047;
#pragma unroll
                    for (int bj = 0; bj < 2; ++bj) {
                        const int pos = bj ? (s & 63) : (s >> 6);
#pragma unroll
                        for (int n = 0; n < 2; ++n) {
                            float cs4[4] = {1.f, 1.f, 1.f, 1.f}, sn4[4] = {0.f, 0.f, 0.f, 0.f};
                            if (lat) {
                                const int f0 = 8 * (fq & 1) + 4 * n;
                                const f32x4 c4 = *(const LAS f32x4*)(rope + pos * 16 + f0), s4 = *(const LAS f32x4*)(rope + 1024 + pos * 16 + f0);
                                cs4[0] = c4.x; cs4[1] = c4.y; cs4[2] = c4.z; cs4[3] = c4.w; sn4[0] = s4.x; sn4[1] = s4.y; sn4[2] = s4.z; sn4[3] = s4.w;
                            }
#pragma unroll
                            for (int j = 0; j < 4; ++j) {
                                const float w = v[bj][n][j] * gq[bj][n][j];
                                const float pw = __shfl_xor(w, 32);
                                const float o = (fq & 2) ? (w * cs4[j] + pw * sn4[j]) : (w * cs4[j] - pw * sn4[j]);
                                v[bj][n][j] = o * rstd * qs;
                            }
                        }
                    }
                }
                bf16_t* rowp = dst + (size_t)(kvmap ? kv_row(t) : t) * ld;
#pragma unroll
                for (int bj = 0; bj < 2; ++bj) {
                    u32x4 w; w.x = pack2(v[bj][0][0], v[bj][0][1]); w.y = pack2(v[bj][0][2], v[bj][0][3]); w.z = pack2(v[bj][1][0], v[bj][1][1]); w.w = pack2(v[bj][1][2], v[bj][1][3]);
                    *(u32x4*)(rowp + 32 * bj + 8 * fq) = w;
                }
            }
    }
};
struct EpiOut {
    static constexpr bool PERM = false;
    const P* pp; int l;
    DEV void operator()(const f32x4 (&acc)[2][2][4][2], const pg8::Unit& u, int wr, int wc, int fr, int fq) const {
        const P& p = *pp;
        const int col0 = u.pn * 256 + wc * 32 + 4 * fq;
        const int mr = u.pm < TL / 256 ? (u.pm >> 3) : 8;
        const float* g1 = p.mod + (size_t)(l * 9 + mr) * 6144 + 2048 + col0;
        f32x4 gv[2][2];
#pragma unroll
        for (int bj = 0; bj < 2; ++bj)
#pragma unroll
            for (int n = 0; n < 2; ++n) gv[bj][n] = *(const f32x4*)(g1 + bj * 128 + n * 16);
#pragma unroll
        for (int ai = 0; ai < 2; ++ai)
#pragma unroll
            for (int m = 0; m < 4; ++m) {
                const int t = u.pm * 256 + ai * 128 + wr * 64 + m * 16 + fr;
                const float* res = (l == 0) ? (t < TL ? p.x + (size_t)t * D : p.ctx + (size_t)(t - TL) * D) : p.xres + (size_t)t * D;
                float* o = p.xres + (size_t)t * D + col0;
#pragma unroll
                for (int bj = 0; bj < 2; ++bj)
#pragma unroll
                    for (int n = 0; n < 2; ++n) { const f32x4 r4 = *(const f32x4*)(res + col0 + bj * 128 + n * 16); *(f32x4*)(o + bj * 128 + n * 16) = r4 + gv[bj][n] * acc[ai][bj][m][n]; }
            }
    }
};
struct MoeUpDesc {
    const bf16_t* A; const bf16_t* Bt; int K; const LAS i32x2* ptab; const int* cnt; const int* list;
    DEV const char* a_base(const pg8::Unit&) const { return (const char*)A; }
    DEV const char* b_base(const pg8::Unit& u) const { const int e = ptab[u.pm].x; return (const char*)Bt + ((size_t)e * D + (size_t)u.pn * 256) * (D * 2); }
    DEV unsigned a_off(const pg8::Unit& u, int h, int R, int C) const {
        const i32x2 pe = ptab[u.pm]; const int pos = pe.y + h * 128 + R;
        const int tok = pos < cnt[pe.x] ? (list[pe.x * TT + pos] >> 1) : 0;
        return (unsigned)(tok * D + C) * 2u;
    }
};
struct MoeDownDesc {
    const bf16_t* A; const bf16_t* Bt; int K; const LAS i32x2* ptab;
    DEV const char* a_base(const pg8::Unit& u) const { return (const char*)A + (size_t)u.pm * (256 * DE * 2); }
    DEV const char* b_base(const pg8::Unit& u) const { const int e = ptab[u.pm].x; return (const char*)Bt + ((size_t)e * D + (size_t)u.pn * 256) * (DE * 2); }
    DEV unsigned a_off(const pg8::Unit&, int h, int R, int C) const { return (unsigned)((h * 128 + R) * DE + C) * 2u; }
};
struct EpiMoeUp {
    static constexpr bool PERM = true;
    bf16_t* hid;
    DEV void operator()(const f32x4 (&acc)[2][2][4][2], const pg8::Unit& u, int wr, int wc, int fr, int fq) const {
#pragma unroll
        for (int ai = 0; ai < 2; ++ai)
#pragma unroll
            for (int m = 0; m < 4; ++m) {
                bf16_t* rowp = hid + (size_t)(u.pm * 256 + ai * 128 + wr * 64 + m * 16 + fr) * DE + u.pn * 128 + wc * 16 + fq * 4;
#pragma unroll
                for (int bj = 0; bj < 2; ++bj) {
                    const f32x4 g = acc[ai][bj][m][0], up = acc[ai][bj][m][1];
                    float h[4];
#pragma unroll
                    for (int j = 0; j < 4; ++j) h[j] = g[j] * sigmoidf_(g[j]) * up[j];
                    *(u32x2*)(rowp + bj * 64) = (u32x2){pack2(h[0], h[1]), pack2(h[2], h[3])};
                }
            }
    }
};
struct EpiMoeDown {
    static constexpr bool PERM = true;
    bf16_t* y; const float* tokw; const LAS i32x2* ptab; const int* cnt; const int* list;
    DEV void operator()(const f32x4 (&acc)[2][2][4][2], const pg8::Unit& u, int wr, int wc, int fr, int fq) const {
        const i32x2 pe = ptab[u.pm]; const int ce = cnt[pe.x];
#pragma unroll
        for (int ai = 0; ai < 2; ++ai)
#pragma unroll
            for (int m = 0; m < 4; ++m) {
                const int pos = pe.y + ai * 128 + wr * 64 + m * 16 + fr;
                if (pos < ce) {
                    const int pair = list[pe.x * TT + pos]; const float wt = tokw[pair];
                    bf16_t* rowp = y + (size_t)pair * D + u.pn * 256 + wc * 32 + 8 * fq;
#pragma unroll
                    for (int bj = 0; bj < 2; ++bj) {
                        const f32x4 a0 = acc[ai][bj][m][0] * wt, a1 = acc[ai][bj][m][1] * wt;
                        *(u32x4*)(rowp + bj * 128) = (u32x4){pack2(a0[0], a0[1]), pack2(a0[2], a0[3]), pack2(a1[0], a1[1]), pack2(a1[2], a1[3])};
                    }
                }
            }
    }
};
DEV int moe_build_ptab(const int* cnt, LAS i32x2* ptab, int tid) {
    __syncthreads();
    if (tid < 64) {
        const int c = tid < NE ? cnt[tid] : 0;
        const int npan = (c + 255) >> 8;
        int incl = npan;
#pragma unroll
        for (int o = 1; o < 16; o <<= 1) { const int v = __shfl_up(incl, o); if (tid >= o) incl += v; }
        int base = incl - npan;
#pragma unroll 1
        for (int r0 = 0; r0 < c; r0 += 256) { ptab[base] = (i32x2){tid, r0}; ++base; }
        if (tid == NE - 1) ptab[MAXPANELS] = (i32x2){incl, 0};
    }
    __syncthreads();
    return ptab[MAXPANELS].x;
}

#include <hip/hip_bf16.h>
namespace attn_body {
using bf16=__hip_bfloat16;
using bf16x8=__attribute__((ext_vector_type(8)))short;
using s16x4=__attribute__((ext_vector_type(4)))short;
using f32x16=__attribute__((ext_vector_type(16)))float;
using u32x4=__attribute__((ext_vector_type(4)))unsigned;
constexpr int D=64,QP=512,KP=128;
constexpr int NW=8,QBLK=32,QB=QBLK*NW,KVBLK=64;
__device__ __forceinline__ int crow(int r,int hi){return (r&3)+8*(r>>2)+4*hi;}
#define SBAR() __builtin_amdgcn_sched_barrier(0)
constexpr int NSLOT=3, SLOTB=8192;
constexpr int LDS_K=0, LDS_V=NSLOT*SLOTB, LDS_WS=2*NSLOT*SLOTB, LDS_OST=LDS_WS+NW*64*4, LDS_BYTES=LDS_OST+NW*4096;
constexpr float C2=0.125f*1.4426950408889634f;
__device__ __forceinline__ void glds16(const void*gsrc,unsigned lds_dst){unsigned keep;
  asm volatile("s_mov_b32 %0, m0\n\ts_mov_b32 m0, %2\n\ts_nop 0\n\tglobal_load_lds_dwordx4 %1, off\n\ts_mov_b32 m0, %0":"=&s"(keep):"v"(gsrc),"s"(lds_dst):"memory");}
__device__ __forceinline__ float max3f(float a,float b,float c){float r;asm("v_max3_f32 %0, %1, %2, %3":"=v"(r):"v"(a),"v"(b),"v"(c));return r;}
__device__ __forceinline__ float max2f(float a,float b){float r;asm("v_max_f32_e32 %0, %1, %2":"=v"(r):"v"(a),"v"(b));return r;}
__device__ __forceinline__ float fadd_s(float a,float b){float r;asm("v_add_f32_e32 %0, %1, %2":"=v"(r):"v"(a),"v"(b));return r;}
__device__ __forceinline__ float fsub_s(float a,float b){float r;asm("v_sub_f32_e32 %0, %1, %2":"=v"(r):"v"(a),"v"(b));return r;}
typedef float f32x2_t __attribute__((ext_vector_type(2))); typedef __bf16 bf16x2_t __attribute__((ext_vector_type(2)));
__device__ __forceinline__ unsigned cvtpk_s(float lo,float hi){f32x2_t v={lo,hi};bf16x2_t b=__builtin_convertvector(v,bf16x2_t);return __builtin_bit_cast(unsigned,b);}
#define WAIT_BAR(N) asm volatile("s_waitcnt vmcnt(" #N ") lgkmcnt(0)\n\ts_barrier":::"memory")

__device__ __forceinline__ void qkt(f32x16&p0,f32x16&p1,const char*Kslot,const bf16x8*qr,const f32x16&negm,int r32,int hi){
  const char*kb=Kslot+hi*1024+r32*16;
  #pragma unroll
  for(int d0=0;d0<4;++d0){
    const bf16x8 b0=*reinterpret_cast<const bf16x8*>(kb+d0*2048);
    const bf16x8 b1=*reinterpret_cast<const bf16x8*>(kb+d0*2048+512);
    if(d0==0){p0=__builtin_amdgcn_mfma_f32_32x32x16_bf16(b0,qr[0],negm,0,0,0);p1=__builtin_amdgcn_mfma_f32_32x32x16_bf16(b1,qr[0],negm,0,0,0);}
    else{p0=__builtin_amdgcn_mfma_f32_32x32x16_bf16(b0,qr[d0],p0,0,0,0);p1=__builtin_amdgcn_mfma_f32_32x32x16_bf16(b1,qr[d0],p1,0,0,0);}}
}
typedef __attribute__((address_space(3))) const char* lds_cptr;
typedef short v4i16_t __attribute__((ext_vector_type(4)));
__device__ __forceinline__ void kload8(bf16x8*kf,lds_cptr kp){
  kf[0]=*(const __attribute__((address_space(3))) bf16x8*)(kp);      kf[1]=*(const __attribute__((address_space(3))) bf16x8*)(kp+512);
  kf[2]=*(const __attribute__((address_space(3))) bf16x8*)(kp+2048); kf[3]=*(const __attribute__((address_space(3))) bf16x8*)(kp+2560);
  kf[4]=*(const __attribute__((address_space(3))) bf16x8*)(kp+4096); kf[5]=*(const __attribute__((address_space(3))) bf16x8*)(kp+4608);
  kf[6]=*(const __attribute__((address_space(3))) bf16x8*)(kp+6144); kf[7]=*(const __attribute__((address_space(3))) bf16x8*)(kp+6656);
}
__device__ __forceinline__ void kload2(bf16x8*kf,lds_cptr kp,int j){ kf[2*j]=*(const __attribute__((address_space(3))) bf16x8*)(kp+j*2048); kf[2*j+1]=*(const __attribute__((address_space(3))) bf16x8*)(kp+j*2048+512); }
__device__ __forceinline__ s16x4 vtr(lds_cptr p){ return __builtin_bit_cast(s16x4,__builtin_amdgcn_ds_read_tr16_b64_v4i16((__attribute__((address_space(3))) v4i16_t*)p)); }
__device__ __forceinline__ float rowmax(const f32x16&p0,const f32x16&p1){
  float a=max3f(p0[0],p0[1],p1[0]),b=max3f(p0[2],p0[3],p1[1]);a=max3f(a,p1[2],p1[3]);
  #pragma unroll
  for(int r=4;r<16;r+=4){a=max3f(a,p0[r],p0[r+1]);b=max3f(b,p0[r+2],p0[r+3]);a=max3f(a,p1[r],p1[r+1]);b=max3f(b,p1[r+2],p1[r+3]);}
  const float m=max2f(a,b);
  auto rr=__builtin_amdgcn_permlane32_swap(__float_as_uint(m),__float_as_uint(m),false,false);
  return max2f(__uint_as_float(rr[0]),__uint_as_float(rr[1]));
}
__device__ __forceinline__ void pv(f32x16*o,int vb,bf16x8 pa0,bf16x8 pa1,bf16x8 pa2,bf16x8 pa3){
  #pragma unroll
  for(int d0=0;d0<2;++d0){s16x4 lo[4],hi[4];
    #pragma unroll
    for(int ks=0;ks<4;++ks){
      asm volatile("ds_read_b64_tr_b16 %0,%1 offset:%c2":"=&v"(lo[ks]):"v"(vb),"i"(d0*4096+ks*1024):"memory");
      asm volatile("ds_read_b64_tr_b16 %0,%1 offset:%c2":"=&v"(hi[ks]):"v"(vb),"i"(d0*4096+ks*1024+512):"memory");}
    asm volatile("s_waitcnt lgkmcnt(0)":::"memory");SBAR();
    #define PK(k) (bf16x8){lo[k][0],lo[k][1],lo[k][2],lo[k][3],hi[k][0],hi[k][1],hi[k][2],hi[k][3]}
    o[d0]=__builtin_amdgcn_mfma_f32_32x32x16_bf16(pa0,PK(0),o[d0],0,0,0);
    o[d0]=__builtin_amdgcn_mfma_f32_32x32x16_bf16(pa1,PK(1),o[d0],0,0,0);
    o[d0]=__builtin_amdgcn_mfma_f32_32x32x16_bf16(pa2,PK(2),o[d0],0,0,0);
    o[d0]=__builtin_amdgcn_mfma_f32_32x32x16_bf16(pa3,PK(3),o[d0],0,0,0);
    #undef PK
  }
}

#ifndef ATTN_STORE16
#define ATTN_STORE16(p,v) (*(u32x4*)(p)=(v))
#endif
template<int THRL> __device__ __forceinline__ void attn_unit(const bf16*Qu,const bf16*__restrict__ Kh,const bf16*__restrict__ Vh,bf16*Ou,const int NT,char*shm,const int tid){
  const int lane=tid&63,r32=lane&31,hi=lane>>5; const int wid=__builtin_amdgcn_readfirstlane(tid>>6);
  const bf16*Qw=Qu+(long)(wid*QBLK)*QP;
  const unsigned lds0=(unsigned)(uintptr_t)shm;
  float*wsf=(float*)(shm+LDS_WS)+wid*64;
  const bf16*ksrc=Kh+(long)lane*KP+wid*8;
  const bf16*vsrc=Vh+(long)(16*(wid&3)+(lane>>2))*KP+(wid>>2)*32+(lane&3)*8;
  const unsigned kdst=lds0+LDS_K+wid*1024, vdst=lds0+LDS_V+wid*1024;
  #define DMA_K(t,slot) glds16(ksrc+(long)(t)*KVBLK*KP,(unsigned)__builtin_amdgcn_readfirstlane(kdst+(slot)))
  #define DMA_V(t,slot) glds16(vsrc+(long)(t)*KVBLK*KP,(unsigned)__builtin_amdgcn_readfirstlane(vdst+(slot)))
  const int vb0=(int)(lds0+LDS_V)+((lane>>4)&1)*32+(lane&3)*8+(4*hi+((lane&15)>>2))*64;
  const char*Kbase=shm+LDS_K; bf16x8 kf[8];
  const lds_cptr shm3=(lds_cptr)shm; const lds_cptr kp0=shm3+LDS_K+hi*1024+r32*16; const lds_cptr vp0=shm3+LDS_V+((lane>>4)&1)*32+(lane&3)*8+(4*hi+((lane&15)>>2))*64;
  DMA_K(0,0);DMA_V(0,0);DMA_K(1,SLOTB);
  bf16x8 qr[4];
  #pragma unroll
  for(int d0=0;d0<4;++d0)qr[d0]=*reinterpret_cast<const bf16x8*>(&Qw[(long)r32*QP+d0*16+hi*8]);
  float mhat=0.f,l_reg=0.f;f32x16 o[2];o[0]=f32x16{};o[1]=f32x16{};f32x16 negm=f32x16{};asm volatile("":"+v"(negm));
  #define CMASK(P0,P1,t) do{}while(0)
  bool resc=false;
  #define START(P0,P1) do{ const float rm=rowmax(P0,P1); resc=false; \
    { const float dl=rm; mhat=fadd_s(mhat,dl); \
      _Pragma("unroll") for(int r=0;r<16;++r){P0[r]=fsub_s(P0[r],dl);P1[r]=fsub_s(P1[r],dl);} \
      _Pragma("unroll") for(int r=0;r<16;++r)negm[r]=-mhat; asm volatile("":"+v"(negm)); } \
    _Pragma("unroll") for(int r=0;r<16;++r)P0[r]=__builtin_amdgcn_exp2f(P0[r]); }while(0)
  #define RESC() do{ if(resc){ asm volatile("s_waitcnt lgkmcnt(0)":::"memory"); \
      _Pragma("unroll") for(int d_=0;d_<2;++d_) _Pragma("unroll") for(int r=0;r<16;++r)o[d_][r]*=wsf[crow(r,hi)]; } }while(0)
  f32x16 pA0,pA1,pB0,pB1;
  int sl_prev=0,sl_cur=0,sl_next=SLOTB;
  #define ROT() do{sl_prev=sl_cur;sl_cur=sl_next;sl_next=(sl_next==(NSLOT-1)*SLOTB)?0:sl_next+SLOTB;}while(0)
  DMA_K(2,2*SLOTB);
  WAIT_BAR(3);
  qkt(pA0,pA1,Kbase,qr,negm,r32,hi);asm volatile("s_nop 15\n\ts_nop 7":"+v"(pA0),"+v"(pA1));CMASK(pA0,pA1,0);
  START(pA0,pA1);
  _Pragma("unroll") for(int r=0;r<16;++r)pA1[r]=__builtin_amdgcn_exp2f(pA1[r]);
  WAIT_BAR(0);
  DMA_K(3,0);DMA_V(1,SLOTB);
  ROT();
  kload8(kf,kp0+sl_cur);
  WAIT_BAR(2);
  s16x4 vlo[8],vhi[8]; u32x4 pw0,pw1,pw2,pw3;
  #define PKW(P,B) cvtpk_s(P[B],P[B+1])
  #define PAF(k) __builtin_bit_cast(bf16x8,pw##k)
  #define VFR(i) (bf16x8){vlo[i][0],vlo[i][1],vlo[i][2],vlo[i][3],vhi[i][0],vhi[i][1],vhi[i][2],vhi[i][3]}
  #define PIN(x) asm volatile("":"+v"(x))
  #define MX3(a,b,c) __builtin_fmaxf(__builtin_fmaxf((a),(b)),(c))
  #define GAPA(MF,A0,A1,A2,A3,W0,W1,PW) do{ MF; sacc+=A0; sacc+=A1; sacc+=A2; sacc+=A3; PIN(sacc); W0; W1; PIN(PW); SBAR(); }while(0)
  #define EX(v) __builtin_amdgcn_exp2f(v)
  #define GAPB(MF,X,B) do{ MF; X[B]=EX(X[B]); X[B+1]=EX(X[B+1]); X[B+2]=EX(X[B+2]); X[B+3]=EX(X[B+3]); PIN(X); SBAR(); }while(0)
  #define VRD(i) do{ vlo[i]=vtr(vp_+(((i)>>2)*4096+((i)&3)*1024)); vhi[i]=vtr(vp_+(((i)>>2)*4096+((i)&3)*1024+512)); }while(0)
  #define KRD(G,j) do{ if(G){ kload2(kf,kp0+sl_next,j); SBAR(); } }while(0)
  #define STEP(C0,C1,P0,P1,t,GK,GV,GL) do{ SBAR(); \
    const lds_cptr vp_=vp0+sl_prev; \
    VRD(0); SBAR(); float sacc=(P0[0]+P0[1]); \
    GAPA(C0=__builtin_amdgcn_mfma_f32_32x32x16_bf16(kf[0],qr[0],negm,0,0,0), P0[2],P0[3],P0[4],P0[5],     pw0[0]=PKW(P0,0), pw0[1]=PKW(P0,2), pw0); \
    VRD(4); SBAR(); GAPA(C1=__builtin_amdgcn_mfma_f32_32x32x16_bf16(kf[1],qr[0],negm,0,0,0), P0[6],P0[7],P0[8],P0[9],     pw0[2]=PKW(P0,4), pw0[3]=PKW(P0,6), pw0); \
    VRD(1); SBAR(); GAPA(C0=__builtin_amdgcn_mfma_f32_32x32x16_bf16(kf[2],qr[1],C0,0,0,0),   P0[10],P0[11],P0[12],P0[13], pw1[0]=PKW(P0,8), pw1[1]=PKW(P0,10), pw1); \
    VRD(5); SBAR(); GAPA(C1=__builtin_amdgcn_mfma_f32_32x32x16_bf16(kf[3],qr[1],C1,0,0,0),   P0[14],P0[15],P1[0],P1[1],   pw1[2]=PKW(P0,12),pw1[3]=PKW(P0,14), pw1); \
    VRD(2); SBAR(); GAPA(C0=__builtin_amdgcn_mfma_f32_32x32x16_bf16(kf[4],qr[2],C0,0,0,0),   P1[2],P1[3],P1[4],P1[5],     pw2[0]=PKW(P1,0), pw2[1]=PKW(P1,2), pw2); \
    VRD(6); SBAR(); GAPA(C1=__builtin_amdgcn_mfma_f32_32x32x16_bf16(kf[5],qr[2],C1,0,0,0),   P1[6],P1[7],P1[8],P1[9],     pw2[2]=PKW(P1,4), pw2[3]=PKW(P1,6), pw2); \
    VRD(3); SBAR(); GAPA(C0=__builtin_amdgcn_mfma_f32_32x32x16_bf16(kf[6],qr[3],C0,0,0,0),   P1[10],P1[11],P1[12],P1[13], pw3[0]=PKW(P1,8), pw3[1]=PKW(P1,10), pw3); \
    VRD(7); SBAR(); GAPA(C1=__builtin_amdgcn_mfma_f32_32x32x16_bf16(kf[7],qr[3],C1,0,0,0),   P1[14],P1[15],0.f,0.f,       pw3[2]=PKW(P1,12),pw3[3]=PKW(P1,14), pw3); \
    l_reg+=sacc; \
    if(GK){DMA_K((t)+3,sl_cur);} if(GV){DMA_V((t)+1,sl_next);} \
    CMASK(C0,C1,t); \
    { float a=MX3(C0[0],C0[1],C1[0]),b=MX3(C0[2],C0[3],C1[1]); a=MX3(a,C1[2],C1[3]); \
      _Pragma("unroll") for(int r=4;r<16;r+=4){a=MX3(a,C0[r],C0[r+1]);b=MX3(b,C0[r+2],C0[r+3]);a=MX3(a,C1[r],C1[r+1]);b=MX3(b,C1[r+2],C1[r+3]);} \
      float rm=__builtin_fmaxf(a,b); { auto rr=__builtin_amdgcn_permlane32_swap(__float_as_uint(rm),__float_as_uint(rm),false,false); rm=__builtin_fmaxf(__uint_as_float(rr[0]),__uint_as_float(rr[1])); } \
      resc=false; \
      if(__builtin_expect(__any(rm>(float)THRL),0)){ const float dl=__builtin_fmaxf(rm,0.f); mhat+=dl; \
        _Pragma("unroll") for(int r=0;r<16;++r){C0[r]-=dl;C1[r]-=dl;} \
        _Pragma("unroll") for(int r=0;r<16;++r)negm[r]=-mhat; asm volatile("":"+v"(negm)); \
        const float f=__builtin_amdgcn_exp2f(-dl); l_reg*=f; if(hi==0)wsf[r32]=f; resc=true; } } \
    SBAR(); \
    GAPB(o[0]=__builtin_amdgcn_mfma_f32_32x32x16_bf16(PAF(0),VFR(0),o[0],0,0,0), C0,0); \
    GAPB(o[1]=__builtin_amdgcn_mfma_f32_32x32x16_bf16(PAF(0),VFR(4),o[1],0,0,0), C0,4); \
    KRD(GL,0); GAPB(o[0]=__builtin_amdgcn_mfma_f32_32x32x16_bf16(PAF(1),VFR(1),o[0],0,0,0), C0,8); \
    KRD(GL,1); GAPB(o[1]=__builtin_amdgcn_mfma_f32_32x32x16_bf16(PAF(1),VFR(5),o[1],0,0,0), C0,12); \
    KRD(GL,2); GAPB(o[0]=__builtin_amdgcn_mfma_f32_32x32x16_bf16(PAF(2),VFR(2),o[0],0,0,0), C1,0); \
    KRD(GL,3); GAPB(o[1]=__builtin_amdgcn_mfma_f32_32x32x16_bf16(PAF(2),VFR(6),o[1],0,0,0), C1,4); \
    GAPB(o[0]=__builtin_amdgcn_mfma_f32_32x32x16_bf16(PAF(3),VFR(3),o[0],0,0,0), C1,8); \
    GAPB(o[1]=__builtin_amdgcn_mfma_f32_32x32x16_bf16(PAF(3),VFR(7),o[1],0,0,0), C1,12); \
    }while(0)
  int t=1;
  #undef CMASK
  #define CMASK(P0,P1,t) do{}while(0)
  for(;t+5<NT;t+=2){
    STEP(pB0,pB1,pA0,pA1,t,true,true,true);     WAIT_BAR(2); RESC(); ROT();
    STEP(pA0,pA1,pB0,pB1,t+1,true,true,true);   WAIT_BAR(2); RESC(); ROT();
  }
  #undef CMASK
  #define CMASK(P0,P1,t) do{}while(0)
  #define ENDW(tt) do{ if((tt)+3<NT){WAIT_BAR(2);} else if((tt)+2<NT){WAIT_BAR(1);} else {WAIT_BAR(0);} }while(0)
  for(;t+1<NT;t+=2){
    STEP(pB0,pB1,pA0,pA1,t,(t+3<NT),(t+1<NT),(t+1<NT));       ENDW(t);   RESC(); ROT();
    STEP(pA0,pA1,pB0,pB1,t+1,(t+4<NT),(t+2<NT),(t+2<NT));     ENDW(t+1); RESC(); ROT();
  }
  STEP(pB0,pB1,pA0,pA1,NT-1,false,false,false); RESC();
  { float sacc=pB0[0]+pB0[1]; _Pragma("unroll") for(int r=2;r<16;++r)sacc+=pB0[r]; _Pragma("unroll") for(int r=0;r<16;++r)sacc+=pB1[r]; l_reg+=sacc;
    pw0=(u32x4){PKW(pB0,0),PKW(pB0,2),PKW(pB0,4),PKW(pB0,6)};pw1=(u32x4){PKW(pB0,8),PKW(pB0,10),PKW(pB0,12),PKW(pB0,14)};pw2=(u32x4){PKW(pB1,0),PKW(pB1,2),PKW(pB1,4),PKW(pB1,6)};pw3=(u32x4){PKW(pB1,8),PKW(pB1,10),PKW(pB1,12),PKW(pB1,14)};
    SBAR(); pv(o,vb0+sl_cur,PAF(0),PAF(1),PAF(2),PAF(3)); }
  #undef PKW
  #undef PAF
  #undef VFR
  #undef PIN
  #undef MX3
  #undef GAPA
  #undef GAPB
  #undef EX
  #undef VRD
  #undef KRD
  #undef STEP
  #undef ENDW
  {auto rr=__builtin_amdgcn_permlane32_swap(__float_as_uint(l_reg),__float_as_uint(l_reg),false,false);l_reg=__uint_as_float(rr[0])+__uint_as_float(rr[1]);}
  if(hi==0)wsf[32+r32]=l_reg;asm volatile("s_waitcnt lgkmcnt(0)":::"memory");
  float rli[16];
  #pragma unroll
  for(int r=0;r<16;++r)rli[r]=__builtin_amdgcn_rcpf(wsf[32+crow(r,hi)]);
  bf16*Ow=Ou+(long)(wid*QBLK)*QP;
  { bf16*stg=(bf16*)(shm+LDS_OST)+wid*2048;
    #pragma unroll
    for(int r=0;r<16;++r){const int orow=crow(r,hi);
      #pragma unroll
      for(int d0=0;d0<2;++d0)stg[orow*64+d0*32+r32]=__float2bfloat16(o[d0][r]*rli[r]);}
    asm volatile("s_waitcnt lgkmcnt(0)":::"memory");
    #pragma unroll
    for(int i=0;i<4;++i){const int row=i*8+(lane>>3),ch=lane&7; const u32x4 v=*(const u32x4*)(stg+row*64+ch*8); ATTN_STORE16(Ow+(long)row*QP+ch*8,v);} }
  asm volatile("s_waitcnt lgkmcnt(0)\n\ts_barrier":::"memory");
  #undef DMA_K
  #undef DMA_V
  #undef CMASK
  #undef START
  #undef RESC
  #undef ROT
}
constexpr int ATTN_LDS_BYTES=LDS_BYTES;
#undef SBAR
#undef WAIT_BAR
}

DEV void phase_attn(const P& p, int l, LAS unsigned char* lds, volatile LAS unsigned* misc, int tid) {
    const int nunits = (l == 0) ? 512 + 64 : 512;
    for (;;) {
        __syncthreads();
        if (tid == 0) misc[4] = (unsigned)atomicAdd(p.qctr + l, 1);
        __syncthreads();
        const int u = (int)misc[4];
        if (u >= nunits) break;
        int b, h, qrow0, nt;
        if (u < 512) { b = u >> 6; h = (u >> 3) & 7; qrow0 = b * S + (u & 7) * 256; nt = KVS / 64; }
        else { const int u2 = u - 512; b = u2 >> 3; h = u2 & 7; qrow0 = TL + b * CL; nt = CL / 64; }
        attn_body::bf16* qp = (attn_body::bf16*)(p.q + (size_t)qrow0 * 512 + h * 64);
        const attn_body::bf16* kp = (const attn_body::bf16*)(p.k + (size_t)b * KVS * 128 + (h >> 2) * 64);
        const attn_body::bf16* vp = (const attn_body::bf16*)(p.v + (size_t)b * KVS * 128 + (h >> 2) * 64);
        attn_body::attn_unit<8>(qp, kp, vp, qp, nt, (char*)lds, tid);
    }
}

constexpr int LRU_WT = 0, LRU_A = 16384, LRU_B = LRU_A + 32768, LRU_SEG = LRU_B + 32768  , LRU_CARRY = LRU_SEG + 8192  ,
              LRU_PAR = LRU_CARRY + 512  , LRU_WAVE = LRU_PAR + 2304, LRU_WAVE_BYTES = 2432 + 2304;
static_assert(LRU_WAVE + 8 * LRU_WAVE_BYTES <= RING_BYTES, "LRU LDS map");
DEV void lru_item(const P& p, int l, int b, int n, LAS unsigned char* lds, int tid) {
    const int lane = tid & 63, w = __builtin_amdgcn_readfirstlane(tid >> 6), q = lane & 15, cg = lane >> 4;
    LAS bf16_t* Wt = (LAS bf16_t*)(lds + LRU_WT);
    LAS float* Aa = (LAS float*)(lds + LRU_A);
    LAS float* Bb = (LAS float*)(lds + LRU_B);
    LAS float* seg = (LAS float*)(lds + LRU_SEG);
    LAS float* carry = (LAS float*)(lds + LRU_CARRY);
    LAS float* par = (LAS float*)(lds + LRU_PAR);
    LAS bf16_t* Uraw = (LAS bf16_t*)(lds + LRU_WAVE + w * LRU_WAVE_BYTES);
    LAS bf16_t* Ub = (LAS bf16_t*)(lds + LRU_WAVE + w * LRU_WAVE_BYTES + 2432);
    bf16_t* rec = p.hdir;
#pragma unroll 1
    for (int d = 0; d < 2; ++d) {
        __syncthreads();
        {
            const float* wa = p.lru_wa + ((size_t)((l * 2 + d) * 8 + n) * 64) * 64; const float* wx = p.lru_wx + ((size_t)((l * 2 + d) * 8 + n) * 64) * 64;
            for (int i = tid; i < 2 * 4096; i += NTHR) { const int g = i >> 12, k = (i >> 6) & 63, e = i & 63; Wt[(g * 64 + e) * 64 + ((((k >> 3) ^ (e & 7)) << 3) | (k & 7))] = (bf16_t)f2bf((g ? wx : wa)[k * 64 + e]); }
            if (tid < 64) {
                const int pi = (l * 2 + d) * 512 + n * 64 + tid; const float lam = p.lru_lambda[pi];
                par[tid] = p.lru_ba[pi]; par[64 + tid] = p.lru_bx[pi]; par[128 + tid] = (-lam > 20.f) ? -lam : log1pf(__expf(-lam));
                par[192 + tid] = p.conv_b[l * 512 + n * 64 + tid];
#pragma unroll
                for (int j = 0; j < 4; ++j) par[256 + j * 64 + tid] = p.conv_w[(l * 4 + j) * 512 + n * 64 + tid];
                carry[tid] = 0.f;
            }
        }
        __syncthreads();
#pragma unroll 1
        for (int c = 0; c < 18; ++c) {
            const bool isctx = c < 2;
            const int seqbase = isctx ? TL + b * CL : b * S, seqlen = isctx ? CL : S;
            const int pseq = (isctx ? 128 * c : 128 * (c - 2)) + 16 * w;
            const int lo = d == 0 ? pseq : seqlen - pseq - 16;
#pragma unroll
            for (int i = 0; i < 3; ++i) {
                const int r = (lane >> 3) + 8 * i, tok = lo - 2 + r;
                if (r < 19) {
                    u32x4 v = (u32x4){0u, 0u, 0u, 0u};
                    if (tok >= 0 && tok < seqlen) v = *(const u32x4*)(p.u + (size_t)(seqbase + tok) * 512 + n * 64 + (lane & 7) * 8);
                    *(LAS u32x4*)(Uraw + r * 64 + (lane & 7) * 8) = v;
                }
            }
            asm volatile("s_waitcnt lgkmcnt(0)" ::: "memory");
            const int rr = d == 0 ? q : 15 - q;
            float uc[4][4];
#pragma unroll
            for (int ct = 0; ct < 4; ++ct) {
                const int ch0 = ct * 16 + cg * 4;
                f32x4 acc = *(const LAS f32x4*)(par + 192 + ch0);
#pragma unroll
                for (int j = 0; j < 4; ++j) {
                    const u32x2 raw = *(const LAS u32x2*)(Uraw + (rr + j) * 64 + ch0); const f32x4 cw = *(const LAS f32x4*)(par + 256 + j * 64 + ch0);
                    acc[0] += bflo(raw.x) * cw[0]; acc[1] += bfhi(raw.x) * cw[1]; acc[2] += bflo(raw.y) * cw[2]; acc[3] += bfhi(raw.y) * cw[3];
                }
                uc[ct][0] = acc[0]; uc[ct][1] = acc[1]; uc[ct][2] = acc[2]; uc[ct][3] = acc[3];
                *(LAS u32x2*)(Ub + q * 72 + ch0) = (u32x2){pack2(acc[0], acc[1]), pack2(acc[2], acc[3])};
            }
            asm volatile("s_waitcnt lgkmcnt(0)" ::: "memory");
            f32x4 pre[2][4];
            {
                bf16x8 bu[2];
#pragma unroll
                for (int ks = 0; ks < 2; ++ks) bu[ks] = *(const LAS bf16x8*)(Ub + q * 72 + ks * 32 + cg * 8);
#pragma unroll
                for (int g = 0; g < 2; ++g)
#pragma unroll
                    for (int ct = 0; ct < 4; ++ct) {
                        f32x4 a4 = (f32x4){0.f, 0.f, 0.f, 0.f};
#pragma unroll
                        for (int ks = 0; ks < 2; ++ks) { const bf16x8 wv = *(const LAS bf16x8*)(Wt + (g * 64 + ct * 16 + q) * 64 + (((ks * 4 + cg) ^ (q & 7)) << 3)); a4 = __builtin_amdgcn_mfma_f32_16x16x32_bf16(wv, bu[ks], a4, 0, 0, 0); }
                        pre[g][ct] = a4;
                    }
            }
#pragma unroll
            for (int ct = 0; ct < 4; ++ct) {
                const int ch0 = ct * 16 + cg * 4;
                const f32x4 ba = *(const LAS f32x4*)(par + ch0), bx = *(const LAS f32x4*)(par + 64 + ch0), sp = *(const LAS f32x4*)(par + 128 + ch0);
                f32x4 av, bv;
#pragma unroll
                for (int j = 0; j < 4; ++j) {
                    const float r = sigmoidf_(pre[0][ct][j] + ba[j]), ig = sigmoidf_(pre[1][ct][j] + bx[j]);
                    const float log_a = -8.f * r * sp[j];
                    av[j] = __expf(log_a);
                    bv[j] = sqrtf(fmaxf(1.f - __expf(2.f * log_a), 0.f)) * (ig * uc[ct][j]);
                }
                *(LAS f32x4*)(Aa + (16 * w + q) * 64 + ch0) = av; *(LAS f32x4*)(Bb + (16 * w + q) * 64 + ch0) = bv;
            }
            asm volatile("s_waitcnt lgkmcnt(0)" ::: "memory");
            {
                float A = 1.f, H = 0.f;
#pragma unroll
                for (int pp = 0; pp < 16; ++pp) {
                    const float a = Aa[(16 * w + pp) * 64 + lane], bb = Bb[(16 * w + pp) * 64 + lane];
                    H = a * H + bb; A = A * a;
                    Aa[(16 * w + pp) * 64 + lane] = A; Bb[(16 * w + pp) * 64 + lane] = H;
                }
                seg[((c & 1) * 2 + 0) * 512 + w * 64 + lane] = A; seg[((c & 1) * 2 + 1) * 512 + w * 64 + lane] = H;
            }
            __syncthreads();
            float h = carry[(c & 1) * 64 + lane];
            for (int sgi = 0; sgi < w; ++sgi) h = seg[((c & 1) * 2 + 0) * 512 + sgi * 64 + lane] * h + seg[((c & 1) * 2 + 1) * 512 + sgi * 64 + lane];
            if (w == 7) carry[((c + 1) & 1) * 64 + lane] = seg[((c & 1) * 2 + 0) * 512 + 7 * 64 + lane] * h + seg[((c & 1) * 2 + 1) * 512 + 7 * 64 + lane];
            bf16_t* rp = rec + (size_t)(seqbase + lo) * 512 + n * 64 + lane;
            if (d == 0) {
#pragma unroll
                for (int pp = 0; pp < 16; ++pp) { const float hv = Bb[(16 * w + pp) * 64 + lane] + Aa[(16 * w + pp) * 64 + lane] * h; rp[(size_t)pp * 512] = (bf16_t)f2bf(hv); }
            } else {
                const bf16_t* gp = p.gb + (size_t)(seqbase + lo) * 512 + n * 64 + lane;
                float fv[16], gv[16];
#pragma unroll
                for (int pp = 0; pp < 16; ++pp) { fv[pp] = bf2f(rp[(size_t)(15 - pp) * 512]); gv[pp] = bf2f(gp[(size_t)(15 - pp) * 512]); }
#pragma unroll
                for (int pp = 0; pp < 16; ++pp) { const float hv = Bb[(16 * w + pp) * 64 + lane] + Aa[(16 * w + pp) * 64 + lane] * h; rp[(size_t)(15 - pp) * 512] = (bf16_t)f2bf((fv[pp] + hv) * gelu_tanh(gv[pp])); }
            }
        }
        __threadfence();
    }
    __syncthreads();
}

DEV void phase_mix(const P& p, int l, int bid, int nb) {
    const int tid = otid(), lane = tid & 63, wv = tid >> 6;
    const int nrows = l == 0 ? TT : TL;
    for (int t = bid * 8 + wv; t < nrows; t += nb * 8) {
        const int c0 = lane * 8;
        const uint4 a4 = *(const uint4*)(p.q + (size_t)t * 512 + c0);
        const uint4 f4 = *(const uint4*)(p.hdir + (size_t)t * 512 + c0);
        float av[8] = {bflo(a4.x), bfhi(a4.x), bflo(a4.y), bfhi(a4.y), bflo(a4.z), bfhi(a4.z), bflo(a4.w), bfhi(a4.w)};
        const float fv[8] = {bflo(f4.x), bfhi(f4.x), bflo(f4.y), bfhi(f4.y), bflo(f4.z), bfhi(f4.z), bflo(f4.w), bfhi(f4.w)};
        float rv[8]; float sa = 0.f, sr = 0.f;
#pragma unroll
        for (int i = 0; i < 8; ++i) { rv[i] = fv[i]; sa += av[i] * av[i]; sr += rv[i] * rv[i]; }
        sa = wave_sum(sa); sr = wave_sum(sr);
        const float ra = rsqrtf(sa * (1.f / 512.f) + EPS), rr = rsqrtf(sr * (1.f / 512.f) + EPS);
        const float* ga = p.attn_out_g + l * 512 + c0; const float* gr = p.lru_out_g + l * 512 + c0;
#pragma unroll
        for (int i = 0; i < 8; ++i) { av[i] = av[i] * ra * ga[i]; rv[i] = rv[i] * rr * gr[i]; }
        uint4 o; o.x = pack2(av[0], av[1]); o.y = pack2(av[2], av[3]); o.z = pack2(av[4], av[5]); o.w = pack2(av[6], av[7]);
        *(uint4*)(p.xn + (size_t)t * D + c0) = o;
        o.x = pack2(rv[0], rv[1]); o.y = pack2(rv[2], rv[3]); o.z = pack2(rv[4], rv[5]); o.w = pack2(rv[6], rv[7]);
        *(uint4*)(p.xn + (size_t)t * D + 512 + c0) = o;
    }
}

DEV void phase_route(const P& p, int l, int bid, int nb) {
    const int tid = otid(), lane = tid & 63, wv = tid >> 6;
    const int nrows = l == 0 ? TT : TL;
    for (int t = bid * 8 + wv; t < nrows; t += nb * 8) {
        const int mr = mod_row(t);
        const float* src = p.xres + (size_t)t * D;
        float xv[16];
#pragma unroll
        for (int i = 0; i < 4; ++i) { const float4 v4 = *(const float4*)(src + i * 256 + lane * 4); xv[i * 4] = v4.x; xv[i * 4 + 1] = v4.y; xv[i * 4 + 2] = v4.z; xv[i * 4 + 3] = v4.w; }
        float ss = 0.f;
#pragma unroll
        for (int i = 0; i < 16; ++i) ss += xv[i] * xv[i];
        ss = wave_sum(ss);
        const float rstd = rsqrtf(ss * (1.f / D) + EPS);
        const float* ng = p.norm2_g + l * D; const float* mm = p.mod + (size_t)(l * 9 + mr) * 6144;
        float lg[16];
#pragma unroll
        for (int e = 0; e < 16; ++e) lg[e] = 0.f;
#pragma unroll
        for (int i = 0; i < 4; ++i) {
            const int c0 = i * 256 + lane * 4;
            const float4 g4 = *(const float4*)(ng + c0), sh = *(const float4*)(mm + 3072 + c0), sc = *(const float4*)(mm + 4096 + c0);
            const float o0 = xv[i * 4] * rstd * g4.x * (1.f + sc.x) + sh.x, o1 = xv[i * 4 + 1] * rstd * g4.y * (1.f + sc.y) + sh.y;
            const float o2 = xv[i * 4 + 2] * rstd * g4.z * (1.f + sc.z) + sh.z, o3 = xv[i * 4 + 3] * rstd * g4.w * (1.f + sc.w) + sh.w;
            *(uint2*)(p.xn + (size_t)t * D + c0) = make_uint2(pack2(o0, o1), pack2(o2, o3));
            const float hv[4] = {o0, o1, o2, o3};
#pragma unroll
            for (int j = 0; j < 4; ++j) {
                const float4* rw = (const float4*)(p.router_w + (size_t)(c0 + j) * 16);
#pragma unroll
                for (int q4 = 0; q4 < 4; ++q4) { const float4 r4 = rw[q4]; lg[q4 * 4] += hv[j] * r4.x; lg[q4 * 4 + 1] += hv[j] * r4.y; lg[q4 * 4 + 2] += hv[j] * r4.z; lg[q4 * 4 + 3] += hv[j] * r4.w; }
            }
        }
        float sc_[16], bi[16];
#pragma unroll
        for (int e = 0; e < 16; ++e) { lg[e] = wave_sum(lg[e]); sc_[e] = 1.f / (1.f + expf(-lg[e])); bi[e] = sc_[e] + p.router_b[e]; }
        float gs[4];
#pragma unroll
        for (int g = 0; g < 4; ++g) {
            const float a = bi[g * 4], b = bi[g * 4 + 1], c = bi[g * 4 + 2], d = bi[g * 4 + 3];
            const float m1 = fmaxf(fmaxf(a, b), fmaxf(c, d));
            const float m2 = fmaxf(fmaxf(fminf(a, b), fminf(c, d)), fminf(fmaxf(a, b), fmaxf(c, d)));
            gs[g] = m1 + m2;
        }
        int bg = 0; float bgs = gs[0];
#pragma unroll
        for (int g = 1; g < 4; ++g) if (gs[g] > bgs) { bgs = gs[g]; bg = g; }
        float v0 = 0.f, v1 = 0.f, v2 = 0.f, v3 = 0.f, s0 = 0.f, s1 = 0.f, s2 = 0.f, s3 = 0.f;
#pragma unroll
        for (int g = 0; g < 4; ++g) if (bg == g) { v0 = bi[g * 4]; v1 = bi[g * 4 + 1]; v2 = bi[g * 4 + 2]; v3 = bi[g * 4 + 3]; s0 = sc_[g * 4]; s1 = sc_[g * 4 + 1]; s2 = sc_[g * 4 + 2]; s3 = sc_[g * 4 + 3]; }
        int i1 = 0; float b1 = v0, w1 = s0;
        if (v1 > b1) { b1 = v1; i1 = 1; w1 = s1; }
        if (v2 > b1) { b1 = v2; i1 = 2; w1 = s2; }
        if (v3 > b1) { b1 = v3; i1 = 3; w1 = s3; }
        int i2 = -1; float b2 = -1e30f, w2 = 0.f;
        if (i1 != 0 && v0 > b2) { b2 = v0; i2 = 0; w2 = s0; }
        if (i1 != 1 && v1 > b2) { b2 = v1; i2 = 1; w2 = s1; }
        if (i1 != 2 && v2 > b2) { b2 = v2; i2 = 2; w2 = s2; }
        if (i1 != 3 && v3 > b2) { b2 = v3; i2 = 3; w2 = s3; }
        if (lane == 0) {
            const float inv = 1.f / (w1 + w2);
            const int e1 = bg * 4 + i1, e2 = bg * 4 + i2;
            p.tokw[2 * t] = w1 * inv; p.tokw[2 * t + 1] = w2 * inv;
            const int p1 = atomicAdd(&p.cnt[l * 16 + e1], 1); p.list[e1 * TT + p1] = 2 * t;
            const int p2 = atomicAdd(&p.cnt[l * 16 + e2], 1); p.list[e2 * TT + p2] = 2 * t + 1;
        }
    }
}

__global__ void __launch_bounds__(NTHR, 2) fwd_megakernel(P p) {
    extern __shared__ __attribute__((aligned(16))) unsigned char lds_raw[];
    LAS unsigned char* lds = (LAS unsigned char*)lds_raw;
    volatile LAS unsigned* misc = (volatile LAS unsigned*)(lds + MISC_OFF);
    if (threadIdx.x < 16) misc[threadIdx.x] = 0u;
    __syncthreads();
    XcdBarrier gbar = xcd_barrier_post(p.bar, misc);
    const int bid = blockIdx.x, nb = gridDim.x;
    LAS float* rope_l = (LAS float*)(lds + MISC_OFF + MISC_ROPE);
    LAS i32x2* ptab = (LAS i32x2*)(lds + MISC_OFF + MISC_PTAB);
    {
        const int tid = otid();
        for (int i = tid; i < 1024; i += NTHR) {
            const int pos = i >> 4, f = i & 15;
            const float inv = exp2f(-(float)(2 * f) / 32.f * 13.287712379549449f);
            const float ang = (float)pos * inv;
            rope_l[i] = __cosf(ang); rope_l[1024 + i] = __sinf(ang);
        }
    }
    phase_prologue(p, bid, nb, lds);
    xcd_barrier(gbar);
#pragma unroll
    for (int l = 0; l < 2; ++l) {
        if (l == 0) phase_rowA<0>(p, l, bid, nb);
        else {
            phase_rowA<1>(p, l, bid, nb);
            const int tid = otid();
            convert_experts(p, 1, bid * 8 + (tid >> 6), nb * 8, (LAS float*)(lds + (tid >> 6) * 16384), tid & 63);
        }
        xcd_barrier(gbar);
        {
            const int tid = otid();
            pg8::GemmPlain g{p.xn, p.wt_in + (size_t)l * INW * D, D};
            pg8::RowMajorOrder so{7, (TT / 256) * 7, nb, bid};
            EpiIn E{&p, l, rope_l};
            pg8::gemm_phase<EpiIn, pg8::GemmPlain, pg8::RowMajorOrder, true>(lds, g, so, E, tid);
        }
        xcd_barrier(gbar);
        if (bid < 64) { const int tid = otid(); lru_item(p, l, bid >> 3, bid & 7, lds, tid); }
        { const int tid = otid(); phase_attn(p, l, lds, misc, tid); }
        xcd_barrier(gbar);
        phase_mix(p, l, bid, nb);
        xcd_barrier(gbar);
        {
            const int tid = otid();
            pg8::GemmPlain g{p.xn, p.wt_out + (size_t)l * D * D, D};
            pg8::RowMajorOrder so{4, ((l == 0 ? TT : TL) / 256) * 4, nb, bid};
            EpiOut E{&p, l};
            pg8::gemm_phase<EpiOut, pg8::GemmPlain, pg8::RowMajorOrder, true>(lds, g, so, E, tid);
        }
        xcd_barrier(gbar);
        phase_route(p, l, bid, nb);
        xcd_barrier(gbar);
        {
            const int tid = otid();
            const int np = moe_build_ptab(p.cnt + l * 16, ptab, tid);
            MoeUpDesc g{p.xn, p.wt_gu, D, ptab, p.cnt + l * 16, p.list};
            pg8::RowMajorOrder so{4, np * 4, nb, bid};
            EpiMoeUp E{p.hid};
            pg8::gemm_phase<EpiMoeUp, MoeUpDesc, pg8::RowMajorOrder, true>(lds, g, so, E, tid);
        }
        xcd_barrier(gbar);
        {
            const int tid = otid();
            const int np = ptab[MAXPANELS].x;
            MoeDownDesc g{p.hid, p.wt_d, DE, ptab};
            pg8::RowMajorOrder so{4, np * 4, nb, bid};
            EpiMoeDown E{p.y, p.tokw, ptab, p.cnt + l * 16, p.list};
            pg8::gemm_phase<EpiMoeDown, MoeDownDesc, pg8::RowMajorOrder, true>(lds, g, so, E, tid);
        }
        xcd_barrier(gbar);
    }
    phase_rowA<2>(p, 1, bid, nb);
}

extern "C" void kernel_launch(void* const* d_in, const int* in_sizes, int n_in, void* d_out, int out_size, void* d_ws, size_t ws_size, hipStream_t stream) {
    P p{};
    const float* const* in = (const float* const*)d_in;
    p.x = in[0]; p.c = in[1]; p.ctx = in[2]; p.c_ctx = in[3]; p.ada_w = in[4]; p.ada_b = in[5]; p.norm1_g = in[6]; p.w_in = in[7]; p.q_norm_g = in[8]; p.k_norm_g = in[9];
    p.conv_w = in[10]; p.conv_b = in[11]; p.lru_wa = in[12]; p.lru_ba = in[13]; p.lru_wx = in[14]; p.lru_bx = in[15]; p.lru_lambda = in[16]; p.attn_out_g = in[17];
    p.lru_out_g = in[18]; p.w_out = in[19]; p.norm2_g = in[20]; p.router_w = in[21]; p.router_b = in[22]; p.w_gate = in[23]; p.w_up = in[24]; p.w_down = in[25]; p.final_g = in[26];
    p.out = (float*)d_out;
    char* ws = (char*)d_ws; size_t off = 0;
    auto carve = [&](size_t bytes) { void* r = ws + off; off += (bytes + 255) & ~(size_t)255; return r; };
    p.bar = (unsigned*)carve(XCD_BAR_WORDS * 4);
    p.cnt = (int*)carve(32 * 4);
    p.qctr = (int*)carve(64 * 4);
    const size_t ctl_bytes = off;
    p.mod = (float*)carve((size_t)2 * 9 * 6144 * 4);
    p.tokw = (float*)carve((size_t)2 * TT * 4);
    p.list = (int*)carve((size_t)NE * TT * 4);
    p.wt_in = (bf16_t*)carve((size_t)2 * INW * D * 2);
    p.wt_out = (bf16_t*)carve((size_t)2 * D * D * 2);
    p.wt_gu = (bf16_t*)carve((size_t)NE * D * D * 2);
    p.wt_d = (bf16_t*)carve((size_t)NE * D * DE * 2);
    p.xres = (float*)carve((size_t)TT * D * 4);
    p.xn = (bf16_t*)carve((size_t)TT * D * 2);
    p.hid = (bf16_t*)carve((size_t)MAXPANELS * 256 * DE * 2);
    p.q = (bf16_t*)carve((size_t)TT * 512 * 2);
    p.y = p.q;
    p.k = (bf16_t*)carve((size_t)TT * 128 * 2);
    p.v = (bf16_t*)carve((size_t)TT * 128 * 2);
    p.u = (bf16_t*)carve((size_t)TT * 512 * 2);
    p.gb = (bf16_t*)carve((size_t)TT * 512 * 2);
    p.hdir = (bf16_t*)carve((size_t)TT * 512 * 2);
    if (off > ws_size) { fprintf(stderr, "workspace too small: need %zu have %zu\n", off, ws_size); return; }
    static int grid_blocks = 0;
    if (!grid_blocks) {
        int dev = 0, cus = 0;
        (void)hipGetDevice(&dev);
        (void)hipDeviceGetAttribute(&cus, hipDeviceAttributeMultiprocessorCount, dev);
        if (hipFuncSetAttribute((const void*)fwd_megakernel, hipFuncAttributeMaxDynamicSharedMemorySize, LDS_BYTES) != hipSuccess) { fprintf(stderr, "hipFuncSetAttribute failed\n"); grid_blocks = -1; return; }
        grid_blocks = cus > 0 ? cus : 256;
    }
    if (grid_blocks < 0) return;
    (void)hipMemsetAsync(ws, 0, ctl_bytes, stream);
    hipLaunchKernelGGL(fwd_megakernel, dim3(grid_blocks), dim3(NTHR), LDS_BYTES, stream, p);
}
```

```cpp
#include <hip/hip_runtime.h>
#include <stdint.h>
#include <cstdio>

#define DEV __device__ __forceinline__
#define LAS __attribute__((address_space(3)))
typedef unsigned short bf16_t;
typedef short bf16x8 __attribute__((ext_vector_type(8)));
typedef float f32x4 __attribute__((ext_vector_type(4)));
typedef unsigned u32x4 __attribute__((ext_vector_type(4)));
typedef unsigned u32x2 __attribute__((ext_vector_type(2)));
typedef int i32x2 __attribute__((ext_vector_type(2)));

constexpr int D = 1024, NB = 8, S = 2048, CL = 256, TL = NB * S, TC = NB * CL, TT = TL + TC, KVS = CL + S;
constexpr int INW = 1792, NE = 16, DE = 512;
constexpr float EPS = 1e-6f;
constexpr int NTHR = 512;
constexpr int RING_BYTES = 131072, MISC_OFF = RING_BYTES, LDS_BYTES = 147456;
constexpr int MAXPANELS = 2 * TT / 256 + NE;
constexpr int MISC_ROPE = 64, MISC_PTAB = 64 + 8192;

DEV float bf2f(bf16_t v) { return __uint_as_float(((unsigned)v) << 16); }
DEV unsigned f2bf(float f) { unsigned u = __float_as_uint(f); return (u + 0x7fffu + ((u >> 16) & 1u)) >> 16; }
DEV float bflo(unsigned w) { return __uint_as_float(w << 16); }
DEV float bfhi(unsigned w) { return __uint_as_float(w & 0xffff0000u); }
DEV unsigned pack2(float lo, float hi) { return f2bf(lo) | (f2bf(hi) << 16); }
DEV float wave_sum(float v) {
#pragma unroll
    for (int o = 32; o > 0; o >>= 1) v += __shfl_xor(v, o);
    return v;
}
DEV float sigmoidf_(float x) { return 1.f / (1.f + __expf(-x)); }
DEV float gelu_tanh(float x) {
    const float u = 0.7978845608028654f * (x + 0.044715f * x * x * x);
    const float e = __expf(2.f * u);
    const float th = 1.f - 2.f / (e + 1.f);
    return 0.5f * x * (1.f + th);
}
constexpr float attn_body_C2 = 0.125f * 1.4426950408889634f;
DEV int otid() { int t = threadIdx.x; asm volatile("" : "+v"(t)); return t; }
DEV int mod_row(int t) { return t < TL ? (t >> 11) : 8; }
DEV int kv_row(int t) { return t < TL ? (t >> 11) * KVS + CL + (t & 2047) : ((t - TL) >> 8) * KVS + ((t - TL) & 255); }

struct P {
    const float *x, *c, *ctx, *c_ctx, *ada_w, *ada_b, *norm1_g, *w_in, *q_norm_g, *k_norm_g, *conv_w, *conv_b, *lru_wa, *lru_ba, *lru_wx, *lru_bx,
        *lru_lambda, *attn_out_g, *lru_out_g, *w_out, *norm2_g, *router_w, *router_b, *w_gate, *w_up, *w_down, *final_g;
    float* out;
    float *mod, *xres, *tokw, *sptab, *totA, *totH;
    bf16_t *xn, *q, *k, *v, *u, *gb, *hl, *ac, *hid, *y;
    bf16_t *wt_in, *wt_out, *wt_gu, *wt_d, *wt_lru;
    int *cnt, *list, *qctr;
    unsigned* bar;
};

#define XB_TMO      128
#define XB_XCNT(j)  (256  + 64 * (j))
#define XB_XSUB(j)  (1280 + 64 * (j))
#define XB_XGEN(j)  (2304 + 64 * (j))
#define XB_TOP      3328
#define XB_TOPGEN   3392
#define XCD_BAR_WORDS 3456
#define XB_SPIN_CAP (1u << 20)
DEV unsigned xb_ld(unsigned* p) { return __hip_atomic_load(p, __ATOMIC_RELAXED, __HIP_MEMORY_SCOPE_AGENT); }
DEV unsigned xb_add(unsigned* p, unsigned v) { return __hip_atomic_fetch_add(p, v, __ATOMIC_RELAXED, __HIP_MEMORY_SCOPE_AGENT); }
DEV unsigned xb_xcc_id() { return (unsigned)__builtin_amdgcn_s_getreg((3 << 11) | 20) & 0xFu; }
#define XB_SPIN(cond, bar) do { unsigned _sp = 0; while (cond) { __builtin_amdgcn_s_sleep(1); \
    if ((++_sp & 255u) == 0u) { if (xb_ld(&(bar)[XB_TMO])) break; if (_sp > XB_SPIN_CAP) { atomicAdd(&(bar)[XB_TMO], 1u); break; } } } } while (0)
struct XcdBarrier { unsigned* bar; unsigned x; volatile LAS unsigned* st; };
DEV XcdBarrier xcd_barrier_post(unsigned* bar, volatile LAS unsigned* st) {
    XcdBarrier b; b.bar = bar; b.x = xb_xcc_id(); b.st = st;
    if (threadIdx.x == 0) { (void)xb_add(&bar[XB_XCNT(b.x)], 1u); st[2] = b.x; }
    return b;
}
DEV void xcd_barrier_complete(unsigned* bar, unsigned x, unsigned& nloc, unsigned& nx) {
    const unsigned G = gridDim.x * gridDim.y * gridDim.z;
    unsigned sum, cnt, mine, sp = 0u;
    for (;;) {
        sum = 0u; cnt = 0u; mine = 0u;
#pragma unroll
        for (unsigned j = 0; j < 16; ++j) { const unsigned c = xb_ld(&bar[XB_XCNT(j)]); sum += c; cnt += (c > 0u) ? 1u : 0u; mine = (j == x) ? c : mine; }
        if (sum == G) break;
        __builtin_amdgcn_s_sleep(1);
        if ((++sp & 255u) == 0u) { if (xb_ld(&bar[XB_TMO])) break; if (sp > XB_SPIN_CAP) { atomicAdd(&bar[XB_TMO], 1u); break; } }
    }
    nloc = mine > 0u ? mine : 1u; nx = cnt > 0u ? cnt : 1u;
}
DEV void xcd_barrier(const XcdBarrier& b) {
    asm volatile("s_waitcnt vmcnt(0)" ::: "memory");
    __syncthreads();
    if (threadIdx.x == 0) {
        unsigned* bar = b.bar;
        __builtin_amdgcn_s_waitcnt(0);
        unsigned nloc = b.st[0], nx = b.st[1]; const unsigned bx = b.st[2];
        if (nloc == 0u) { xcd_barrier_complete(bar, bx, nloc, nx); b.st[0] = nloc; b.st[1] = nx; }
        const unsigned old = xb_add(&bar[XB_XSUB(bx)], 1u);
        const unsigned gen = old / nloc;
        if (old + 1u == (gen + 1u) * nloc) {
            __builtin_amdgcn_fence(__ATOMIC_RELEASE, "agent");
            asm volatile("s_waitcnt vmcnt(0)" ::: "memory");
            const unsigned og = xb_add(&bar[XB_TOP], 1u);
            const unsigned tg = og / nx;
            if (og + 1u == (tg + 1u) * nx) xb_add(&bar[XB_TOPGEN], 1u);
            else XB_SPIN(xb_ld(&bar[XB_TOPGEN]) == tg, bar);
            __builtin_amdgcn_fence(__ATOMIC_ACQUIRE, "agent");
            xb_add(&bar[XB_XGEN(bx)], 1u);
            asm volatile("s_waitcnt vmcnt(0)" ::: "memory");
        } else {
            XB_SPIN(xb_ld(&bar[XB_XGEN(bx)]) == gen, bar);
            __builtin_amdgcn_fence(__ATOMIC_ACQUIRE, "agent");
            asm volatile("s_waitcnt vmcnt(0)" ::: "memory");
        }
    }
    __syncthreads();
}

namespace pg8 {
constexpr int BM = 256, BK = 64, HALF = 128, HTB = HALF * BK * 2, STAGE_BYTES = 8 * HTB;
DEV int lds_byte(int r, int c) { const int st = (r >> 4) * 2 + (c >> 5), rr = r & 15, cc = c & 31, ob = rr * 64 + cc * 2; return st * 1024 + (ob ^ (((ob >> 9) & 1) << 5)); }
DEV void stage_rc(int b, int& R, int& C) { const int st = b / 1024, sb = b % 1024, swz = sb ^ (((sb >> 9) & 1) << 5); R = (st >> 1) * 16 + swz / 64; C = (st & 1) * 32 + (swz % 64) / 2; }
DEV int perm32(int rho) { const int n = rho >> 4, i = rho & 15; return 8 * (i >> 2) + 4 * n + (i & 3); }
struct Unit { int pm, pn; };

template <class Epi, class G, class Sched, bool ALIGN_EPI>
DEV void gemm_phase(LAS unsigned char* lds, const G& g, const Sched& S, const Epi& E, const int tid) {
    const int wid = __builtin_amdgcn_readfirstlane(tid >> 6), lane = tid & 63, wr = wid >> 2, wc = wid & 3, fr = lane & 15, fq = lane >> 4;
    const int K = g.K, nt = K / BK;
    int sR[2], sC[2]; unsigned voffB[2];
#pragma unroll
    for (int i = 0; i < 2; ++i) { stage_rc(tid * 16 + i * 8192, sR[i], sC[i]); const int Rb = Epi::PERM ? ((sR[i] & ~31) + perm32(sR[i] & 31)) : sR[i];
        voffB[i] = (unsigned)(Rb * K + sC[i]) * 2u; }
    const size_t kstep = (size_t)(BK * 2);
    const size_t hstep = (size_t)HALF * K * 2;
    const unsigned ldsw = (unsigned)wid * 1024u;
    const int aoff = lds_byte(wr * 64 + fr, fq * 8), boff = lds_byte(wc * 32 + fr, fq * 8);
#define PG8_SA(b, h) (((b) * 2 + (h)) * HTB)
#define PG8_SB(b, h) ((4 + (b) * 2 + (h)) * HTB)
#define PG8_STAGE(bufoff, gbase, voff) do { _Pragma("unroll") for (int _i = 0; _i < 2; ++_i) \
        __builtin_amdgcn_global_load_lds((const unsigned*)((const char*)(gbase) + (voff)[_i]), (LAS unsigned*)(lds + (bufoff) + ldsw + _i * 8192), 16, 0, 0); } while (0)
#define PG8_LDA(dst, b, h) do { _Pragma("unroll") for (int m = 0; m < 4; ++m) _Pragma("unroll") for (int k = 0; k < 2; ++k) dst[m][k] = *(const LAS bf16x8*)(lds + PG8_SA(b, h) + aoff + m * 2048 + k * 1024); } while (0)
#define PG8_LDB(dst, b, h) do { _Pragma("unroll") for (int n = 0; n < 2; ++n) _Pragma("unroll") for (int k = 0; k < 2; ++k) dst[n][k] = *(const LAS bf16x8*)(lds + PG8_SB(b, h) + boff + n * 2048 + k * 1024); } while (0)
#define PG8_MMA(ai, bj, At, Bt) do { __builtin_amdgcn_s_setprio(1); _Pragma("unroll") for (int m = 0; m < 4; ++m) _Pragma("unroll") for (int n = 0; n < 2; ++n) _Pragma("unroll") for (int k = 0; k < 2; ++k) \
        acc[ai][bj][m][n] = __builtin_amdgcn_mfma_f32_16x16x32_bf16(Bt[n][k], At[m][k], acc[ai][bj][m][n], 0, 0, 0); __builtin_amdgcn_s_setprio(0); } while (0)
#define PG8_WAIT_V(n) asm volatile("s_waitcnt vmcnt(" #n ")" ::: "memory")
#define PG8_WAIT_L(n) asm volatile("s_waitcnt lgkmcnt(" #n ")" ::: "memory")
#define PG8_BAR __builtin_amdgcn_s_barrier()
#define PG8_SCHED __builtin_amdgcn_sched_barrier(0)
    Unit cur, nxt; int ui = 0;
    if (!S.next(0, cur)) return;
    f32x4 acc[2][2][4][2];
#pragma unroll
    for (int a = 0; a < 2; ++a)
#pragma unroll
        for (int b = 0; b < 2; ++b)
#pragma unroll
            for (int m = 0; m < 4; ++m)
#pragma unroll
                for (int n = 0; n < 2; ++n) acc[a][b][m][n] = (f32x4){0.f, 0.f, 0.f, 0.f};
    bf16x8 At[4][2], B0[2][2], B1[2][2];
    unsigned oc[2][2], on[2][2];
#pragma unroll
    for (int h = 0; h < 2; ++h)
#pragma unroll
        for (int i = 0; i < 2; ++i) oc[h][i] = g.a_off(cur, h, sR[i], sC[i]);
    const char* cA = g.a_base(cur); const char* cB = g.b_base(cur);
    PG8_STAGE(PG8_SB(0, 0), cB, voffB); PG8_STAGE(PG8_SB(0, 1), cB + hstep, voffB); PG8_STAGE(PG8_SA(0, 0), cA, oc[0]); PG8_STAGE(PG8_SA(0, 1), cA, oc[1]);
    if (wr == 1) PG8_BAR;
    PG8_WAIT_V(2); PG8_BAR;
    PG8_STAGE(PG8_SB(1, 0), cB + kstep, voffB); PG8_STAGE(PG8_SA(1, 0), cA + kstep, oc[0]); PG8_STAGE(PG8_SB(1, 1), cB + hstep + kstep, voffB);
    PG8_WAIT_V(6); PG8_BAR;
    for (;;) {
        const bool has_next = S.next(ui + 1, nxt);
#pragma unroll
        for (int h = 0; h < 2; ++h)
#pragma unroll
            for (int i = 0; i < 2; ++i) on[h][i] = has_next ? g.a_off(nxt, h, sR[i], sC[i]) : oc[h][i];
        const char* nA = has_next ? g.a_base(nxt) : cA; const char* nB = has_next ? g.b_base(nxt) : cB;
        for (int t = 0; t < nt; t += 2) {
            const bool last = (t == nt - 2);
            const char* a1 = cA + (size_t)(t + 1) * kstep;
            const char* a2 = last ? nA : cA + (size_t)(t + 2) * kstep; const char* b2 = last ? nB : cB + (size_t)(t + 2) * kstep;
            const char* a3 = a2 + kstep; const char* b3 = b2 + kstep;
            unsigned o2[2][2];
#pragma unroll
            for (int h = 0; h < 2; ++h)
#pragma unroll
                for (int i = 0; i < 2; ++i) o2[h][i] = last ? on[h][i] : oc[h][i];
            PG8_LDB(B0, 0, 0); PG8_LDB(B1, 0, 1); PG8_SCHED; PG8_LDA(At, 0, 0); PG8_STAGE(PG8_SA(1, 1), a1, oc[1]);
            PG8_WAIT_V(8); PG8_WAIT_L(0); PG8_BAR; PG8_MMA(0, 0, At, B0); PG8_MMA(0, 1, At, B1); PG8_BAR; PG8_SCHED;
            PG8_LDA(At, 0, 1); PG8_STAGE(PG8_SB(0, 0), b2, voffB); PG8_STAGE(PG8_SB(0, 1), b2 + hstep, voffB); PG8_STAGE(PG8_SA(0, 0), a2, o2[0]);
            PG8_WAIT_V(8); PG8_WAIT_L(0); PG8_BAR; PG8_MMA(1, 0, At, B0); PG8_MMA(1, 1, At, B1); PG8_BAR; PG8_SCHED;
            PG8_LDB(B0, 1, 0); PG8_LDB(B1, 1, 1); PG8_SCHED; PG8_LDA(At, 1, 0); PG8_STAGE(PG8_SA(0, 1), a2, o2[1]);
            PG8_WAIT_V(8); PG8_WAIT_L(0); PG8_BAR; PG8_MMA(0, 0, At, B0); PG8_MMA(0, 1, At, B1); PG8_BAR; PG8_SCHED;
            PG8_LDA(At, 1, 1); PG8_STAGE(PG8_SB(1, 0), b3, voffB); PG8_STAGE(PG8_SB(1, 1), b3 + hstep, voffB); PG8_STAGE(PG8_SA(1, 0), a3, o2[0]);
            PG8_WAIT_V(8); PG8_WAIT_L(0); PG8_BAR; PG8_MMA(1, 0, At, B0); PG8_MMA(1, 1, At, B1); PG8_BAR; PG8_SCHED;
        }
        if (ALIGN_EPI) { if (wr == 0) PG8_BAR; }
        E(acc, cur, wr, wc, fr, fq);
        if (!has_next) break;
#pragma unroll
        for (int a = 0; a < 2; ++a)
#pragma unroll
            for (int b = 0; b < 2; ++b)
#pragma unroll
                for (int m = 0; m < 4; ++m)
#pragma unroll
                    for (int n = 0; n < 2; ++n) acc[a][b][m][n] = (f32x4){0.f, 0.f, 0.f, 0.f};
        cur = nxt; cA = nA; cB = nB; ++ui;
#pragma unroll
        for (int h = 0; h < 2; ++h)
#pragma unroll
            for (int i = 0; i < 2; ++i) oc[h][i] = on[h][i];
        if (ALIGN_EPI) { if (wr == 1) PG8_BAR; }
    }
    PG8_WAIT_V(0);
    if (!ALIGN_EPI) { if (wr == 0) PG8_BAR; }
    PG8_BAR;
#undef PG8_SA
#undef PG8_SB
#undef PG8_STAGE
#undef PG8_LDA
#undef PG8_LDB
#undef PG8_MMA
#undef PG8_WAIT_V
#undef PG8_WAIT_L
#undef PG8_BAR
#undef PG8_SCHED
}

struct GemmPlain {
    const bf16_t* A; const bf16_t* Bt; int K;
    DEV const char* a_base(const Unit& u) const { return (const char*)A + (size_t)u.pm * (256 * K * 2); }
    DEV const char* b_base(const Unit& u) const { return (const char*)Bt + (size_t)u.pn * (256 * K * 2); }
    DEV unsigned a_off(const Unit&, int h, int R, int C) const { return (unsigned)((h * 128 + R) * K + C) * 2u; }
};
struct RowMajorOrder {
    int nN, nunits, G, c;
    DEV bool next(int i, Unit& u) const { const int L = i * G + c; if (L >= nunits) return false; u.pm = L / nN; u.pn = L - u.pm * nN; return true; }
};
}

template <class RowMap>
DEV void transpose_item(const float* W, int K, int N, bf16_t* WT, LAS float* scr, int item, int lane, const RowMap& rm) {
    const int nblk = N / 32, kb = item / nblk, nbk = item % nblk, k0 = 64 * kb, n0 = 32 * nbk;
#pragma unroll 8
    for (int i = 0; i < 32; ++i) { const int kk = 2 * i + (lane >> 5); scr[kk * 33 + (lane & 31)] = W[(size_t)(k0 + kk) * N + n0 + (lane & 31)]; }
    asm volatile("s_waitcnt lgkmcnt(0)" ::: "memory");
    const int c = lane & 7;
#pragma unroll
    for (int j = 0; j < 4; ++j) { const int n = (lane >> 3) + 8 * j; const LAS float* s = scr + (8 * c) * 33 + n;
        u32x4 o; o.x = pack2(s[0 * 33], s[1 * 33]); o.y = pack2(s[2 * 33], s[3 * 33]); o.z = pack2(s[4 * 33], s[5 * 33]); o.w = pack2(s[6 * 33], s[7 * 33]);
        *(u32x4*)(WT + (size_t)rm(n0 + n) * K + k0 + 8 * c) = o; }
    asm volatile("s_waitcnt lgkmcnt(0)" ::: "memory");
}
struct MapId { DEV int operator()(int n) const { return n; } };
struct MapIn { DEV int operator()(int n) const { return (n & ~255) | ((n & 32) << 2) | ((n & 192) >> 1) | (n & 31); } };
template <int NSEL> struct MapGU { DEV int operator()(int h) const { return ((h >> 7) << 8) | (((h >> 6) & 1) << 7) | (((h >> 4) & 3) << 5) | (((h >> 2) & 3) << 3) | (NSEL << 2) | (h & 3); } };

constexpr int IT_IN = (D / 64) * (INW / 32), IT_OUT = (D / 64) * (D / 32), IT_G = (D / 64) * (DE / 32), IT_D = (DE / 64) * (D / 32), IT_EXP = 2 * IT_G + IT_D;
DEV void convert_experts(const P& p, int l, int gw, int ngw, LAS float* scr, int lane) {
    for (int it = gw; it < NE * IT_EXP; it += ngw) {
        const int e = it / IT_EXP; int r = it - e * IT_EXP;
        const size_t le = (size_t)(l * NE + e);
        if (r < IT_G) { transpose_item(p.w_gate + le * D * DE, D, DE, p.wt_gu + (size_t)e * D * D, scr, r, lane, MapGU<0>()); continue; } r -= IT_G;
        if (r < IT_G) { transpose_item(p.w_up + le * D * DE, D, DE, p.wt_gu + (size_t)e * D * D, scr, r, lane, MapGU<1>()); continue; } r -= IT_G;
        transpose_item(p.w_down + le * DE * D, DE, D, p.wt_d + (size_t)e * D * DE, scr, r, lane, MapId());
    }
}
DEV void phase_prologue(const P& p, int bid, int nb, LAS unsigned char* lds) {
    const int tid = otid(), lane = tid & 63, wv = tid >> 6;
    {
        LAS float* sil = (LAS float*)lds;
        LAS float* red = (LAS float*)(lds + 9 * 1024 * 4);
        bool have = false;
        for (int w = bid; w < 2 * 96; w += nb) {
            if (!have) {
                for (int i = tid; i < 9 * 1024; i += NTHR) { const int r = i >> 10, d = i & 1023; const float v = r < 8 ? p.c[r * 1024 + d] : p.c_ctx[d]; sil[i] = v * sigmoidf_(v); }
                have = true;
            }
            __syncthreads();
            const int l = w / 96, col0 = (w % 96) * 64, kq = tid >> 4, c4 = (tid & 15) * 4;
            const float* wp = p.ada_w + (size_t)l * 1024 * 6144 + col0 + c4;
            float acc[9][4];
#pragma unroll
            for (int r = 0; r < 9; ++r)
#pragma unroll
                for (int j = 0; j < 4; ++j) acc[r][j] = 0.f;
#pragma unroll 4
            for (int i = 0; i < 32; ++i) {
                const int k = kq + 32 * i;
                const float4 w4 = *(const float4*)(wp + (size_t)k * 6144);
#pragma unroll
                for (int r = 0; r < 9; ++r) { const float sv = sil[r * 1024 + k]; acc[r][0] += sv * w4.x; acc[r][1] += sv * w4.y; acc[r][2] += sv * w4.z; acc[r][3] += sv * w4.w; }
            }
#pragma unroll
            for (int r = 0; r < 9; ++r)
#pragma unroll
                for (int j = 0; j < 4; ++j) red[(kq * 64 + c4 + j) * 9 + r] = acc[r][j];
            __syncthreads();
            for (int o = tid; o < 64 * 9; o += NTHR) {
                const int cc = o / 9, r = o - cc * 9; float s = 0.f;
#pragma unroll 8
                for (int g = 0; g < 32; ++g) s += red[(g * 64 + cc) * 9 + r];
                p.mod[(size_t)(l * 9 + r) * 6144 + col0 + cc] = s + p.ada_b[l * 6144 + col0 + cc];
            }
        }
        __syncthreads();
    }
    {
        LAS float* scr = (LAS float*)(lds + wv * 16384);
        const int gw = bid * 8 + wv, ngw = nb * 8;
        for (int it = gw; it < 2 * (IT_IN + IT_OUT); it += ngw) {
            const int l = it / (IT_IN + IT_OUT); int r = it - l * (IT_IN + IT_OUT);
            if (r < IT_IN) transpose_item(p.w_in + (size_t)l * D * INW, D, INW, p.wt_in + (size_t)l * INW * D, scr, r, lane, MapIn());
            else transpose_item(p.w_out + (size_t)l * D * D, D, D, p.wt_out + (size_t)l * D * D, scr, r - IT_IN, lane, MapId());
        }
        for (int it = gw; it < 2 * 2 * 8 * 2 * 2; it += ngw) {
            const int m = it >> 2, g = (it >> 1) & 1, r = it & 1;
            transpose_item((g ? p.lru_wx : p.lru_wa) + (size_t)m * 4096, 64, 64, p.wt_lru + (size_t)(m * 2 + g) * 4096, scr, r, lane, MapId());
        }
        convert_experts(p, 0, gw, ngw, scr, lane);
        if (bid == nb - 1) for (int i = tid; i < 2 * 2 * 512; i += NTHR) { const float lam = p.lru_lambda[i]; p.sptab[i] = (-lam > 20.f) ? -lam : log1pf(__expf(-lam)); }
    }
}

template <int MODE>
DEV void phase_rowA(const P& p, int l, int bid, int nb) {
    const int tid = otid(), lane = tid & 63, wv = tid >> 6;
    const int nrows = (MODE == 2) ? TL : TT;
    for (int t = bid * 8 + wv; t < nrows; t += nb * 8) {
        const int mr = mod_row(t);
        float xv[16];
        if (MODE == 0) {
            const float* src = t < TL ? p.x + (size_t)t * D : p.ctx + (size_t)(t - TL) * D;
#pragma unroll
            for (int i = 0; i < 4; ++i) { const float4 v4 = *(const float4*)(src + i * 256 + lane * 4); xv[i * 4] = v4.x; xv[i * 4 + 1] = v4.y; xv[i * 4 + 2] = v4.z; xv[i * 4 + 3] = v4.w; }
        } else {
            const int lp = (MODE == 2) ? 1 : 0;
            const float* src = p.xres + (size_t)t * D;
            const float* g2 = p.mod + (size_t)(lp * 9 + mr) * 6144 + 5 * 1024;
            const bf16_t* y0 = p.y + (size_t)(2 * t) * D; const bf16_t* y1 = y0 + D;
#pragma unroll
            for (int i = 0; i < 4; ++i) {
                const int c0 = i * 256 + lane * 4;
                const float4 v4 = *(const float4*)(src + c0); const float4 g4 = *(const float4*)(g2 + c0);
                const uint2 a = *(const uint2*)(y0 + c0), b = *(const uint2*)(y1 + c0);
                xv[i * 4] = v4.x + g4.x * (bflo(a.x) + bflo(b.x)); xv[i * 4 + 1] = v4.y + g4.y * (bfhi(a.x) + bfhi(b.x));
                xv[i * 4 + 2] = v4.z + g4.z * (bflo(a.y) + bflo(b.y)); xv[i * 4 + 3] = v4.w + g4.w * (bfhi(a.y) + bfhi(b.y));
            }
            if (MODE == 1) {
#pragma unroll
                for (int i = 0; i < 4; ++i) *(float4*)(p.xres + (size_t)t * D + i * 256 + lane * 4) = make_float4(xv[i * 4], xv[i * 4 + 1], xv[i * 4 + 2], xv[i * 4 + 3]);
            }
        }
        float ss = 0.f;
#pragma unroll
        for (int i = 0; i < 16; ++i) ss += xv[i] * xv[i];
        ss = wave_sum(ss);
        const float rstd = rsqrtf(ss * (1.f / D) + EPS);
        if (MODE == 2) {
#pragma unroll
            for (int i = 0; i < 4; ++i) {
                const int c0 = i * 256 + lane * 4; const float4 g4 = *(const float4*)(p.final_g + c0);
                *(float4*)(p.out + (size_t)t * D + c0) = make_float4(xv[i * 4] * rstd * g4.x, xv[i * 4 + 1] * rstd * g4.y, xv[i * 4 + 2] * rstd * g4.z, xv[i * 4 + 3] * rstd * g4.w);
            }
        } else {
            const float* ng = p.norm1_g + l * D; const float* mm = p.mod + (size_t)(l * 9 + mr) * 6144;
#pragma unroll
            for (int i = 0; i < 4; ++i) {
                const int c0 = i * 256 + lane * 4;
                const float4 g4 = *(const float4*)(ng + c0), sh = *(const float4*)(mm + c0), sc = *(const float4*)(mm + 1024 + c0);
                const float o0 = xv[i * 4] * rstd * g4.x * (1.f + sc.x) + sh.x, o1 = xv[i * 4 + 1] * rstd * g4.y * (1.f + sc.y) + sh.y;
                const float o2 = xv[i * 4 + 2] * rstd * g4.z * (1.f + sc.z) + sh.z, o3 = xv[i * 4 + 3] * rstd * g4.w * (1.f + sc.w) + sh.w;
                *(uint2*)(p.xn + (size_t)t * D + c0) = make_uint2(pack2(o0, o1), pack2(o2, o3));
            }
        }
    }
}

struct EpiIn {
    static constexpr bool PERM = true;
    const P* pp; int l; const LAS float* rope;
    DEV void operator()(const f32x4 (&acc)[2][2][4][2], const pg8::Unit& u, int wr, int wc, int fr, int fq) const {
        const P& p = *pp;
        const int pn = u.pn;
        const bool lat = u.pm < TL / 256;
        const bool is_qk = (pn < 2) || (pn == 2 && wc < 2);
        const float qs = pn < 2 ? attn_body_C2 : 1.f;
        bf16_t* dst; int ld; bool kvmap = false;
        if (pn < 2) { dst = p.q + (pn * 4 + wc) * 64; ld = 512; }
        else if (pn == 2) { dst = (wc < 2 ? p.k + wc * 64 : p.v + (wc - 2) * 64); ld = 128; kvmap = true; }
        else if (pn < 5) { dst = p.u + (pn - 3) * 256 + wc * 64; ld = 512; }
        else { dst = p.gb + (pn - 5) * 256 + wc * 64; ld = 512; }
        float gq[2][2][4];
#pragma unroll
        for (int bj = 0; bj < 2; ++bj)
#pragma unroll
            for (int n = 0; n < 2; ++n)
#pragma unroll
                for (int j = 0; j < 4; ++j) gq[bj][n][j] = 1.f;
        if (is_qk) {
            const float* g = (pn < 2 ? p.q_norm_g : p.k_norm_g) + l * 64;
#pragma unroll
            for (int bj = 0; bj < 2; ++bj)
#pragma unroll
                for (int n = 0; n < 2; ++n) { const float4 g4 = *(const float4*)(g + 32 * bj + 8 * fq + 4 * n); gq[bj][n][0] = g4.x; gq[bj][n][1] = g4.y; gq[bj][n][2] = g4.z; gq[bj][n][3] = g4.w; }
        }
#pragma unroll
        for (int ai = 0; ai < 2; ++ai)
#pragma unroll
            for (int m = 0; m < 4; ++m) {
                const int t = u.pm * 256 + ai * 128 + wr * 64 + m * 16 + fr;
                float v[2][2][4];
#pragma unroll
                for (int bj = 0; bj < 2; ++bj)
#pragma unroll
                    for (int n = 0; n < 2; ++n)
#pragma unroll
                        for (int j = 0; j < 4; ++j) v[bj][n][j] = acc[ai][bj][m][n][j];
                if (is_qk) {
                    float ss = 0.f;
#pragma unroll
                    for (int bj = 0; bj < 2; ++bj)
#pragma unroll
                        for (int n = 0; n < 2; ++n)
#pragma unroll
                            for (int j = 0; j < 4; ++j) ss += v[bj][n][j] * v[bj][n][j];
                    ss += __shfl_xor(ss, 16); ss += __shfl_xor(ss, 32);
                    const float rstd = rsqrtf(ss * (1.f / 64.f) + EPS);
                    const int s = t & 2047;
#pragma unroll
                    for (int bj = 0; bj < 2; ++bj) {
                        const int pos = bj ? (s & 63) : (s >> 6);
#pragma unroll
                        for (int n = 0; n < 2; ++n) {
                            float cs4[4] = {1.f, 1.f, 1.f, 1.f}, sn4[4] = {0.f, 0.f, 0.f, 0.f};
                            if (lat) {
                                const int f0 = 8 * (fq & 1) + 4 * n;
                                const f32x4 c4 = *(const LAS f32x4*)(rope + pos * 16 + f0), s4 = *(const LAS f32x4*)(rope + 1024 + pos * 16 + f0);
                                cs4[0] = c4.x; cs4[1] = c4.y; cs4[2] = c4.z; cs4[3] = c4.w; sn4[0] = s4.x; sn4[1] = s4.y; sn4[2] = s4.z; sn4[3] = s4.w;
                            }
#pragma unroll
                            for (int j = 0; j < 4; ++j) {
                                const float w = v[bj][n][j] * gq[bj][n][j];
                                const float pw = __shfl_xor(w, 32);
                                const float o = (fq & 2) ? (w * cs4[j] + pw * sn4[j]) : (w * cs4[j] - pw * sn4[j]);
                                v[bj][n][j] = o * rstd * qs;
                            }
                        }
                    }
                }
                bf16_t* rowp = dst + (size_t)(kvmap ? kv_row(t) : t) * ld;
#pragma unroll
                for (int bj = 0; bj < 2; ++bj) {
                    u32x4 w; w.x = pack2(v[bj][0][0], v[bj][0][1]); w.y = pack2(v[bj][0][2], v[bj][0][3]); w.z = pack2(v[bj][1][0], v[bj][1][1]); w.w = pack2(v[bj][1][2], v[bj][1][3]);
                    *(u32x4*)(rowp + 32 * bj + 8 * fq) = w;
                }
            }
    }
};
struct EpiOut {
    static constexpr bool PERM = false;
    const P* pp; int l;
    DEV void operator()(const f32x4 (&acc)[2][2][4][2], const pg8::Unit& u, int wr, int wc, int fr, int fq) const {
        const P& p = *pp;
        const int col0 = u.pn * 256 + wc * 32 + 4 * fq;
        const int mr = u.pm < TL / 256 ? (u.pm >> 3) : 8;
        const float* g1 = p.mod + (size_t)(l * 9 + mr) * 6144 + 2048 + col0;
        f32x4 gv[2][2];
#pragma unroll
        for (int bj = 0; bj < 2; ++bj)
#pragma unroll
            for (int n = 0; n < 2; ++n) gv[bj][n] = *(const f32x4*)(g1 + bj * 128 + n * 16);
#pragma unroll
        for (int ai = 0; ai < 2; ++ai)
#pragma unroll
            for (int m = 0; m < 4; ++m) {
                const int t = u.pm * 256 + ai * 128 + wr * 64 + m * 16 + fr;
                const float* res = (l == 0) ? (t < TL ? p.x + (size_t)t * D : p.ctx + (size_t)(t - TL) * D) : p.xres + (size_t)t * D;
                float* o = p.xres + (size_t)t * D + col0;
#pragma unroll
                for (int bj = 0; bj < 2; ++bj)
#pragma unroll
                    for (int n = 0; n < 2; ++n) { const f32x4 r4 = *(const f32x4*)(res + col0 + bj * 128 + n * 16); *(f32x4*)(o + bj * 128 + n * 16) = r4 + gv[bj][n] * acc[ai][bj][m][n]; }
            }
    }
};
struct MoeUpDesc {
    const bf16_t* A; const bf16_t* Bt; int K; const LAS i32x2* ptab; const int* cnt; const int* list;
    DEV const char* a_base(const pg8::Unit&) const { return (const char*)A; }
    DEV const char* b_base(const pg8::Unit& u) const { const int e = ptab[u.pm].x; return (const char*)Bt + ((size_t)e * D + (size_t)u.pn * 256) * (D * 2); }
    DEV unsigned a_off(const pg8::Unit& u, int h, int R, int C) const {
        const i32x2 pe = ptab[u.pm]; const int pos = pe.y + h * 128 + R;
        const int tok = pos < cnt[pe.x] ? (list[pe.x * TT + pos] >> 1) : 0;
        return (unsigned)(tok * D + C) * 2u;
    }
};
struct MoeDownDesc {
    const bf16_t* A; const bf16_t* Bt; int K; const LAS i32x2* ptab;
    DEV const char* a_base(const pg8::Unit& u) const { return (const char*)A + (size_t)u.pm * (256 * DE * 2); }
    DEV const char* b_base(const pg8::Unit& u) const { const int e = ptab[u.pm].x; return (const char*)Bt + ((size_t)e * D + (size_t)u.pn * 256) * (DE * 2); }
    DEV unsigned a_off(const pg8::Unit&, int h, int R, int C) const { return (unsigned)((h * 128 + R) * DE + C) * 2u; }
};
struct EpiMoeUp {
    static constexpr bool PERM = true;
    bf16_t* hid;
    DEV void operator()(const f32x4 (&acc)[2][2][4][2], const pg8::Unit& u, int wr, int wc, int fr, int fq) const {
#pragma unroll
        for (int ai = 0; ai < 2; ++ai)
#pragma unroll
            for (int m = 0; m < 4; ++m) {
                bf16_t* rowp = hid + (size_t)(u.pm * 256 + ai * 128 + wr * 64 + m * 16 + fr) * DE + u.pn * 128 + wc * 16 + fq * 4;
#pragma unroll
                for (int bj = 0; bj < 2; ++bj) {
                    const f32x4 g = acc[ai][bj][m][0], up = acc[ai][bj][m][1];
                    float h[4];
#pragma unroll
                    for (int j = 0; j < 4; ++j) h[j] = g[j] * sigmoidf_(g[j]) * up[j];
                    *(u32x2*)(rowp + bj * 64) = (u32x2){pack2(h[0], h[1]), pack2(h[2], h[3])};
                }
            }
    }
};
struct EpiMoeDown {
    static constexpr bool PERM = true;
    bf16_t* y; const float* tokw; const LAS i32x2* ptab; const int* cnt; const int* list;
    DEV void operator()(const f32x4 (&acc)[2][2][4][2], const pg8::Unit& u, int wr, int wc, int fr, int fq) const {
        const i32x2 pe = ptab[u.pm]; const int ce = cnt[pe.x];
#pragma unroll
        for (int ai = 0; ai < 2; ++ai)
#pragma unroll
            for (int m = 0; m < 4; ++m) {
                const int pos = pe.y + ai * 128 + wr * 64 + m * 16 + fr;
                if (pos < ce) {
                    const int pair = list[pe.x * TT + pos]; const float wt = tokw[pair];
                    bf16_t* rowp = y + (size_t)pair * D + u.pn * 256 + wc * 32 + 8 * fq;
#pragma unroll
                    for (int bj = 0; bj < 2; ++bj) {
                        const f32x4 a0 = acc[ai][bj][m][0] * wt, a1 = acc[ai][bj][m][1] * wt;
                        *(u32x4*)(rowp + bj * 128) = (u32x4){pack2(a0[0], a0[1]), pack2(a0[2], a0[3]), pack2(a1[0], a1[1]), pack2(a1[2], a1[3])};
                    }
                }
            }
    }
};
DEV int moe_build_ptab(const int* cnt, LAS i32x2* ptab, int tid) {
    __syncthreads();
    if (tid < 64) {
        const int c = tid < NE ? cnt[tid] : 0;
        const int npan = (c + 255) >> 8;
        int incl = npan;
#pragma unroll
        for (int o = 1; o < 16; o <<= 1) { const int v = __shfl_up(incl, o); if (tid >= o) incl += v; }
        int base = incl - npan;
#pragma unroll 1
        for (int r0 = 0; r0 < c; r0 += 256) { ptab[base] = (i32x2){tid, r0}; ++base; }
        if (tid == NE - 1) ptab[MAXPANELS] = (i32x2){incl, 0};
    }
    __syncthreads();
    return ptab[MAXPANELS].x;
}

#include <hip/hip_bf16.h>
namespace attn_body {
using bf16=__hip_bfloat16;
using bf16x8=__attribute__((ext_vector_type(8)))short;
using s16x4=__attribute__((ext_vector_type(4)))short;
using f32x16=__attribute__((ext_vector_type(16)))float;
using u32x4=__attribute__((ext_vector_type(4)))unsigned;
constexpr int D=64,QP=512,KP=128;
constexpr int NW=8,QBLK=32,QB=QBLK*NW,KVBLK=64;
__device__ __forceinline__ int crow(int r,int hi){return (r&3)+8*(r>>2)+4*hi;}
#define SBAR() __builtin_amdgcn_sched_barrier(0)
constexpr int NSLOT=3, SLOTB=8192;
constexpr int LDS_K=0, LDS_V=NSLOT*SLOTB, LDS_WS=2*NSLOT*SLOTB, LDS_OST=LDS_WS+NW*64*4, LDS_BYTES=LDS_OST+NW*4096;
constexpr float C2=0.125f*1.4426950408889634f;
__device__ __forceinline__ void glds16(const void*gsrc,unsigned lds_dst){unsigned keep;
  asm volatile("s_mov_b32 %0, m0\n\ts_mov_b32 m0, %2\n\ts_nop 0\n\tglobal_load_lds_dwordx4 %1, off\n\ts_mov_b32 m0, %0":"=&s"(keep):"v"(gsrc),"s"(lds_dst):"memory");}
__device__ __forceinline__ float max3f(float a,float b,float c){float r;asm("v_max3_f32 %0, %1, %2, %3":"=v"(r):"v"(a),"v"(b),"v"(c));return r;}
__device__ __forceinline__ float max2f(float a,float b){float r;asm("v_max_f32_e32 %0, %1, %2":"=v"(r):"v"(a),"v"(b));return r;}
__device__ __forceinline__ float fadd_s(float a,float b){float r;asm("v_add_f32_e32 %0, %1, %2":"=v"(r):"v"(a),"v"(b));return r;}
__device__ __forceinline__ float fsub_s(float a,float b){float r;asm("v_sub_f32_e32 %0, %1, %2":"=v"(r):"v"(a),"v"(b));return r;}
typedef float f32x2_t __attribute__((ext_vector_type(2))); typedef __bf16 bf16x2_t __attribute__((ext_vector_type(2)));
__device__ __forceinline__ unsigned cvtpk_s(float lo,float hi){f32x2_t v={lo,hi};bf16x2_t b=__builtin_convertvector(v,bf16x2_t);return __builtin_bit_cast(unsigned,b);}
#define WAIT_BAR(N) asm volatile("s_waitcnt vmcnt(" #N ") lgkmcnt(0)\n\ts_barrier":::"memory")

__device__ __forceinline__ void qkt(f32x16&p0,f32x16&p1,const char*Kslot,const bf16x8*qr,const f32x16&negm,int r32,int hi){
  const char*kb=Kslot+hi*1024+r32*16;
  #pragma unroll
  for(int d0=0;d0<4;++d0){
    const bf16x8 b0=*reinterpret_cast<const bf16x8*>(kb+d0*2048);
    const bf16x8 b1=*reinterpret_cast<const bf16x8*>(kb+d0*2048+512);
    if(d0==0){p0=__builtin_amdgcn_mfma_f32_32x32x16_bf16(b0,qr[0],negm,0,0,0);p1=__builtin_amdgcn_mfma_f32_32x32x16_bf16(b1,qr[0],negm,0,0,0);}
    else{p0=__builtin_amdgcn_mfma_f32_32x32x16_bf16(b0,qr[d0],p0,0,0,0);p1=__builtin_amdgcn_mfma_f32_32x32x16_bf16(b1,qr[d0],p1,0,0,0);}}
}
typedef __attribute__((address_space(3))) const char* lds_cptr;
typedef short v4i16_t __attribute__((ext_vector_type(4)));
__device__ __forceinline__ void kload8(bf16x8*kf,lds_cptr kp){
  kf[0]=*(const __attribute__((address_space(3))) bf16x8*)(kp);      kf[1]=*(const __attribute__((address_space(3))) bf16x8*)(kp+512);
  kf[2]=*(const __attribute__((address_space(3))) bf16x8*)(kp+2048); kf[3]=*(const __attribute__((address_space(3))) bf16x8*)(kp+2560);
  kf[4]=*(const __attribute__((address_space(3))) bf16x8*)(kp+4096); kf[5]=*(const __attribute__((address_space(3))) bf16x8*)(kp+4608);
  kf[6]=*(const __attribute__((address_space(3))) bf16x8*)(kp+6144); kf[7]=*(const __attribute__((address_space(3))) bf16x8*)(kp+6656);
}
__device__ __forceinline__ void kload2(bf16x8*kf,lds_cptr kp,int j){ kf[2*j]=*(const __attribute__((address_space(3))) bf16x8*)(kp+j*2048); kf[2*j+1]=*(const __attribute__((address_space(3))) bf16x8*)(kp+j*2048+512); }
__device__ __forceinline__ s16x4 vtr(lds_cptr p){ return __builtin_bit_cast(s16x4,__builtin_amdgcn_ds_read_tr16_b64_v4i16((__attribute__((address_space(3))) v4i16_t*)p)); }
__device__ __forceinline__ float rowmax(const f32x16&p0,const f32x16&p1){
  float a=max3f(p0[0],p0[1],p1[0]),b=max3f(p0[2],p0[3],p1[1]);a=max3f(a,p1[2],p1[3]);
  #pragma unroll
  for(int r=4;r<16;r+=4){a=max3f(a,p0[r],p0[r+1]);b=max3f(b,p0[r+2],p0[r+3]);a=max3f(a,p1[r],p1[r+1]);b=max3f(b,p1[r+2],p1[r+3]);}
  const float m=max2f(a,b);
  auto rr=__builtin_amdgcn_permlane32_swap(__float_as_uint(m),__float_as_uint(m),false,false);
  return max2f(__uint_as_float(rr[0]),__uint_as_float(rr[1]));
}
__device__ __forceinline__ void pv(f32x16*o,int vb,bf16x8 pa0,bf16x8 pa1,bf16x8 pa2,bf16x8 pa3){
  #pragma unroll
  for(int d0=0;d0<2;++d0){s16x4 lo[4],hi[4];
    #pragma unroll
    for(int ks=0;ks<4;++ks){
      asm volatile("ds_read_b64_tr_b16 %0,%1 offset:%c2":"=&v"(lo[ks]):"v"(vb),"i"(d0*4096+ks*1024):"memory");
      asm volatile("ds_read_b64_tr_b16 %0,%1 offset:%c2":"=&v"(hi[ks]):"v"(vb),"i"(d0*4096+ks*1024+512):"memory");}
    asm volatile("s_waitcnt lgkmcnt(0)":::"memory");SBAR();
    #define PK(k) (bf16x8){lo[k][0],lo[k][1],lo[k][2],lo[k][3],hi[k][0],hi[k][1],hi[k][2],hi[k][3]}
    o[d0]=__builtin_amdgcn_mfma_f32_32x32x16_bf16(pa0,PK(0),o[d0],0,0,0);
    o[d0]=__builtin_amdgcn_mfma_f32_32x32x16_bf16(pa1,PK(1),o[d0],0,0,0);
    o[d0]=__builtin_amdgcn_mfma_f32_32x32x16_bf16(pa2,PK(2),o[d0],0,0,0);
    o[d0]=__builtin_amdgcn_mfma_f32_32x32x16_bf16(pa3,PK(3),o[d0],0,0,0);
    #undef PK
  }
}

#ifndef ATTN_STORE16
#define ATTN_STORE16(p,v) (*(u32x4*)(p)=(v))
#endif
template<int THRL> __device__ __forceinline__ void attn_unit(const bf16*Qu,const bf16*__restrict__ Kh,const bf16*__restrict__ Vh,bf16*Ou,const int NT,char*shm,const int tid){
  const int lane=tid&63,r32=lane&31,hi=lane>>5; const int wid=__builtin_amdgcn_readfirstlane(tid>>6);
  const bf16*Qw=Qu+(long)(wid*QBLK)*QP;
  const unsigned lds0=(unsigned)(uintptr_t)shm;
  float*wsf=(float*)(shm+LDS_WS)+wid*64;
  const bf16*ksrc=Kh+(long)lane*KP+wid*8;
  const bf16*vsrc=Vh+(long)(16*(wid&3)+(lane>>2))*KP+(wid>>2)*32+(lane&3)*8;
  const unsigned kdst=lds0+LDS_K+wid*1024, vdst=lds0+LDS_V+wid*1024;
  #define DMA_K(t,slot) glds16(ksrc+(long)(t)*KVBLK*KP,(unsigned)__builtin_amdgcn_readfirstlane(kdst+(slot)))
  #define DMA_V(t,slot) glds16(vsrc+(long)(t)*KVBLK*KP,(unsigned)__builtin_amdgcn_readfirstlane(vdst+(slot)))
  const int vb0=(int)(lds0+LDS_V)+((lane>>4)&1)*32+(lane&3)*8+(4*hi+((lane&15)>>2))*64;
  const char*Kbase=shm+LDS_K; bf16x8 kf[8];
  const lds_cptr shm3=(lds_cptr)shm; const lds_cptr kp0=shm3+LDS_K+hi*1024+r32*16; const lds_cptr vp0=shm3+LDS_V+((lane>>4)&1)*32+(lane&3)*8+(4*hi+((lane&15)>>2))*64;
  DMA_K(0,0);DMA_V(0,0);DMA_K(1,SLOTB);
  bf16x8 qr[4];
  #pragma unroll
  for(int d0=0;d0<4;++d0)qr[d0]=*reinterpret_cast<const bf16x8*>(&Qw[(long)r32*QP+d0*16+hi*8]);
  float mhat=0.f,l_reg=0.f;f32x16 o[2];o[0]=f32x16{};o[1]=f32x16{};f32x16 negm=f32x16{};asm volatile("":"+v"(negm));
  #define CMASK(P0,P1,t) do{}while(0)
  bool resc=false;
  #define START(P0,P1) do{ const float rm=rowmax(P0,P1); resc=false; \
    { const float dl=rm; mhat=fadd_s(mhat,dl); \
      _Pragma("unroll") for(int r=0;r<16;++r){P0[r]=fsub_s(P0[r],dl);P1[r]=fsub_s(P1[r],dl);} \
      _Pragma("unroll") for(int r=0;r<16;++r)negm[r]=-mhat; asm volatile("":"+v"(negm)); } \
    _Pragma("unroll") for(int r=0;r<16;++r)P0[r]=__builtin_amdgcn_exp2f(P0[r]); }while(0)
  #define RESC() do{ if(resc){ asm volatile("s_waitcnt lgkmcnt(0)":::"memory"); \
      _Pragma("unroll") for(int d_=0;d_<2;++d_) _Pragma("unroll") for(int r=0;r<16;++r)o[d_][r]*=wsf[crow(r,hi)]; } }while(0)
  f32x16 pA0,pA1,pB0,pB1;
  int sl_prev=0,sl_cur=0,sl_next=SLOTB;
  #define ROT() do{sl_prev=sl_cur;sl_cur=sl_next;sl_next=(sl_next==(NSLOT-1)*SLOTB)?0:sl_next+SLOTB;}while(0)
  DMA_K(2,2*SLOTB);
  WAIT_BAR(3);
  qkt(pA0,pA1,Kbase,qr,negm,r32,hi);asm volatile("s_nop 15\n\ts_nop 7":"+v"(pA0),"+v"(pA1));CMASK(pA0,pA1,0);
  START(pA0,pA1);
  _Pragma("unroll") for(int r=0;r<16;++r)pA1[r]=__builtin_amdgcn_exp2f(pA1[r]);
  WAIT_BAR(0);
  DMA_K(3,0);DMA_V(1,SLOTB);
  ROT();
  kload8(kf,kp0+sl_cur);
  WAIT_BAR(2);
  s16x4 vlo[8],vhi[8]; u32x4 pw0,pw1,pw2,pw3;
  #define PKW(P,B) cvtpk_s(P[B],P[B+1])
  #define PAF(k) __builtin_bit_cast(bf16x8,pw##k)
  #define VFR(i) (bf16x8){vlo[i][0],vlo[i][1],vlo[i][2],vlo[i][3],vhi[i][0],vhi[i][1],vhi[i][2],vhi[i][3]}
  #define PIN(x) asm volatile("":"+v"(x))
  #define MX3(a,b,c) __builtin_fmaxf(__builtin_fmaxf((a),(b)),(c))
  #define GAPA(MF,A0,A1,A2,A3,W0,W1,PW) do{ MF; sacc+=A0; sacc+=A1; sacc+=A2; sacc+=A3; PIN(sacc); W0; W1; PIN(PW); SBAR(); }while(0)
  #define EX(v) __builtin_amdgcn_exp2f(v)
  #define GAPB(MF,X,B) do{ MF; X[B]=EX(X[B]); X[B+1]=EX(X[B+1]); X[B+2]=EX(X[B+2]); X[B+3]=EX(X[B+3]); PIN(X); SBAR(); }while(0)
  #define VRD(i) do{ vlo[i]=vtr(vp_+(((i)>>2)*4096+((i)&3)*1024)); vhi[i]=vtr(vp_+(((i)>>2)*4096+((i)&3)*1024+512)); }while(0)
  #define KRD(G,j) do{ if(G){ kload2(kf,kp0+sl_next,j); SBAR(); } }while(0)
  #define STEP(C0,C1,P0,P1,t,GK,GV,GL) do{ SBAR(); \
    const lds_cptr vp_=vp0+sl_prev; \
    VRD(0); SBAR(); float sacc=(P0[0]+P0[1]); \
    GAPA(C0=__builtin_amdgcn_mfma_f32_32x32x16_bf16(kf[0],qr[0],negm,0,0,0), P0[2],P0[3],P0[4],P0[5],     pw0[0]=PKW(P0,0), pw0[1]=PKW(P0,2), pw0); \
    VRD(4); SBAR(); GAPA(C1=__builtin_amdgcn_mfma_f32_32x32x16_bf16(kf[1],qr[0],negm,0,0,0), P0[6],P0[7],P0[8],P0[9],     pw0[2]=PKW(P0,4), pw0[3]=PKW(P0,6), pw0); \
    VRD(1); SBAR(); GAPA(C0=__builtin_amdgcn_mfma_f32_32x32x16_bf16(kf[2],qr[1],C0,0,0,0),   P0[10],P0[11],P0[12],P0[13], pw1[0]=PKW(P0,8), pw1[1]=PKW(P0,10), pw1); \
    VRD(5); SBAR(); GAPA(C1=__builtin_amdgcn_mfma_f32_32x32x16_bf16(kf[3],qr[1],C1,0,0,0),   P0[14],P0[15],P1[0],P1[1],   pw1[2]=PKW(P0,12),pw1[3]=PKW(P0,14), pw1); \
    VRD(2); SBAR(); GAPA(C0=__builtin_amdgcn_mfma_f32_32x32x16_bf16(kf[4],qr[2],C0,0,0,0),   P1[2],P1[3],P1[4],P1[5],     pw2[0]=PKW(P1,0), pw2[1]=PKW(P1,2), pw2); \
    VRD(6); SBAR(); GAPA(C1=__builtin_amdgcn_mfma_f32_32x32x16_bf16(kf[5],qr[2],C1,0,0,0),   P1[6],P1[7],P1[8],P1[9],     pw2[2]=PKW(P1,4), pw2[3]=PKW(P1,6), pw2); \
    VRD(3); SBAR(); GAPA(C0=__builtin_amdgcn_mfma_f32_32x32x16_bf16(kf[6],qr[3],C0,0,0,0),   P1[10],P1[11],P1[12],P1[13], pw3[0]=PKW(P1,8), pw3[1]=PKW(P1,10), pw3); \
    VRD(7); SBAR(); GAPA(C1=__builtin_amdgcn_mfma_f32_32x32x16_bf16(kf[7],qr[3],C1,0,0,0),   P1[14],P1[15],0.f,0.f,       pw3[2]=PKW(P1,12),pw3[3]=PKW(P1,14), pw3); \
    l_reg+=sacc; \
    if(GK){DMA_K((t)+3,sl_cur);} if(GV){DMA_V((t)+1,sl_next);} \
    CMASK(C0,C1,t); \
    { float a=MX3(C0[0],C0[1],C1[0]),b=MX3(C0[2],C0[3],C1[1]); a=MX3(a,C1[2],C1[3]); \
      _Pragma("unroll") for(int r=4;r<16;r+=4){a=MX3(a,C0[r],C0[r+1]);b=MX3(b,C0[r+2],C0[r+3]);a=MX3(a,C1[r],C1[r+1]);b=MX3(b,C1[r+2],C1[r+3]);} \
      float rm=__builtin_fmaxf(a,b); { auto rr=__builtin_amdgcn_permlane32_swap(__float_as_uint(rm),__float_as_uint(rm),false,false); rm=__builtin_fmaxf(__uint_as_float(rr[0]),__uint_as_float(rr[1])); } \
      resc=false; \
      if(__builtin_expect(__any(rm>(float)THRL),0)){ const float dl=__builtin_fmaxf(rm,0.f); mhat+=dl; \
        _Pragma("unroll") for(int r=0;r<16;++r){C0[r]-=dl;C1[r]-=dl;} \
        _Pragma("unroll") for(int r=0;r<16;++r)negm[r]=-mhat; asm volatile("":"+v"(negm)); \
        const float f=__builtin_amdgcn_exp2f(-dl); l_reg*=f; if(hi==0)wsf[r32]=f; resc=true; } } \
    SBAR(); \
    GAPB(o[0]=__builtin_amdgcn_mfma_f32_32x32x16_bf16(PAF(0),VFR(0),o[0],0,0,0), C0,0); \
    GAPB(o[1]=__builtin_amdgcn_mfma_f32_32x32x16_bf16(PAF(0),VFR(4),o[1],0,0,0), C0,4); \
    KRD(GL,0); GAPB(o[0]=__builtin_amdgcn_mfma_f32_32x32x16_bf16(PAF(1),VFR(1),o[0],0,0,0), C0,8); \
    KRD(GL,1); GAPB(o[1]=__builtin_amdgcn_mfma_f32_32x32x16_bf16(PAF(1),VFR(5),o[1],0,0,0), C0,12); \
    KRD(GL,2); GAPB(o[0]=__builtin_amdgcn_mfma_f32_32x32x16_bf16(PAF(2),VFR(2),o[0],0,0,0), C1,0); \
    KRD(GL,3); GAPB(o[1]=__builtin_amdgcn_mfma_f32_32x32x16_bf16(PAF(2),VFR(6),o[1],0,0,0), C1,4); \
    GAPB(o[0]=__builtin_amdgcn_mfma_f32_32x32x16_bf16(PAF(3),VFR(3),o[0],0,0,0), C1,8); \
    GAPB(o[1]=__builtin_amdgcn_mfma_f32_32x32x16_bf16(PAF(3),VFR(7),o[1],0,0,0), C1,12); \
    }while(0)
  int t=1;
  #undef CMASK
  #define CMASK(P0,P1,t) do{}while(0)
  for(;t+5<NT;t+=2){
    STEP(pB0,pB1,pA0,pA1,t,true,true,true);     WAIT_BAR(2); RESC(); ROT();
    STEP(pA0,pA1,pB0,pB1,t+1,true,true,true);   WAIT_BAR(2); RESC(); ROT();
  }
  #undef CMASK
  #define CMASK(P0,P1,t) do{}while(0)
  #define ENDW(tt) do{ if((tt)+3<NT){WAIT_BAR(2);} else if((tt)+2<NT){WAIT_BAR(1);} else {WAIT_BAR(0);} }while(0)
  for(;t+1<NT;t+=2){
    STEP(pB0,pB1,pA0,pA1,t,(t+3<NT),(t+1<NT),(t+1<NT));       ENDW(t);   RESC(); ROT();
    STEP(pA0,pA1,pB0,pB1,t+1,(t+4<NT),(t+2<NT),(t+2<NT));     ENDW(t+1); RESC(); ROT();
  }
  STEP(pB0,pB1,pA0,pA1,NT-1,false,false,false); RESC();
  { float sacc=pB0[0]+pB0[1]; _Pragma("unroll") for(int r=2;r<16;++r)sacc+=pB0[r]; _Pragma("unroll") for(int r=0;r<16;++r)sacc+=pB1[r]; l_reg+=sacc;
    pw0=(u32x4){PKW(pB0,0),PKW(pB0,2),PKW(pB0,4),PKW(pB0,6)};pw1=(u32x4){PKW(pB0,8),PKW(pB0,10),PKW(pB0,12),PKW(pB0,14)};pw2=(u32x4){PKW(pB1,0),PKW(pB1,2),PKW(pB1,4),PKW(pB1,6)};pw3=(u32x4){PKW(pB1,8),PKW(pB1,10),PKW(pB1,12),PKW(pB1,14)};
    SBAR(); pv(o,vb0+sl_cur,PAF(0),PAF(1),PAF(2),PAF(3)); }
  #undef PKW
  #undef PAF
  #undef VFR
  #undef PIN
  #undef MX3
  #undef GAPA
  #undef GAPB
  #undef EX
  #undef VRD
  #undef KRD
  #undef STEP
  #undef ENDW
  {auto rr=__builtin_amdgcn_permlane32_swap(__float_as_uint(l_reg),__float_as_uint(l_reg),false,false);l_reg=__uint_as_float(rr[0])+__uint_as_float(rr[1]);}
  if(hi==0)wsf[32+r32]=l_reg;asm volatile("s_waitcnt lgkmcnt(0)":::"memory");
  float rli[16];
  #pragma unroll
  for(int r=0;r<16;++r)rli[r]=__builtin_amdgcn_rcpf(wsf[32+crow(r,hi)]);
  bf16*Ow=Ou+(long)(wid*QBLK)*QP;
  { bf16*stg=(bf16*)(shm+LDS_OST)+wid*2048;
    #pragma unroll
    for(int r=0;r<16;++r){const int orow=crow(r,hi);
      #pragma unroll
      for(int d0=0;d0<2;++d0)stg[orow*64+d0*32+r32]=__float2bfloat16(o[d0][r]*rli[r]);}
    asm volatile("s_waitcnt lgkmcnt(0)":::"memory");
    #pragma unroll
    for(int i=0;i<4;++i){const int row=i*8+(lane>>3),ch=lane&7; const u32x4 v=*(const u32x4*)(stg+row*64+ch*8); ATTN_STORE16(Ow+(long)row*QP+ch*8,v);} }
  asm volatile("s_waitcnt lgkmcnt(0)\n\ts_barrier":::"memory");
  #undef DMA_K
  #undef DMA_V
  #undef CMASK
  #undef START
  #undef RESC
  #undef ROT
}
constexpr int ATTN_LDS_BYTES=LDS_BYTES;
#undef SBAR
#undef WAIT_BAR
}

DEV void lru_chunk_item(const P& p, int l, int item, LAS unsigned char* lds, int tid);
DEV void phase_attn_lru(const P& p, int l, LAS unsigned char* lds, volatile LAS unsigned* misc, int tid) {
    const int nattn = (l == 0) ? 512 + 64 : 512, nitems = nattn + NB * 8 * 18;
    for (;;) {
        __syncthreads();
        if (tid == 0) misc[4] = (unsigned)atomicAdd(p.qctr + l, 1);
        __syncthreads();
        const int u = (int)misc[4];
        if (u >= nitems) break;
        int t2 = tid; asm volatile("" : "+v"(t2));
        if (u >= nattn) { lru_chunk_item(p, l, u - nattn, lds, t2); continue; }
        int b, h, qrow0, nt;
        if (u < 512) { b = u >> 6; h = (u >> 3) & 7; qrow0 = b * S + (u & 7) * 256; nt = KVS / 64; }
        else { const int u2 = u - 512; b = u2 >> 3; h = u2 & 7; qrow0 = TL + b * CL; nt = CL / 64; }
        attn_body::bf16* qp = (attn_body::bf16*)(p.q + (size_t)qrow0 * 512 + h * 64);
        const attn_body::bf16* kp = (const attn_body::bf16*)(p.k + (size_t)b * KVS * 128 + (h >> 2) * 64);
        const attn_body::bf16* vp = (const attn_body::bf16*)(p.v + (size_t)b * KVS * 128 + (h >> 2) * 64);
        attn_body::attn_unit<8>(qp, kp, vp, qp, nt, (char*)lds, t2);
    }
}

constexpr int NCHK = 18;
constexpr int LRU_URAW = 0  , LRU_UB = 16896  , LRU_A = LRU_UB + 18432, LRU_B = LRU_A + 32768, LRU_SEG = LRU_B + 32768  ,
              LRU_PAR = LRU_SEG + 4096  , LRU_END = LRU_PAR + 1280;
static_assert(LRU_END <= RING_BYTES, "LRU LDS map");
DEV void lru_chunk_item(const P& p, int l, int item, LAS unsigned char* lds, int tid) {
    const int c = item % NCHK, n = (item / NCHK) & 7, b = item / (NCHK * 8);
    const int lane = tid & 63, w = __builtin_amdgcn_readfirstlane(tid >> 6), q = lane & 15, cg = lane >> 4;
    LAS bf16_t* Uraw = (LAS bf16_t*)(lds + LRU_URAW);
    LAS bf16_t* Ub = (LAS bf16_t*)(lds + LRU_UB);
    LAS float* Aa = (LAS float*)(lds + LRU_A);
    LAS float* Bb = (LAS float*)(lds + LRU_B);
    LAS float* seg = (LAS float*)(lds + LRU_SEG);
    LAS float* par = (LAS float*)(lds + LRU_PAR);
    const bool isctx = c < 2;
    const int seqbase = isctx ? TL + b * CL : b * S, seqlen = isctx ? CL : S, t0 = isctx ? 128 * c : 128 * (c - 2);
    __syncthreads();
    for (int i = tid; i < 131 * 8; i += NTHR) {
        const int r = i >> 3, pc = i & 7, tok = t0 - 2 + r;
        u32x4 v = (u32x4){0u, 0u, 0u, 0u};
        if (tok >= 0 && tok < seqlen) v = *(const u32x4*)(p.u + (size_t)(seqbase + tok) * 512 + n * 64 + pc * 8);
        *(LAS u32x4*)(Uraw + r * 64 + pc * 8) = v;
    }
    if (tid < 64) {
        par[tid] = p.conv_b[l * 512 + n * 64 + tid];
#pragma unroll
        for (int j = 0; j < 4; ++j) par[64 + j * 64 + tid] = p.conv_w[(l * 4 + j) * 512 + n * 64 + tid];
    }
    __syncthreads();
    float uc[4][4];
#pragma unroll
    for (int ct = 0; ct < 4; ++ct) {
        const int ch0 = ct * 16 + cg * 4;
        f32x4 acc = *(const LAS f32x4*)(par + ch0);
#pragma unroll
        for (int j = 0; j < 4; ++j) {
            const u32x2 raw = *(const LAS u32x2*)(Uraw + (16 * w + q + j) * 64 + ch0); const f32x4 cw = *(const LAS f32x4*)(par + 64 + j * 64 + ch0);
            acc[0] += bflo(raw.x) * cw[0]; acc[1] += bfhi(raw.x) * cw[1]; acc[2] += bflo(raw.y) * cw[2]; acc[3] += bfhi(raw.y) * cw[3];
        }
        uc[ct][0] = acc[0]; uc[ct][1] = acc[1]; uc[ct][2] = acc[2]; uc[ct][3] = acc[3];
        *(LAS u32x2*)(Ub + (16 * w + q) * 72 + ch0) = (u32x2){pack2(acc[0], acc[1]), pack2(acc[2], acc[3])};
    }
    asm volatile("s_waitcnt lgkmcnt(0)" ::: "memory");
    bf16x8 bu[2];
#pragma unroll
    for (int ks = 0; ks < 2; ++ks) bu[ks] = *(const LAS bf16x8*)(Ub + (16 * w + q) * 72 + ks * 32 + cg * 8);
#pragma unroll 1
    for (int d = 0; d < 2; ++d) {
        const int pbase = (l * 2 + d) * 512 + n * 64;
        const bf16_t* wl = p.wt_lru + (size_t)(((l * 2 + d) * 8 + n) * 2) * 4096;
        f32x4 pre[2][4];
#pragma unroll
        for (int g = 0; g < 2; ++g)
#pragma unroll
            for (int ct = 0; ct < 4; ++ct) {
                f32x4 a4 = (f32x4){0.f, 0.f, 0.f, 0.f};
#pragma unroll
                for (int ks = 0; ks < 2; ++ks) { const bf16x8 wv = *(const bf16x8*)(wl + (g * 64 + ct * 16 + q) * 64 + (ks * 4 + cg) * 8); a4 = __builtin_amdgcn_mfma_f32_16x16x32_bf16(wv, bu[ks], a4, 0, 0, 0); }
                pre[g][ct] = a4;
            }
#pragma unroll
        for (int ct = 0; ct < 4; ++ct) {
            const int ch0 = ct * 16 + cg * 4;
            const f32x4 ba = *(const f32x4*)(p.lru_ba + pbase + ch0), bx = *(const f32x4*)(p.lru_bx + pbase + ch0), sp = *(const f32x4*)(p.sptab + pbase + ch0);
            f32x4 av, bv;
#pragma unroll
            for (int j = 0; j < 4; ++j) {
                const float r = sigmoidf_(pre[0][ct][j] + ba[j]), ig = sigmoidf_(pre[1][ct][j] + bx[j]);
                const float log_a = -8.f * r * sp[j];
                av[j] = __expf(log_a);
                bv[j] = __builtin_amdgcn_sqrtf(fmaxf(1.f - __expf(2.f * log_a), 0.f)) * (ig * uc[ct][j]);
            }
            *(LAS f32x4*)(Aa + (16 * w + q) * 64 + ch0) = av; *(LAS f32x4*)(Bb + (16 * w + q) * 64 + ch0) = bv;
        }
        asm volatile("s_waitcnt lgkmcnt(0)" ::: "memory");
        {
            float A = 1.f, H = 0.f;
#pragma unroll
            for (int kk = 0; kk < 16; ++kk) {
                const int pp = d == 0 ? kk : 15 - kk;
                const float a = Aa[(16 * w + pp) * 64 + lane], bb = Bb[(16 * w + pp) * 64 + lane];
                H = a * H + bb; A = A * a;
                Aa[(16 * w + pp) * 64 + lane] = A; Bb[(16 * w + pp) * 64 + lane] = H;
            }
            seg[w * 64 + lane] = A; seg[512 + w * 64 + lane] = H;
        }
        __syncthreads();
        float hin = 0.f, apre = 1.f;
        if (d == 0) { for (int sgi = 0; sgi < w; ++sgi) { const float sa = seg[sgi * 64 + lane]; hin = sa * hin + seg[512 + sgi * 64 + lane]; apre *= sa; } }
        else { for (int sgi = 7; sgi > w; --sgi) { const float sa = seg[sgi * 64 + lane]; hin = sa * hin + seg[512 + sgi * 64 + lane]; apre *= sa; } }
        if (w == (d == 0 ? 7 : 0)) {
            const float sa = seg[w * 64 + lane]; const size_t ti = ((size_t)((b * 2 + d) * NCHK + c)) * 512 + n * 64 + lane;
            p.totA[ti] = apre * sa; p.totH[ti] = sa * hin + seg[512 + w * 64 + lane];
        }
        {
            const size_t o0 = ((size_t)d * TT + seqbase + t0 + 16 * w) * 512 + n * 64 + lane;
            bf16_t* hp = p.hl + o0; bf16_t* ap = p.ac + o0;
#pragma unroll
            for (int pp = 0; pp < 16; ++pp) {
                const float aq = Aa[(16 * w + pp) * 64 + lane];
                hp[(size_t)pp * 512] = (bf16_t)f2bf(Bb[(16 * w + pp) * 64 + lane] + aq * hin); ap[(size_t)pp * 512] = (bf16_t)f2bf(aq * apre);
            }
        }
        __syncthreads();
    }
}

DEV void phase_mix(const P& p, int l, int bid, int nb, LAS unsigned char* lds) {
    const int tid = otid(), lane = tid & 63, wv = tid >> 6;
    LAS float* cin = (LAS float*)lds;
    const int nitems = NB * NCHK;
    for (int it = bid; it < nitems; it += nb) {
        const int b = it / NCHK, c = it - b * NCHK;
        if (l == 1 && c < 2) continue;
        __syncthreads();
        {
            const int ch = tid;
            const float* tA = p.totA + (size_t)(b * 2) * NCHK * 512 + ch; const float* tH = p.totH + (size_t)(b * 2) * NCHK * 512 + ch;
            float h = 0.f;
            for (int cc = 0; cc < c; ++cc) h = tA[cc * 512] * h + tH[cc * 512];
            cin[ch] = h;
            tA += NCHK * 512; tH += NCHK * 512;
            h = 0.f;
            if (c == 0) h = tH[512];
            else if (c >= 2) {
                h = tA[0] * tH[512] + tH[0];
                for (int cc = NCHK - 1; cc > c; --cc) h = tA[cc * 512] * h + tH[cc * 512];
            }
            cin[512 + ch] = h;
        }
        __syncthreads();
        const int tbase = (c < 2) ? TL + b * CL + 128 * c : b * S + 128 * (c - 2);
        const int c0 = lane * 8;
        float cf[8], cb[8];
#pragma unroll
        for (int i = 0; i < 8; ++i) { cf[i] = cin[c0 + i]; cb[i] = cin[512 + c0 + i]; }
        const float* ga = p.attn_out_g + l * 512 + c0; const float* gr = p.lru_out_g + l * 512 + c0;
        for (int r = wv; r < 128; r += 8) {
            const int t = tbase + r;
            const uint4 a4 = *(const uint4*)(p.q + (size_t)t * 512 + c0), g4 = *(const uint4*)(p.gb + (size_t)t * 512 + c0);
            const uint4 hf4 = *(const uint4*)(p.hl + (size_t)t * 512 + c0), hb4 = *(const uint4*)(p.hl + ((size_t)TT + t) * 512 + c0);
            const uint4 af4 = *(const uint4*)(p.ac + (size_t)t * 512 + c0), ab4 = *(const uint4*)(p.ac + ((size_t)TT + t) * 512 + c0);
            float av[8] = {bflo(a4.x), bfhi(a4.x), bflo(a4.y), bfhi(a4.y), bflo(a4.z), bfhi(a4.z), bflo(a4.w), bfhi(a4.w)};
            const float gv[8] = {bflo(g4.x), bfhi(g4.x), bflo(g4.y), bfhi(g4.y), bflo(g4.z), bfhi(g4.z), bflo(g4.w), bfhi(g4.w)};
            const float hf[8] = {bflo(hf4.x), bfhi(hf4.x), bflo(hf4.y), bfhi(hf4.y), bflo(hf4.z), bfhi(hf4.z), bflo(hf4.w), bfhi(hf4.w)};
            const float hb[8] = {bflo(hb4.x), bfhi(hb4.x), bflo(hb4.y), bfhi(hb4.y), bflo(hb4.z), bfhi(hb4.z), bflo(hb4.w), bfhi(hb4.w)};
            const float af[8] = {bflo(af4.x), bfhi(af4.x), bflo(af4.y), bfhi(af4.y), bflo(af4.z), bfhi(af4.z), bflo(af4.w), bfhi(af4.w)};
            const float ab[8] = {bflo(ab4.x), bfhi(ab4.x), bflo(ab4.y), bfhi(ab4.y), bflo(ab4.z), bfhi(ab4.z), bflo(ab4.w), bfhi(ab4.w)};
            float rv[8]; float sa = 0.f, sr = 0.f;
#pragma unroll
            for (int i = 0; i < 8; ++i) { rv[i] = (hf[i] + af[i] * cf[i] + hb[i] + ab[i] * cb[i]) * gelu_tanh(gv[i]); sa += av[i] * av[i]; sr += rv[i] * rv[i]; }
            sa = wave_sum(sa); sr = wave_sum(sr);
            const float ra = rsqrtf(sa * (1.f / 512.f) + EPS), rr = rsqrtf(sr * (1.f / 512.f) + EPS);
#pragma unroll
            for (int i = 0; i < 8; ++i) { av[i] = av[i] * ra * ga[i]; rv[i] = rv[i] * rr * gr[i]; }
            uint4 o; o.x = pack2(av[0], av[1]); o.y = pack2(av[2], av[3]); o.z = pack2(av[4], av[5]); o.w = pack2(av[6], av[7]);
            *(uint4*)(p.xn + (size_t)t * D + c0) = o;
            o.x = pack2(rv[0], rv[1]); o.y = pack2(rv[2], rv[3]); o.z = pack2(rv[4], rv[5]); o.w = pack2(rv[6], rv[7]);
            *(uint4*)(p.xn + (size_t)t * D + 512 + c0) = o;
        }
    }
}

DEV void phase_route(const P& p, int l, int bid, int nb) {
    const int tid = otid(), lane = tid & 63, wv = tid >> 6;
    const int nrows = l == 0 ? TT : TL;
    for (int t = bid * 8 + wv; t < nrows; t += nb * 8) {
        const int mr = mod_row(t);
        const float* src = p.xres + (size_t)t * D;
        float xv[16];
#pragma unroll
        for (int i = 0; i < 4; ++i) { const float4 v4 = *(const float4*)(src + i * 256 + lane * 4); xv[i * 4] = v4.x; xv[i * 4 + 1] = v4.y; xv[i * 4 + 2] = v4.z; xv[i * 4 + 3] = v4.w; }
        float ss = 0.f;
#pragma unroll
        for (int i = 0; i < 16; ++i) ss += xv[i] * xv[i];
        ss = wave_sum(ss);
        const float rstd = rsqrtf(ss * (1.f / D) + EPS);
        const float* ng = p.norm2_g + l * D; const float* mm = p.mod + (size_t)(l * 9 + mr) * 6144;
        float lg[16];
#pragma unroll
        for (int e = 0; e < 16; ++e) lg[e] = 0.f;
#pragma unroll
        for (int i = 0; i < 4; ++i) {
            const int c0 = i * 256 + lane * 4;
            const float4 g4 = *(const float4*)(ng + c0), sh = *(const float4*)(mm + 3072 + c0), sc = *(const float4*)(mm + 4096 + c0);
            const float o0 = xv[i * 4] * rstd * g4.x * (1.f + sc.x) + sh.x, o1 = xv[i * 4 + 1] * rstd * g4.y * (1.f + sc.y) + sh.y;
            const float o2 = xv[i * 4 + 2] * rstd * g4.z * (1.f + sc.z) + sh.z, o3 = xv[i * 4 + 3] * rstd * g4.w * (1.f + sc.w) + sh.w;
            *(uint2*)(p.xn + (size_t)t * D + c0) = make_uint2(pack2(o0, o1), pack2(o2, o3));
            const float hv[4] = {o0, o1, o2, o3};
#pragma unroll
            for (int j = 0; j < 4; ++j) {
                const float4* rw = (const float4*)(p.router_w + (size_t)(c0 + j) * 16);
#pragma unroll
                for (int q4 = 0; q4 < 4; ++q4) { const float4 r4 = rw[q4]; lg[q4 * 4] += hv[j] * r4.x; lg[q4 * 4 + 1] += hv[j] * r4.y; lg[q4 * 4 + 2] += hv[j] * r4.z; lg[q4 * 4 + 3] += hv[j] * r4.w; }
            }
        }
        float sc_[16], bi[16];
#pragma unroll
        for (int e = 0; e < 16; ++e) { lg[e] = wave_sum(lg[e]); sc_[e] = 1.f / (1.f + expf(-lg[e])); bi[e] = sc_[e] + p.router_b[e]; }
        float gs[4];
#pragma unroll
        for (int g = 0; g < 4; ++g) {
            const float a = bi[g * 4], b = bi[g * 4 + 1], c = bi[g * 4 + 2], d = bi[g * 4 + 3];
            const float m1 = fmaxf(fmaxf(a, b), fmaxf(c, d));
            const float m2 = fmaxf(fmaxf(fminf(a, b), fminf(c, d)), fminf(fmaxf(a, b), fmaxf(c, d)));
            gs[g] = m1 + m2;
        }
        int bg = 0; float bgs = gs[0];
#pragma unroll
        for (int g = 1; g < 4; ++g) if (gs[g] > bgs) { bgs = gs[g]; bg = g; }
        float v0 = 0.f, v1 = 0.f, v2 = 0.f, v3 = 0.f, s0 = 0.f, s1 = 0.f, s2 = 0.f, s3 = 0.f;
#pragma unroll
        for (int g = 0; g < 4; ++g) if (bg == g) { v0 = bi[g * 4]; v1 = bi[g * 4 + 1]; v2 = bi[g * 4 + 2]; v3 = bi[g * 4 + 3]; s0 = sc_[g * 4]; s1 = sc_[g * 4 + 1]; s2 = sc_[g * 4 + 2]; s3 = sc_[g * 4 + 3]; }
        int i1 = 0; float b1 = v0, w1 = s0;
        if (v1 > b1) { b1 = v1; i1 = 1; w1 = s1; }
        if (v2 > b1) { b1 = v2; i1 = 2; w1 = s2; }
        if (v3 > b1) { b1 = v3; i1 = 3; w1 = s3; }
        int i2 = -1; float b2 = -1e30f, w2 = 0.f;
        if (i1 != 0 && v0 > b2) { b2 = v0; i2 = 0; w2 = s0; }
        if (i1 != 1 && v1 > b2) { b2 = v1; i2 = 1; w2 = s1; }
        if (i1 != 2 && v2 > b2) { b2 = v2; i2 = 2; w2 = s2; }
        if (i1 != 3 && v3 > b2) { b2 = v3; i2 = 3; w2 = s3; }
        if (lane == 0) {
            const float inv = 1.f / (w1 + w2);
            const int e1 = bg * 4 + i1, e2 = bg * 4 + i2;
            p.tokw[2 * t] = w1 * inv; p.tokw[2 * t + 1] = w2 * inv;
            const int p1 = atomicAdd(&p.cnt[l * 16 + e1], 1); p.list[e1 * TT + p1] = 2 * t;
            const int p2 = atomicAdd(&p.cnt[l * 16 + e2], 1); p.list[e2 * TT + p2] = 2 * t + 1;
        }
    }
}

__global__ void __launch_bounds__(NTHR, 2) fwd_megakernel(P p) {
    extern __shared__ __attribute__((aligned(16))) unsigned char lds_raw[];
    LAS unsigned char* lds = (LAS unsigned char*)lds_raw;
    volatile LAS unsigned* misc = (volatile LAS unsigned*)(lds + MISC_OFF);
    if (threadIdx.x < 16) misc[threadIdx.x] = 0u;
    __syncthreads();
    XcdBarrier gbar = xcd_barrier_post(p.bar, misc);
    const int bid = blockIdx.x, nb = gridDim.x;
    LAS float* rope_l = (LAS float*)(lds + MISC_OFF + MISC_ROPE);
    LAS i32x2* ptab = (LAS i32x2*)(lds + MISC_OFF + MISC_PTAB);
    {
        const int tid = otid();
        for (int i = tid; i < 1024; i += NTHR) {
            const int pos = i >> 4, f = i & 15;
            const float inv = exp2f(-(float)(2 * f) / 32.f * 13.287712379549449f);
            const float ang = (float)pos * inv;
            rope_l[i] = __cosf(ang); rope_l[1024 + i] = __sinf(ang);
        }
    }
    phase_prologue(p, bid, nb, lds);
    xcd_barrier(gbar);
#pragma unroll
    for (int l = 0; l < 2; ++l) {
        if (l == 0) phase_rowA<0>(p, l, bid, nb);
        else {
            phase_rowA<1>(p, l, bid, nb);
            const int tid = otid();
            convert_experts(p, 1, bid * 8 + (tid >> 6), nb * 8, (LAS float*)(lds + (tid >> 6) * 16384), tid & 63);
        }
        xcd_barrier(gbar);
        {
            const int tid = otid();
            pg8::GemmPlain g{p.xn, p.wt_in + (size_t)l * INW * D, D};
            pg8::RowMajorOrder so{7, (TT / 256) * 7, nb, bid};
            EpiIn E{&p, l, rope_l};
            pg8::gemm_phase<EpiIn, pg8::GemmPlain, pg8::RowMajorOrder, true>(lds, g, so, E, tid);
        }
        xcd_barrier(gbar);
        { const int tid = otid(); phase_attn_lru(p, l, lds, misc, tid); }
        xcd_barrier(gbar);
        phase_mix(p, l, bid, nb, lds);
        xcd_barrier(gbar);
        {
            const int tid = otid();
            pg8::GemmPlain g{p.xn, p.wt_out + (size_t)l * D * D, D};
            pg8::RowMajorOrder so{4, ((l == 0 ? TT : TL) / 256) * 4, nb, bid};
            EpiOut E{&p, l};
            pg8::gemm_phase<EpiOut, pg8::GemmPlain, pg8::RowMajorOrder, true>(lds, g, so, E, tid);
        }
        xcd_barrier(gbar);
        phase_route(p, l, bid, nb);
        xcd_barrier(gbar);
        {
            const int tid = otid();
            const int np = moe_build_ptab(p.cnt + l * 16, ptab, tid);
            MoeUpDesc g{p.xn, p.wt_gu, D, ptab, p.cnt + l * 16, p.list};
            pg8::RowMajorOrder so{4, np * 4, nb, bid};
            EpiMoeUp E{p.hid};
            pg8::gemm_phase<EpiMoeUp, MoeUpDesc, pg8::RowMajorOrder, true>(lds, g, so, E, tid);
        }
        xcd_barrier(gbar);
        {
            const int tid = otid();
            const int np = ptab[MAXPANELS].x;
            MoeDownDesc g{p.hid, p.wt_d, DE, ptab};
            pg8::RowMajorOrder so{4, np * 4, nb, bid};
            EpiMoeDown E{p.y, p.tokw, ptab, p.cnt + l * 16, p.list};
            pg8::gemm_phase<EpiMoeDown, MoeDownDesc, pg8::RowMajorOrder, true>(lds, g, so, E, tid);
        }
        xcd_barrier(gbar);
    }
    phase_rowA<2>(p, 1, bid, nb);
}

extern "C" void kernel_launch(void* const* d_in, const int* in_sizes, int n_in, void* d_out, int out_size, void* d_ws, size_t ws_size, hipStream_t stream) {
    P p{};
    const float* const* in = (const float* const*)d_in;
    p.x = in[0]; p.c = in[1]; p.ctx = in[2]; p.c_ctx = in[3]; p.ada_w = in[4]; p.ada_b = in[5]; p.norm1_g = in[6]; p.w_in = in[7]; p.q_norm_g = in[8]; p.k_norm_g = in[9];
    p.conv_w = in[10]; p.conv_b = in[11]; p.lru_wa = in[12]; p.lru_ba = in[13]; p.lru_wx = in[14]; p.lru_bx = in[15]; p.lru_lambda = in[16]; p.attn_out_g = in[17];
    p.lru_out_g = in[18]; p.w_out = in[19]; p.norm2_g = in[20]; p.router_w = in[21]; p.router_b = in[22]; p.w_gate = in[23]; p.w_up = in[24]; p.w_down = in[25]; p.final_g = in[26];
    p.out = (float*)d_out;
    char* ws = (char*)d_ws; size_t off = 0;
    auto carve = [&](size_t bytes) { void* r = ws + off; off += (bytes + 255) & ~(size_t)255; return r; };
    p.bar = (unsigned*)carve(XCD_BAR_WORDS * 4);
    p.cnt = (int*)carve(32 * 4);
    p.qctr = (int*)carve(64 * 4);
    const size_t ctl_bytes = off;
    p.mod = (float*)carve((size_t)2 * 9 * 6144 * 4);
    p.tokw = (float*)carve((size_t)2 * TT * 4);
    p.list = (int*)carve((size_t)NE * TT * 4);
    p.sptab = (float*)carve(2 * 2 * 512 * 4);
    p.totA = (float*)carve((size_t)NB * 2 * NCHK * 512 * 4);
    p.totH = (float*)carve((size_t)NB * 2 * NCHK * 512 * 4);
    p.wt_lru = (bf16_t*)carve((size_t)2 * 2 * 8 * 2 * 4096 * 2);
    p.wt_in = (bf16_t*)carve((size_t)2 * INW * D * 2);
    p.wt_out = (bf16_t*)carve((size_t)2 * D * D * 2);
    p.wt_gu = (bf16_t*)carve((size_t)NE * D * D * 2);
    p.wt_d = (bf16_t*)carve((size_t)NE * D * DE * 2);
    p.xres = (float*)carve((size_t)TT * D * 4);
    p.xn = (bf16_t*)carve((size_t)TT * D * 2);
    p.hid = (bf16_t*)carve((size_t)MAXPANELS * 256 * DE * 2);
    p.q = (bf16_t*)carve((size_t)TT * 512 * 2);
    p.y = p.q;
    p.k = (bf16_t*)carve((size_t)TT * 128 * 2);
    p.v = (bf16_t*)carve((size_t)TT * 128 * 2);
    p.u = (bf16_t*)carve((size_t)TT * 512 * 2);
    p.gb = (bf16_t*)carve((size_t)TT * 512 * 2);
    p.hl = (bf16_t*)carve((size_t)2 * TT * 512 * 2);
    p.ac = p.hid;
    if (off > ws_size) { fprintf(stderr, "workspace too small: need %zu have %zu\n", off, ws_size); return; }
    static int grid_blocks = 0;
    if (!grid_blocks) {
        int dev = 0, cus = 0;
        (void)hipGetDevice(&dev);
        (void)hipDeviceGetAttribute(&cus, hipDeviceAttributeMultiprocessorCount, dev);
        if (hipFuncSetAttribute((const void*)fwd_megakernel, hipFuncAttributeMaxDynamicSharedMemorySize, LDS_BYTES) != hipSuccess) { fprintf(stderr, "hipFuncSetAttribute failed\n"); grid_blocks = -1; return; }
        grid_blocks = cus > 0 ? cus : 256;
    }
    if (grid_blocks < 0) return;
    (void)hipMemsetAsync(ws, 0, ctl_bytes, stream);
    hipLaunchKernelGGL(fwd_megakernel, dim3(grid_blocks), dim3(NTHR), LDS_BYTES, stream, p);
}
```

```cpp
#include <hip/hip_runtime.h>
#include <stdint.h>
#include <cstdio>

#define DEV __device__ __forceinline__
#define LAS __attribute__((address_space(3)))
typedef unsigned short bf16_t;
typedef short bf16x8 __attribute__((ext_vector_type(8)));
typedef float f32x4 __attribute__((ext_vector_type(4)));
typedef unsigned u32x4 __attribute__((ext_vector_type(4)));
typedef unsigned u32x2 __attribute__((ext_vector_type(2)));
typedef int i32x2 __attribute__((ext_vector_type(2)));

constexpr int D = 1024, NB = 8, S = 2048, CL = 256, TL = NB * S, TC = NB * CL, TT = TL + TC, KVS = CL + S;
constexpr int INW = 1792, NE = 16, DE = 512;
constexpr float EPS = 1e-6f;
constexpr int NTHR = 512;
constexpr int RING_BYTES = 131072, MISC_OFF = RING_BYTES, LDS_BYTES = 147456;
constexpr int MAXPANELS = 2 * TT / 256 + NE;
constexpr int MISC_ROPE = 64, MISC_PTAB = 64 + 8192;

DEV float bf2f(bf16_t v) { return __uint_as_float(((unsigned)v) << 16); }
DEV unsigned f2bf(float f) { unsigned u = __float_as_uint(f); return (u + 0x7fffu + ((u >> 16) & 1u)) >> 16; }
DEV float bflo(unsigned w) { return __uint_as_float(w << 16); }
DEV float bfhi(unsigned w) { return __uint_as_float(w & 0xffff0000u); }
DEV unsigned pack2(float lo, float hi) { return f2bf(lo) | (f2bf(hi) << 16); }
template <int CTRL> DEV float dpp_mov(float v) { return __builtin_bit_cast(float, __builtin_amdgcn_update_dpp(0, __builtin_bit_cast(int, v), CTRL, 0xf, 0xf, true)); }
DEV float wave_sum(float v) {
    v += dpp_mov<0xB1>(v);
    v += dpp_mov<0x4E>(v);
    v += dpp_mov<0x141>(v);
    v += dpp_mov<0x140>(v);
    auto r = __builtin_amdgcn_permlane16_swap(__float_as_uint(v), __float_as_uint(v), false, false);
    v = __uint_as_float(r[0]) + __uint_as_float(r[1]);
    r = __builtin_amdgcn_permlane32_swap(__float_as_uint(v), __float_as_uint(v), false, false);
    return __uint_as_float(r[0]) + __uint_as_float(r[1]);
}
DEV float sigmoidf_(float x) { return __builtin_amdgcn_rcpf(1.f + __expf(-x)); }
DEV float gelu_tanh(float x) {
    const float u = 0.7978845608028654f * (x + 0.044715f * x * x * x);
    const float e = __expf(2.f * u);
    const float th = 1.f - 2.f * __builtin_amdgcn_rcpf(e + 1.f);
    return 0.5f * x * (1.f + th);
}
constexpr float attn_body_C2 = 0.125f * 1.4426950408889634f;
DEV int otid() { int t = threadIdx.x; asm volatile("" : "+v"(t)); return t; }
DEV int mod_row(int t) { return t < TL ? (t >> 11) : 8; }
DEV int kv_row(int t) { return t < TL ? (t >> 11) * KVS + CL + (t & 2047) : ((t - TL) >> 8) * KVS + ((t - TL) & 255); }

struct P {
    const float *x, *c, *ctx, *c_ctx, *ada_w, *ada_b, *norm1_g, *w_in, *q_norm_g, *k_norm_g, *conv_w, *conv_b, *lru_wa, *lru_ba, *lru_wx, *lru_bx,
        *lru_lambda, *attn_out_g, *lru_out_g, *w_out, *norm2_g, *router_w, *router_b, *w_gate, *w_up, *w_down, *final_g;
    float* out;
    float *mod, *xres, *tokw, *sptab, *totA, *totH;
    bf16_t *xn, *q, *k, *v, *u, *gb, *hl, *ac, *hid, *y;
    bf16_t *wt_in, *wt_out, *wt_gu, *wt_d, *wt_lru;
    int *cnt, *list, *qctr;
    unsigned* bar;
};

#define XB_TMO      128
#define XB_XCNT(j)  (256  + 64 * (j))
#define XB_XSUB(j)  (1280 + 64 * (j))
#define XB_XGEN(j)  (2304 + 64 * (j))
#define XB_TOP      3328
#define XB_TOPGEN   3392
#define XCD_BAR_WORDS 3456
#define XB_SPIN_CAP (1u << 20)
DEV unsigned xb_ld(unsigned* p) { return __hip_atomic_load(p, __ATOMIC_RELAXED, __HIP_MEMORY_SCOPE_AGENT); }
DEV unsigned xb_add(unsigned* p, unsigned v) { return __hip_atomic_fetch_add(p, v, __ATOMIC_RELAXED, __HIP_MEMORY_SCOPE_AGENT); }
DEV unsigned xb_xcc_id() { return (unsigned)__builtin_amdgcn_s_getreg((3 << 11) | 20) & 0xFu; }
#define XB_SPIN(cond, bar) do { unsigned _sp = 0; while (cond) { __builtin_amdgcn_s_sleep(1); \
    if ((++_sp & 255u) == 0u) { if (xb_ld(&(bar)[XB_TMO])) break; if (_sp > XB_SPIN_CAP) { atomicAdd(&(bar)[XB_TMO], 1u); break; } } } } while (0)
struct XcdBarrier { unsigned* bar; unsigned x; volatile LAS unsigned* st; };
DEV XcdBarrier xcd_barrier_post(unsigned* bar, volatile LAS unsigned* st) {
    XcdBarrier b; b.bar = bar; b.x = xb_xcc_id(); b.st = st;
    if (threadIdx.x == 0) { (void)xb_add(&bar[XB_XCNT(b.x)], 1u); st[2] = b.x; }
    return b;
}
DEV void xcd_barrier_complete(unsigned* bar, unsigned x, unsigned& nloc, unsigned& nx) {
    const unsigned G = gridDim.x * gridDim.y * gridDim.z;
    unsigned sum, cnt, mine, sp = 0u;
    for (;;) {
        sum = 0u; cnt = 0u; mine = 0u;
#pragma unroll
        for (unsigned j = 0; j < 16; ++j) { const unsigned c = xb_ld(&bar[XB_XCNT(j)]); sum += c; cnt += (c > 0u) ? 1u : 0u; mine = (j == x) ? c : mine; }
        if (sum == G) break;
        __builtin_amdgcn_s_sleep(1);
        if ((++sp & 255u) == 0u) { if (xb_ld(&bar[XB_TMO])) break; if (sp > XB_SPIN_CAP) { atomicAdd(&bar[XB_TMO], 1u); break; } }
    }
    nloc = mine > 0u ? mine : 1u; nx = cnt > 0u ? cnt : 1u;
}
DEV void xcd_barrier(const XcdBarrier& b) {
    asm volatile("s_waitcnt vmcnt(0)" ::: "memory");
    __syncthreads();
    if (threadIdx.x == 0) {
        unsigned* bar = b.bar;
        __builtin_amdgcn_s_waitcnt(0);
        unsigned nloc = b.st[0], nx = b.st[1]; const unsigned bx = b.st[2];
        if (nloc == 0u) { xcd_barrier_complete(bar, bx, nloc, nx); b.st[0] = nloc; b.st[1] = nx; }
        const unsigned old = xb_add(&bar[XB_XSUB(bx)], 1u);
        const unsigned gen = old / nloc;
        if (old + 1u == (gen + 1u) * nloc) {
            __builtin_amdgcn_fence(__ATOMIC_RELEASE, "agent");
            asm volatile("s_waitcnt vmcnt(0)" ::: "memory");
            const unsigned og = xb_add(&bar[XB_TOP], 1u);
            const unsigned tg = og / nx;
            if (og + 1u == (tg + 1u) * nx) xb_add(&bar[XB_TOPGEN], 1u);
            else XB_SPIN(xb_ld(&bar[XB_TOPGEN]) == tg, bar);
            __builtin_amdgcn_fence(__ATOMIC_ACQUIRE, "agent");
            xb_add(&bar[XB_XGEN(bx)], 1u);
            asm volatile("s_waitcnt vmcnt(0)" ::: "memory");
        } else {
            XB_SPIN(xb_ld(&bar[XB_XGEN(bx)]) == gen, bar);
            __builtin_amdgcn_fence(__ATOMIC_ACQUIRE, "agent");
            asm volatile("s_waitcnt vmcnt(0)" ::: "memory");
        }
    }
    __syncthreads();
}

namespace pg8 {
constexpr int BM = 256, BK = 64, HALF = 128, HTB = HALF * BK * 2, STAGE_BYTES = 8 * HTB;
DEV int lds_byte(int r, int c) { const int st = (r >> 4) * 2 + (c >> 5), rr = r & 15, cc = c & 31, ob = rr * 64 + cc * 2; return st * 1024 + (ob ^ (((ob >> 9) & 1) << 5)); }
DEV void stage_rc(int b, int& R, int& C) { const int st = b / 1024, sb = b % 1024, swz = sb ^ (((sb >> 9) & 1) << 5); R = (st >> 1) * 16 + swz / 64; C = (st & 1) * 32 + (swz % 64) / 2; }
DEV int perm32(int rho) { const int n = rho >> 4, i = rho & 15; return 8 * (i >> 2) + 4 * n + (i & 3); }
struct Unit { int pm, pn; };

template <class Epi, class G, class Sched, bool ALIGN_EPI>
DEV void gemm_phase(LAS unsigned char* lds, const G& g, const Sched& S, const Epi& E, const int tid) {
    const int wid = __builtin_amdgcn_readfirstlane(tid >> 6), lane = tid & 63, wr = wid >> 2, wc = wid & 3, fr = lane & 15, fq = lane >> 4;
    const int K = g.K, nt = K / BK;
    int sR[2], sC[2]; unsigned voffB[2];
#pragma unroll
    for (int i = 0; i < 2; ++i) { stage_rc(tid * 16 + i * 8192, sR[i], sC[i]); const int Rb = Epi::PERM ? ((sR[i] & ~31) + perm32(sR[i] & 31)) : sR[i];
        voffB[i] = (unsigned)(Rb * K + sC[i]) * 2u; }
    const size_t kstep = (size_t)(BK * 2);
    const size_t hstep = (size_t)HALF * K * 2;
    const unsigned ldsw = (unsigned)wid * 1024u;
    const int aoff = lds_byte(wr * 64 + fr, fq * 8), boff = lds_byte(wc * 32 + fr, fq * 8);
#define PG8_SA(b, h) (((b) * 2 + (h)) * HTB)
#define PG8_SB(b, h) ((4 + (b) * 2 + (h)) * HTB)
#define PG8_STAGE(bufoff, gbase, voff) do { _Pragma("unroll") for (int _i = 0; _i < 2; ++_i) \
        __builtin_amdgcn_global_load_lds((const unsigned*)((const char*)(gbase) + (voff)[_i]), (LAS unsigned*)(lds + (bufoff) + ldsw + _i * 8192), 16, 0, 0); } while (0)
#define PG8_LDA(dst, b, h) do { _Pragma("unroll") for (int m = 0; m < 4; ++m) _Pragma("unroll") for (int k = 0; k < 2; ++k) dst[m][k] = *(const LAS bf16x8*)(lds + PG8_SA(b, h) + aoff + m * 2048 + k * 1024); } while (0)
#define PG8_LDB(dst, b, h) do { _Pragma("unroll") for (int n = 0; n < 2; ++n) _Pragma("unroll") for (int k = 0; k < 2; ++k) dst[n][k] = *(const LAS bf16x8*)(lds + PG8_SB(b, h) + boff + n * 2048 + k * 1024); } while (0)
#define PG8_MMA(ai, bj, At, Bt) do { __builtin_amdgcn_s_setprio(1); _Pragma("unroll") for (int m = 0; m < 4; ++m) _Pragma("unroll") for (int n = 0; n < 2; ++n) _Pragma("unroll") for (int k = 0; k < 2; ++k) \
        acc[ai][bj][m][n] = __builtin_amdgcn_mfma_f32_16x16x32_bf16(Bt[n][k], At[m][k], acc[ai][bj][m][n], 0, 0, 0); __builtin_amdgcn_s_setprio(0); } while (0)
#define PG8_WAIT_V(n) asm volatile("s_waitcnt vmcnt(" #n ")" ::: "memory")
#define PG8_WAIT_L(n) asm volatile("s_waitcnt lgkmcnt(" #n ")" ::: "memory")
#define PG8_BAR __builtin_amdgcn_s_barrier()
#define PG8_SCHED __builtin_amdgcn_sched_barrier(0)
    Unit cur, nxt; int ui = 0;
    if (!S.next(0, cur)) return;
    f32x4 acc[2][2][4][2];
#pragma unroll
    for (int a = 0; a < 2; ++a)
#pragma unroll
        for (int b = 0; b < 2; ++b)
#pragma unroll
            for (int m = 0; m < 4; ++m)
#pragma unroll
                for (int n = 0; n < 2; ++n) acc[a][b][m][n] = (f32x4){0.f, 0.f, 0.f, 0.f};
    bf16x8 At[4][2], B0[2][2], B1[2][2];
    unsigned oc[2][2], on[2][2];
#pragma unroll
    for (int h = 0; h < 2; ++h)
#pragma unroll
        for (int i = 0; i < 2; ++i) oc[h][i] = g.a_off(cur, h, sR[i], sC[i]);
    const char* cA = g.a_base(cur); const char* cB = g.b_base(cur);
    PG8_STAGE(PG8_SB(0, 0), cB, voffB); PG8_STAGE(PG8_SB(0, 1), cB + hstep, voffB); PG8_STAGE(PG8_SA(0, 0), cA, oc[0]); PG8_STAGE(PG8_SA(0, 1), cA, oc[1]);
    if (wr == 1) PG8_BAR;
    PG8_WAIT_V(2); PG8_BAR;
    PG8_STAGE(PG8_SB(1, 0), cB + kstep, voffB); PG8_STAGE(PG8_SA(1, 0), cA + kstep, oc[0]); PG8_STAGE(PG8_SB(1, 1), cB + hstep + kstep, voffB);
    PG8_WAIT_V(6); PG8_BAR;
    for (;;) {
        const bool has_next = S.next(ui + 1, nxt);
#pragma unroll
        for (int h = 0; h < 2; ++h)
#pragma unroll
            for (int i = 0; i < 2; ++i) on[h][i] = has_next ? g.a_off(nxt, h, sR[i], sC[i]) : oc[h][i];
        const char* nA = has_next ? g.a_base(nxt) : cA; const char* nB = has_next ? g.b_base(nxt) : cB;
        for (int t = 0; t < nt; t += 2) {
            const bool last = (t == nt - 2);
            const char* a1 = cA + (size_t)(t + 1) * kstep;
            const char* a2 = last ? nA : cA + (size_t)(t + 2) * kstep; const char* b2 = last ? nB : cB + (size_t)(t + 2) * kstep;
            const char* a3 = a2 + kstep; const char* b3 = b2 + kstep;
            unsigned o2[2][2];
#pragma unroll
            for (int h = 0; h < 2; ++h)
#pragma unroll
                for (int i = 0; i < 2; ++i) o2[h][i] = last ? on[h][i] : oc[h][i];
            PG8_LDB(B0, 0, 0); PG8_LDB(B1, 0, 1); PG8_SCHED; PG8_LDA(At, 0, 0); PG8_STAGE(PG8_SA(1, 1), a1, oc[1]);
            PG8_WAIT_V(8); PG8_WAIT_L(0); PG8_BAR; PG8_MMA(0, 0, At, B0); PG8_MMA(0, 1, At, B1); PG8_BAR; PG8_SCHED;
            PG8_LDA(At, 0, 1); PG8_STAGE(PG8_SB(0, 0), b2, voffB); PG8_STAGE(PG8_SB(0, 1), b2 + hstep, voffB); PG8_STAGE(PG8_SA(0, 0), a2, o2[0]);
            PG8_WAIT_V(8); PG8_WAIT_L(0); PG8_BAR; PG8_MMA(1, 0, At, B0); PG8_MMA(1, 1, At, B1); PG8_BAR; PG8_SCHED;
            PG8_LDB(B0, 1, 0); PG8_LDB(B1, 1, 1); PG8_SCHED; PG8_LDA(At, 1, 0); PG8_STAGE(PG8_SA(0, 1), a2, o2[1]);
            PG8_WAIT_V(8); PG8_WAIT_L(0); PG8_BAR; PG8_MMA(0, 0, At, B0); PG8_MMA(0, 1, At, B1); PG8_BAR; PG8_SCHED;
            PG8_LDA(At, 1, 1); PG8_STAGE(PG8_SB(1, 0), b3, voffB); PG8_STAGE(PG8_SB(1, 1), b3 + hstep, voffB); PG8_STAGE(PG8_SA(1, 0), a3, o2[0]);
            PG8_WAIT_V(8); PG8_WAIT_L(0); PG8_BAR; PG8_MMA(1, 0, At, B0); PG8_MMA(1, 1, At, B1); PG8_BAR; PG8_SCHED;
        }
        if (ALIGN_EPI) { if (wr == 0) PG8_BAR; }
        E(acc, cur, wr, wc, fr, fq);
        if (!has_next) break;
#pragma unroll
        for (int a = 0; a < 2; ++a)
#pragma unroll
            for (int b = 0; b < 2; ++b)
#pragma unroll
                for (int m = 0; m < 4; ++m)
#pragma unroll
                    for (int n = 0; n < 2; ++n) acc[a][b][m][n] = (f32x4){0.f, 0.f, 0.f, 0.f};
        cur = nxt; cA = nA; cB = nB; ++ui;
#pragma unroll
        for (int h = 0; h < 2; ++h)
#pragma unroll
            for (int i = 0; i < 2; ++i) oc[h][i] = on[h][i];
        if (ALIGN_EPI) { if (wr == 1) PG8_BAR; }
    }
    PG8_WAIT_V(0);
    if (!ALIGN_EPI) { if (wr == 0) PG8_BAR; }
    PG8_BAR;
#undef PG8_SA
#undef PG8_SB
#undef PG8_STAGE
#undef PG8_LDA
#undef PG8_LDB
#undef PG8_MMA
#undef PG8_WAIT_V
#undef PG8_WAIT_L
#undef PG8_BAR
#undef PG8_SCHED
}

struct GemmPlain {
    const bf16_t* A; const bf16_t* Bt; int K;
    DEV const char* a_base(const Unit& u) const { return (const char*)A + (size_t)u.pm * (256 * K * 2); }
    DEV const char* b_base(const Unit& u) const { return (const char*)Bt + (size_t)u.pn * (256 * K * 2); }
    DEV unsigned a_off(const Unit&, int h, int R, int C) const { return (unsigned)((h * 128 + R) * K + C) * 2u; }
};
struct RowMajorOrder {
    int nN, nunits, G, c;
    DEV bool next(int i, Unit& u) const { const int L = i * G + c; if (L >= nunits) return false; u.pm = L / nN; u.pn = L - u.pm * nN; return true; }
};
}

template <class RowMap>
DEV void transpose_item(const float* W, int K, int N, bf16_t* WT, LAS float* scr, int item, int lane, const RowMap& rm) {
    const int nblk = N / 32, kb = item / nblk, nbk = item % nblk, k0 = 64 * kb, n0 = 32 * nbk;
#pragma unroll 8
    for (int i = 0; i < 32; ++i) { const int kk = 2 * i + (lane >> 5); scr[kk * 33 + (lane & 31)] = W[(size_t)(k0 + kk) * N + n0 + (lane & 31)]; }
    asm volatile("s_waitcnt lgkmcnt(0)" ::: "memory");
    const int c = lane & 7;
#pragma unroll
    for (int j = 0; j < 4; ++j) { const int n = (lane >> 3) + 8 * j; const LAS float* s = scr + (8 * c) * 33 + n;
        u32x4 o; o.x = pack2(s[0 * 33], s[1 * 33]); o.y = pack2(s[2 * 33], s[3 * 33]); o.z = pack2(s[4 * 33], s[5 * 33]); o.w = pack2(s[6 * 33], s[7 * 33]);
        *(u32x4*)(WT + (size_t)rm(n0 + n) * K + k0 + 8 * c) = o; }
    asm volatile("s_waitcnt lgkmcnt(0)" ::: "memory");
}
struct MapId { DEV int operator()(int n) const { return n; } };
struct MapIn { DEV int operator()(int n) const { return (n & ~255) | ((n & 32) << 2) | ((n & 192) >> 1) | (n & 31); } };
template <int NSEL> struct MapGU { DEV int operator()(int h) const { return ((h >> 7) << 8) | (((h >> 6) & 1) << 7) | (((h >> 4) & 3) << 5) | (((h >> 2) & 3) << 3) | (NSEL << 2) | (h & 3); } };

constexpr int IT_IN = (D / 64) * (INW / 32), IT_OUT = (D / 64) * (D / 32), IT_G = (D / 64) * (DE / 32), IT_D = (DE / 64) * (D / 32), IT_EXP = 2 * IT_G + IT_D;
DEV void convert_experts(const P& p, int l, int gw, int ngw, LAS float* scr, int lane) {
    for (int it = gw; it < NE * IT_EXP; it += ngw) {
        const int e = it / IT_EXP; int r = it - e * IT_EXP;
        const size_t le = (size_t)(l * NE + e);
        if (r < IT_G) { transpose_item(p.w_gate + le * D * DE, D, DE, p.wt_gu + (size_t)e * D * D, scr, r, lane, MapGU<0>()); continue; } r -= IT_G;
        if (r < IT_G) { transpose_item(p.w_up + le * D * DE, D, DE, p.wt_gu + (size_t)e * D * D, scr, r, lane, MapGU<1>()); continue; } r -= IT_G;
        transpose_item(p.w_down + le * DE * D, DE, D, p.wt_d + (size_t)e * D * DE, scr, r, lane, MapId());
    }
}
DEV void phase_prologue(const P& p, int bid, int nb, LAS unsigned char* lds) {
    const int tid = otid(), lane = tid & 63, wv = tid >> 6;
    {
        LAS float* sil = (LAS float*)lds;
        LAS float* red = (LAS float*)(lds + 9 * 1024 * 4);
        bool have = false;
        for (int w = bid; w < 2 * 96; w += nb) {
            if (!have) {
                for (int i = tid; i < 9 * 1024; i += NTHR) { const int r = i >> 10, d = i & 1023; const float v = r < 8 ? p.c[r * 1024 + d] : p.c_ctx[d]; sil[i] = v * sigmoidf_(v); }
                have = true;
            }
            __syncthreads();
            const int l = w / 96, col0 = (w % 96) * 64, kq = tid >> 4, c4 = (tid & 15) * 4;
            const float* wp = p.ada_w + (size_t)l * 1024 * 6144 + col0 + c4;
            float acc[9][4];
#pragma unroll
            for (int r = 0; r < 9; ++r)
#pragma unroll
                for (int j = 0; j < 4; ++j) acc[r][j] = 0.f;
#pragma unroll 4
            for (int i = 0; i < 32; ++i) {
                const int k = kq + 32 * i;
                const float4 w4 = *(const float4*)(wp + (size_t)k * 6144);
#pragma unroll
                for (int r = 0; r < 9; ++r) { const float sv = sil[r * 1024 + k]; acc[r][0] += sv * w4.x; acc[r][1] += sv * w4.y; acc[r][2] += sv * w4.z; acc[r][3] += sv * w4.w; }
            }
#pragma unroll
            for (int r = 0; r < 9; ++r)
#pragma unroll
                for (int j = 0; j < 4; ++j) red[(kq * 64 + c4 + j) * 9 + r] = acc[r][j];
            __syncthreads();
            for (int o = tid; o < 64 * 9; o += NTHR) {
                const int cc = o / 9, r = o - cc * 9; float s = 0.f;
#pragma unroll 8
                for (int g = 0; g < 32; ++g) s += red[(g * 64 + cc) * 9 + r];
                p.mod[(size_t)(l * 9 + r) * 6144 + col0 + cc] = s + p.ada_b[l * 6144 + col0 + cc];
            }
        }
        __syncthreads();
    }
    {
        LAS float* scr = (LAS float*)(lds + wv * 16384);
        const int gw = bid * 8 + wv, ngw = nb * 8;
        for (int it = gw; it < 2 * (IT_IN + IT_OUT); it += ngw) {
            const int l = it / (IT_IN + IT_OUT); int r = it - l * (IT_IN + IT_OUT);
            if (r < IT_IN) transpose_item(p.w_in + (size_t)l * D * INW, D, INW, p.wt_in + (size_t)l * INW * D, scr, r, lane, MapIn());
            else transpose_item(p.w_out + (size_t)l * D * D, D, D, p.wt_out + (size_t)l * D * D, scr, r - IT_IN, lane, MapId());
        }
        for (int it = gw; it < 2 * 2 * 8 * 2 * 2; it += ngw) {
            const int m = it >> 2, g = (it >> 1) & 1, r = it & 1;
            transpose_item((g ? p.lru_wx : p.lru_wa) + (size_t)m * 4096, 64, 64, p.wt_lru + (size_t)(m * 2 + g) * 4096, scr, r, lane, MapId());
        }
        convert_experts(p, 0, gw, ngw, scr, lane);
        if (bid == nb - 1) for (int i = tid; i < 2 * 2 * 512; i += NTHR) { const float lam = p.lru_lambda[i]; p.sptab[i] = (-lam > 20.f) ? -lam : log1pf(__expf(-lam)); }
    }
}

DEV void unpack8(const uint2 a, float (&o)[4]) { o[0] = bflo(a.x); o[1] = bfhi(a.x); o[2] = bflo(a.y); o[3] = bfhi(a.y); }
template <int MODE>
DEV void phase_rowA(const P& p, int l, int bid, int nb) {
    const int tid = otid(), lane = tid & 63, wv = tid >> 6;
    const int nrows = (MODE == 2) ? TL : TT;
    const int rpw = (nrows + nb * 8 - 1) / (nb * 8);
    const int r0 = (bid * 8 + wv) * rpw, r1 = min(r0 + rpw, nrows);
    const int lp = (MODE == 2) ? 1 : 0;
    f32x4 ng[4];
#pragma unroll
    for (int i = 0; i < 4; ++i) ng[i] = *(const f32x4*)((MODE == 2 ? p.final_g : p.norm1_g + l * D) + i * 256 + lane * 4);
    for (int t0 = r0; t0 < r1; t0 += 2) {
        f32x4 xr[2][4], g2[2][4], sh[2][4], sc[2][4]; uint2 ya[2][4], yb[2][4];
#pragma unroll
        for (int rr = 0; rr < 2; ++rr) {
            const int t = min(t0 + rr, r1 - 1), mr = mod_row(t);
            const float* src = (MODE == 0) ? (t < TL ? p.x + (size_t)t * D : p.ctx + (size_t)(t - TL) * D) : p.xres + (size_t)t * D;
            const float* mm = p.mod + (size_t)(l * 9 + mr) * 6144;
#pragma unroll
            for (int i = 0; i < 4; ++i) {
                const int c0 = i * 256 + lane * 4;
                xr[rr][i] = *(const f32x4*)(src + c0);
                if (MODE != 0) { g2[rr][i] = *(const f32x4*)(p.mod + (size_t)(lp * 9 + mr) * 6144 + 5 * 1024 + c0); ya[rr][i] = *(const uint2*)(p.y + (size_t)(2 * t) * D + c0); yb[rr][i] = *(const uint2*)(p.y + (size_t)(2 * t + 1) * D + c0); }
                if (MODE != 2) { sh[rr][i] = *(const f32x4*)(mm + c0); sc[rr][i] = *(const f32x4*)(mm + 1024 + c0); }
            }
        }
#pragma unroll
        for (int rr = 0; rr < 2; ++rr) {
            const int t = t0 + rr;
            if (t < r1) {
                float ss = 0.f;
#pragma unroll
                for (int i = 0; i < 4; ++i) {
                    if (MODE != 0) { float a[4], b[4]; unpack8(ya[rr][i], a); unpack8(yb[rr][i], b);
#pragma unroll
                        for (int j = 0; j < 4; ++j) xr[rr][i][j] += g2[rr][i][j] * (a[j] + b[j]); }
#pragma unroll
                    for (int j = 0; j < 4; ++j) ss += xr[rr][i][j] * xr[rr][i][j];
                }
                if (MODE == 1) {
#pragma unroll
                    for (int i = 0; i < 4; ++i) *(f32x4*)(p.xres + (size_t)t * D + i * 256 + lane * 4) = xr[rr][i];
                }
                ss = wave_sum(ss);
                const float rstd = rsqrtf(ss * (1.f / D) + EPS);
#pragma unroll
                for (int i = 0; i < 4; ++i) {
                    const int c0 = i * 256 + lane * 4;
                    if (MODE == 2) *(f32x4*)(p.out + (size_t)t * D + c0) = xr[rr][i] * rstd * ng[i];
                    else {
                        const f32x4 o = xr[rr][i] * rstd * ng[i] * (sc[rr][i] + 1.f) + sh[rr][i];
                        *(uint2*)(p.xn + (size_t)t * D + c0) = make_uint2(pack2(o[0], o[1]), pack2(o[2], o[3]));
                    }
                }
            }
        }
    }
}

struct EpiIn {
    static constexpr bool PERM = true;
    const P* pp; int l; const LAS float* rope;
    DEV void operator()(const f32x4 (&acc)[2][2][4][2], const pg8::Unit& u, int wr, int wc, int fr, int fq) const {
        const P& p = *pp;
        const int pn = u.pn;
        const bool lat = u.pm < TL / 256;
        const bool is_qk = (pn < 2) || (pn == 2 && wc < 2);
        const float qs = pn < 2 ? attn_body_C2 : 1.f;
        bf16_t* dst; int ld; bool kvmap = false;
        if (pn < 2) { dst = p.q + (pn * 4 + wc) * 64; ld = 512; }
        else if (pn == 2) { dst = (wc < 2 ? p.k + wc * 64 : p.v + (wc - 2) * 64); ld = 128; kvmap = true; }
        else if (pn < 5) { dst = p.u + (pn - 3) * 256 + wc * 64; ld = 512; }
        else { dst = p.gb + (pn - 5) * 256 + wc * 64; ld = 512; }
        float gq[2][2][4];
#pragma unroll
        for (int bj = 0; bj < 2; ++bj)
#pragma unroll
            for (int n = 0; n < 2; ++n)
#pragma unroll
                for (int j = 0; j < 4; ++j) gq[bj][n][j] = 1.f;
        if (is_qk) {
            const float* g = (pn < 2 ? p.q_norm_g : p.k_norm_g) + l * 64;
#pragma unroll
            for (int bj = 0; bj < 2; ++bj)
#pragma unroll
                for (int n = 0; n < 2; ++n) { const float4 g4 = *(const float4*)(g + 32 * bj + 8 * fq + 4 * n); gq[bj][n][0] = g4.x; gq[bj][n][1] = g4.y; gq[bj][n][2] = g4.z; gq[bj][n][3] = g4.w; }
        }
#pragma unroll
        for (int ai = 0; ai < 2; ++ai)
#pragma unroll
            for (int m = 0; m < 4; ++m) {
                const int t = u.pm * 256 + ai * 128 + wr * 64 + m * 16 + fr;
                float v[2][2][4];
#pragma unroll
                for (int bj = 0; bj < 2; ++bj)
#pragma unroll
                    for (int n = 0; n < 2; ++n)
#pragma unroll
                        for (int j = 0; j < 4; ++j) v[bj][n][j] = acc[ai][bj][m][n][j];
                if (is_qk) {
                    float ss = 0.f;
#pragma unroll
                    for (int bj = 0; bj < 2; ++bj)
#pragma unroll
                        for (int n = 0; n < 2; ++n)
#pragma unroll
                            for (int j = 0; j < 4; ++j) ss += v[bj][n][j] * v[bj][n][j];
                    ss += __shfl_xor(ss, 16); ss += __shfl_xor(ss, 32);
                    const float rstd = rsqrtf(ss * (1.f / 64.f) + EPS);
                    const int s = t & 2047;
#pragma unroll
                    for (int bj = 0; bj < 2; ++bj) {
                        const int pos = bj ? (s & 63) : (s >> 6);
#pragma unroll
                        for (int n = 0; n < 2; ++n) {
                            float cs4[4] = {1.f, 1.f, 1.f, 1.f}, sn4[4] = {0.f, 0.f, 0.f, 0.f};
                            if (lat) {
                                const int f0 = 8 * (fq & 1) + 4 * n;
                                const f32x4 c4 = *(const LAS f32x4*)(rope + pos * 16 + f0), s4 = *(const LAS f32x4*)(rope + 1024 + pos * 16 + f0);
                                cs4[0] = c4.x; cs4[1] = c4.y; cs4[2] = c4.z; cs4[3] = c4.w; sn4[0] = s4.x; sn4[1] = s4.y; sn4[2] = s4.z; sn4[3] = s4.w;
                            }
#pragma unroll
                            for (int j = 0; j < 4; ++j) {
                                const float w = v[bj][n][j] * gq[bj][n][j];
                                const float pw = __shfl_xor(w, 32);
                                const float o = (fq & 2) ? (w * cs4[j] + pw * sn4[j]) : (w * cs4[j] - pw * sn4[j]);
                                v[bj][n][j] = o * rstd * qs;
                            }
                        }
                    }
                }
                bf16_t* rowp = dst + (size_t)(kvmap ? kv_row(t) : t) * ld;
#pragma unroll
                for (int bj = 0; bj < 2; ++bj) {
                    u32x4 w; w.x = pack2(v[bj][0][0], v[bj][0][1]); w.y = pack2(v[bj][0][2], v[bj][0][3]); w.z = pack2(v[bj][1][0], v[bj][1][1]); w.w = pack2(v[bj][1][2], v[bj][1][3]);
                    *(u32x4*)(rowp + 32 * bj + 8 * fq) = w;
                }
            }
    }
};
struct EpiOut {
    static constexpr bool PERM = false;
    const P* pp; int l;
    DEV void operator()(const f32x4 (&acc)[2][2][4][2], const pg8::Unit& u, int wr, int wc, int fr, int fq) const {
        const P& p = *pp;
        const int col0 = u.pn * 256 + wc * 32 + 4 * fq;
        const int mr = u.pm < TL / 256 ? (u.pm >> 3) : 8;
        const float* g1 = p.mod + (size_t)(l * 9 + mr) * 6144 + 2048 + col0;
        f32x4 gv[2][2];
#pragma unroll
        for (int bj = 0; bj < 2; ++bj)
#pragma unroll
            for (int n = 0; n < 2; ++n) gv[bj][n] = *(const f32x4*)(g1 + bj * 128 + n * 16);
#pragma unroll
        for (int ai = 0; ai < 2; ++ai)
#pragma unroll
            for (int m = 0; m < 4; ++m) {
                const int t = u.pm * 256 + ai * 128 + wr * 64 + m * 16 + fr;
                const float* res = (l == 0) ? (t < TL ? p.x + (size_t)t * D : p.ctx + (size_t)(t - TL) * D) : p.xres + (size_t)t * D;
                float* o = p.xres + (size_t)t * D + col0;
#pragma unroll
                for (int bj = 0; bj < 2; ++bj)
#pragma unroll
                    for (int n = 0; n < 2; ++n) { const f32x4 r4 = *(const f32x4*)(res + col0 + bj * 128 + n * 16); *(f32x4*)(o + bj * 128 + n * 16) = r4 + gv[bj][n] * acc[ai][bj][m][n]; }
            }
    }
};
struct MoeUpDesc {
    const bf16_t* A; const bf16_t* Bt; int K; const LAS i32x2* ptab; const int* cnt; const int* list;
    DEV const char* a_base(const pg8::Unit&) const { return (const char*)A; }
    DEV const char* b_base(const pg8::Unit& u) const { const int e = ptab[u.pm].x; return (const char*)Bt + ((size_t)e * D + (size_t)u.pn * 256) * (D * 2); }
    DEV unsigned a_off(const pg8::Unit& u, int h, int R, int C) const {
        const i32x2 pe = ptab[u.pm]; const int pos = pe.y + h * 128 + R;
        const int tok = pos < cnt[pe.x] ? (list[pe.x * TT + pos] >> 1) : 0;
        return (unsigned)(tok * D + C) * 2u;
    }
};
struct MoeDownDesc {
    const bf16_t* A; const bf16_t* Bt; int K; const LAS i32x2* ptab;
    DEV const char* a_base(const pg8::Unit& u) const { return (const char*)A + (size_t)u.pm * (256 * DE * 2); }
    DEV const char* b_base(const pg8::Unit& u) const { const int e = ptab[u.pm].x; return (const char*)Bt + ((size_t)e * D + (size_t)u.pn * 256) * (DE * 2); }
    DEV unsigned a_off(const pg8::Unit&, int h, int R, int C) const { return (unsigned)((h * 128 + R) * DE + C) * 2u; }
};
struct EpiMoeUp {
    static constexpr bool PERM = true;
    bf16_t* hid;
    DEV void operator()(const f32x4 (&acc)[2][2][4][2], const pg8::Unit& u, int wr, int wc, int fr, int fq) const {
#pragma unroll
        for (int ai = 0; ai < 2; ++ai)
#pragma unroll
            for (int m = 0; m < 4; ++m) {
                bf16_t* rowp = hid + (size_t)(u.pm * 256 + ai * 128 + wr * 64 + m * 16 + fr) * DE + u.pn * 128 + wc * 16 + fq * 4;
#pragma unroll
                for (int bj = 0; bj < 2; ++bj) {
                    const f32x4 g = acc[ai][bj][m][0], up = acc[ai][bj][m][1];
                    float h[4];
#pragma unroll
                    for (int j = 0; j < 4; ++j) h[j] = g[j] * sigmoidf_(g[j]) * up[j];
                    *(u32x2*)(rowp + bj * 64) = (u32x2){pack2(h[0], h[1]), pack2(h[2], h[3])};
                }
            }
    }
};
struct EpiMoeDown {
    static constexpr bool PERM = true;
    bf16_t* y; const float* tokw; const LAS i32x2* ptab; const int* cnt; const int* list;
    DEV void operator()(const f32x4 (&acc)[2][2][4][2], const pg8::Unit& u, int wr, int wc, int fr, int fq) const {
        const i32x2 pe = ptab[u.pm]; const int ce = cnt[pe.x];
#pragma unroll
        for (int ai = 0; ai < 2; ++ai)
#pragma unroll
            for (int m = 0; m < 4; ++m) {
                const int pos = pe.y + ai * 128 + wr * 64 + m * 16 + fr;
                if (pos < ce) {
                    const int pair = list[pe.x * TT + pos]; const float wt = tokw[pair];
                    bf16_t* rowp = y + (size_t)pair * D + u.pn * 256 + wc * 32 + 8 * fq;
#pragma unroll
                    for (int bj = 0; bj < 2; ++bj) {
                        const f32x4 a0 = acc[ai][bj][m][0] * wt, a1 = acc[ai][bj][m][1] * wt;
                        *(u32x4*)(rowp + bj * 128) = (u32x4){pack2(a0[0], a0[1]), pack2(a0[2], a0[3]), pack2(a1[0], a1[1]), pack2(a1[2], a1[3])};
                    }
                }
            }
    }
};
DEV int moe_build_ptab(const int* cnt, LAS i32x2* ptab, int tid) {
    __syncthreads();
    if (tid < 64) {
        const int c = tid < NE ? cnt[tid] : 0;
        const int npan = (c + 255) >> 8;
        int incl = npan;
#pragma unroll
        for (int o = 1; o < 16; o <<= 1) { const int v = __shfl_up(incl, o); if (tid >= o) incl += v; }
        int base = incl - npan;
#pragma unroll 1
        for (int r0 = 0; r0 < c; r0 += 256) { ptab[base] = (i32x2){tid, r0}; ++base; }
        if (tid == NE - 1) ptab[MAXPANELS] = (i32x2){incl, 0};
    }
    __syncthreads();
    return ptab[MAXPANELS].x;
}

#include <hip/hip_bf16.h>
namespace attn_body {
using bf16=__hip_bfloat16;
using bf16x8=__attribute__((ext_vector_type(8)))short;
using s16x4=__attribute__((ext_vector_type(4)))short;
using f32x16=__attribute__((ext_vector_type(16)))float;
using u32x4=__attribute__((ext_vector_type(4)))unsigned;
constexpr int D=64,QP=512,KP=128;
constexpr int NW=8,QBLK=32,QB=QBLK*NW,KVBLK=64;
__device__ __forceinline__ int crow(int r,int hi){return (r&3)+8*(r>>2)+4*hi;}
#define SBAR() __builtin_amdgcn_sched_barrier(0)
constexpr int NSLOT=3, SLOTB=8192;
constexpr int LDS_K=0, LDS_V=NSLOT*SLOTB, LDS_WS=2*NSLOT*SLOTB, LDS_OST=LDS_WS+NW*64*4, LDS_BYTES=LDS_OST+NW*4096;
constexpr float C2=0.125f*1.4426950408889634f;
__device__ __forceinline__ void glds16(const void*gsrc,unsigned lds_dst){unsigned keep;
  asm volatile("s_mov_b32 %0, m0\n\ts_mov_b32 m0, %2\n\ts_nop 0\n\tglobal_load_lds_dwordx4 %1, off\n\ts_mov_b32 m0, %0":"=&s"(keep):"v"(gsrc),"s"(lds_dst):"memory");}
__device__ __forceinline__ float max3f(float a,float b,float c){float r;asm("v_max3_f32 %0, %1, %2, %3":"=v"(r):"v"(a),"v"(b),"v"(c));return r;}
__device__ __forceinline__ float max2f(float a,float b){float r;asm("v_max_f32_e32 %0, %1, %2":"=v"(r):"v"(a),"v"(b));return r;}
__device__ __forceinline__ float fadd_s(float a,float b){float r;asm("v_add_f32_e32 %0, %1, %2":"=v"(r):"v"(a),"v"(b));return r;}
__device__ __forceinline__ float fsub_s(float a,float b){float r;asm("v_sub_f32_e32 %0, %1, %2":"=v"(r):"v"(a),"v"(b));return r;}
typedef float f32x2_t __attribute__((ext_vector_type(2))); typedef __bf16 bf16x2_t __attribute__((ext_vector_type(2)));
__device__ __forceinline__ unsigned cvtpk_s(float lo,float hi){f32x2_t v={lo,hi};bf16x2_t b=__builtin_convertvector(v,bf16x2_t);return __builtin_bit_cast(unsigned,b);}
#define WAIT_BAR(N) asm volatile("s_waitcnt vmcnt(" #N ") lgkmcnt(0)\n\ts_barrier":::"memory")

__device__ __forceinline__ void qkt(f32x16&p0,f32x16&p1,const char*Kslot,const bf16x8*qr,const f32x16&negm,int r32,int hi){
  const char*kb=Kslot+hi*1024+r32*16;
  #pragma unroll
  for(int d0=0;d0<4;++d0){
    const bf16x8 b0=*reinterpret_cast<const bf16x8*>(kb+d0*2048);
    const bf16x8 b1=*reinterpret_cast<const bf16x8*>(kb+d0*2048+512);
    if(d0==0){p0=__builtin_amdgcn_mfma_f32_32x32x16_bf16(b0,qr[0],negm,0,0,0);p1=__builtin_amdgcn_mfma_f32_32x32x16_bf16(b1,qr[0],negm,0,0,0);}
    else{p0=__builtin_amdgcn_mfma_f32_32x32x16_bf16(b0,qr[d0],p0,0,0,0);p1=__builtin_amdgcn_mfma_f32_32x32x16_bf16(b1,qr[d0],p1,0,0,0);}}
}
typedef __attribute__((address_space(3))) const char* lds_cptr;
typedef short v4i16_t __attribute__((ext_vector_type(4)));
__device__ __forceinline__ void kload8(bf16x8*kf,lds_cptr kp){
  kf[0]=*(const __attribute__((address_space(3))) bf16x8*)(kp);      kf[1]=*(const __attribute__((address_space(3))) bf16x8*)(kp+512);
  kf[2]=*(const __attribute__((address_space(3))) bf16x8*)(kp+2048); kf[3]=*(const __attribute__((address_space(3))) bf16x8*)(kp+2560);
  kf[4]=*(const __attribute__((address_space(3))) bf16x8*)(kp+4096); kf[5]=*(const __attribute__((address_space(3))) bf16x8*)(kp+4608);
  kf[6]=*(const __attribute__((address_space(3))) bf16x8*)(kp+6144); kf[7]=*(const __attribute__((address_space(3))) bf16x8*)(kp+6656);
}
__device__ __forceinline__ void kload2(bf16x8*kf,lds_cptr kp,int j){ kf[2*j]=*(const __attribute__((address_space(3))) bf16x8*)(kp+j*2048); kf[2*j+1]=*(const __attribute__((address_space(3))) bf16x8*)(kp+j*2048+512); }
__device__ __forceinline__ s16x4 vtr(lds_cptr p){ return __builtin_bit_cast(s16x4,__builtin_amdgcn_ds_read_tr16_b64_v4i16((__attribute__((address_space(3))) v4i16_t*)p)); }
__device__ __forceinline__ float rowmax(const f32x16&p0,const f32x16&p1){
  float a=max3f(p0[0],p0[1],p1[0]),b=max3f(p0[2],p0[3],p1[1]);a=max3f(a,p1[2],p1[3]);
  #pragma unroll
  for(int r=4;r<16;r+=4){a=max3f(a,p0[r],p0[r+1]);b=max3f(b,p0[r+2],p0[r+3]);a=max3f(a,p1[r],p1[r+1]);b=max3f(b,p1[r+2],p1[r+3]);}
  const float m=max2f(a,b);
  auto rr=__builtin_amdgcn_permlane32_swap(__float_as_uint(m),__float_as_uint(m),false,false);
  return max2f(__uint_as_float(rr[0]),__uint_as_float(rr[1]));
}
__device__ __forceinline__ void pv(f32x16*o,int vb,bf16x8 pa0,bf16x8 pa1,bf16x8 pa2,bf16x8 pa3){
  #pragma unroll
  for(int d0=0;d0<2;++d0){s16x4 lo[4],hi[4];
    #pragma unroll
    for(int ks=0;ks<4;++ks){
      asm volatile("ds_read_b64_tr_b16 %0,%1 offset:%c2":"=&v"(lo[ks]):"v"(vb),"i"(d0*4096+ks*1024):"memory");
      asm volatile("ds_read_b64_tr_b16 %0,%1 offset:%c2":"=&v"(hi[ks]):"v"(vb),"i"(d0*4096+ks*1024+512):"memory");}
    asm volatile("s_waitcnt lgkmcnt(0)":::"memory");SBAR();
    #define PK(k) (bf16x8){lo[k][0],lo[k][1],lo[k][2],lo[k][3],hi[k][0],hi[k][1],hi[k][2],hi[k][3]}
    o[d0]=__builtin_amdgcn_mfma_f32_32x32x16_bf16(pa0,PK(0),o[d0],0,0,0);
    o[d0]=__builtin_amdgcn_mfma_f32_32x32x16_bf16(pa1,PK(1),o[d0],0,0,0);
    o[d0]=__builtin_amdgcn_mfma_f32_32x32x16_bf16(pa2,PK(2),o[d0],0,0,0);
    o[d0]=__builtin_amdgcn_mfma_f32_32x32x16_bf16(pa3,PK(3),o[d0],0,0,0);
    #undef PK
  }
}

#ifndef ATTN_STORE16
#define ATTN_STORE16(p,v) (*(u32x4*)(p)=(v))
#endif
template<int THRL> __device__ __forceinline__ void attn_unit(const bf16*Qu,const bf16*__restrict__ Kh,const bf16*__restrict__ Vh,bf16*Ou,const int NT,char*shm,const int tid){
  const int lane=tid&63,r32=lane&31,hi=lane>>5; const int wid=__builtin_amdgcn_readfirstlane(tid>>6);
  const bf16*Qw=Qu+(long)(wid*QBLK)*QP;
  const unsigned lds0=(unsigned)(uintptr_t)shm;
  float*wsf=(float*)(shm+LDS_WS)+wid*64;
  const bf16*ksrc=Kh+(long)lane*KP+wid*8;
  const bf16*vsrc=Vh+(long)(16*(wid&3)+(lane>>2))*KP+(wid>>2)*32+(lane&3)*8;
  const unsigned kdst=lds0+LDS_K+wid*1024, vdst=lds0+LDS_V+wid*1024;
  #define DMA_K(t,slot) glds16(ksrc+(long)(t)*KVBLK*KP,(unsigned)__builtin_amdgcn_readfirstlane(kdst+(slot)))
  #define DMA_V(t,slot) glds16(vsrc+(long)(t)*KVBLK*KP,(unsigned)__builtin_amdgcn_readfirstlane(vdst+(slot)))
  const int vb0=(int)(lds0+LDS_V)+((lane>>4)&1)*32+(lane&3)*8+(4*hi+((lane&15)>>2))*64;
  const char*Kbase=shm+LDS_K; bf16x8 kf[8];
  const lds_cptr shm3=(lds_cptr)shm; const lds_cptr kp0=shm3+LDS_K+hi*1024+r32*16; const lds_cptr vp0=shm3+LDS_V+((lane>>4)&1)*32+(lane&3)*8+(4*hi+((lane&15)>>2))*64;
  DMA_K(0,0);DMA_V(0,0);DMA_K(1,SLOTB);
  bf16x8 qr[4];
  #pragma unroll
  for(int d0=0;d0<4;++d0)qr[d0]=*reinterpret_cast<const bf16x8*>(&Qw[(long)r32*QP+d0*16+hi*8]);
  float mhat=0.f,l_reg=0.f;f32x16 o[2];o[0]=f32x16{};o[1]=f32x16{};f32x16 negm=f32x16{};asm volatile("":"+v"(negm));
  #define CMASK(P0,P1,t) do{}while(0)
  bool resc=false;
  #define START(P0,P1) do{ const float rm=rowmax(P0,P1); resc=false; \
    { const float dl=rm; mhat=fadd_s(mhat,dl); \
      _Pragma("unroll") for(int r=0;r<16;++r){P0[r]=fsub_s(P0[r],dl);P1[r]=fsub_s(P1[r],dl);} \
      _Pragma("unroll") for(int r=0;r<16;++r)negm[r]=-mhat; asm volatile("":"+v"(negm)); } \
    _Pragma("unroll") for(int r=0;r<16;++r)P0[r]=__builtin_amdgcn_exp2f(P0[r]); }while(0)
  #define RESC() do{ if(resc){ asm volatile("s_waitcnt lgkmcnt(0)":::"memory"); \
      _Pragma("unroll") for(int d_=0;d_<2;++d_) _Pragma("unroll") for(int r=0;r<16;++r)o[d_][r]*=wsf[crow(r,hi)]; } }while(0)
  f32x16 pA0,pA1,pB0,pB1;
  int sl_prev=0,sl_cur=0,sl_next=SLOTB;
  #define ROT() do{sl_prev=sl_cur;sl_cur=sl_next;sl_next=(sl_next==(NSLOT-1)*SLOTB)?0:sl_next+SLOTB;}while(0)
  DMA_K(2,2*SLOTB);
  WAIT_BAR(3);
  qkt(pA0,pA1,Kbase,qr,negm,r32,hi);asm volatile("s_nop 15\n\ts_nop 7":"+v"(pA0),"+v"(pA1));CMASK(pA0,pA1,0);
  START(pA0,pA1);
  _Pragma("unroll") for(int r=0;r<16;++r)pA1[r]=__builtin_amdgcn_exp2f(pA1[r]);
  WAIT_BAR(0);
  DMA_K(3,0);DMA_V(1,SLOTB);
  ROT();
  kload8(kf,kp0+sl_cur);
  WAIT_BAR(2);
  s16x4 vlo[8],vhi[8]; u32x4 pw0,pw1,pw2,pw3;
  #define PKW(P,B) cvtpk_s(P[B],P[B+1])
  #define PAF(k) __builtin_bit_cast(bf16x8,pw##k)
  #define VFR(i) (bf16x8){vlo[i][0],vlo[i][1],vlo[i][2],vlo[i][3],vhi[i][0],vhi[i][1],vhi[i][2],vhi[i][3]}
  #define PIN(x) asm volatile("":"+v"(x))
  #define MX3(a,b,c) __builtin_fmaxf(__builtin_fmaxf((a),(b)),(c))
  #define GAPA(MF,A0,A1,A2,A3,W0,W1,PW) do{ MF; sacc+=A0; sacc+=A1; sacc+=A2; sacc+=A3; PIN(sacc); W0; W1; PIN(PW); SBAR(); }while(0)
  #define EX(v) __builtin_amdgcn_exp2f(v)
  #define GAPB(MF,X,B) do{ MF; X[B]=EX(X[B]); X[B+1]=EX(X[B+1]); X[B+2]=EX(X[B+2]); X[B+3]=EX(X[B+3]); PIN(X); SBAR(); }while(0)
  #define VRD(i) do{ vlo[i]=vtr(vp_+(((i)>>2)*4096+((i)&3)*1024)); vhi[i]=vtr(vp_+(((i)>>2)*4096+((i)&3)*1024+512)); }while(0)
  #define KRD(G,j) do{ if(G){ kload2(kf,kp0+sl_next,j); SBAR(); } }while(0)
  #define STEP(C0,C1,P0,P1,t,GK,GV,GL) do{ SBAR(); \
    const lds_cptr vp_=vp0+sl_prev; \
    VRD(0); SBAR(); float sacc=(P0[0]+P0[1]); \
    GAPA(C0=__builtin_amdgcn_mfma_f32_32x32x16_bf16(kf[0],qr[0],negm,0,0,0), P0[2],P0[3],P0[4],P0[5],     pw0[0]=PKW(P0,0), pw0[1]=PKW(P0,2), pw0); \
    VRD(4); SBAR(); GAPA(C1=__builtin_amdgcn_mfma_f32_32x32x16_bf16(kf[1],qr[0],negm,0,0,0), P0[6],P0[7],P0[8],P0[9],     pw0[2]=PKW(P0,4), pw0[3]=PKW(P0,6), pw0); \
    VRD(1); SBAR(); GAPA(C0=__builtin_amdgcn_mfma_f32_32x32x16_bf16(kf[2],qr[1],C0,0,0,0),   P0[10],P0[11],P0[12],P0[13], pw1[0]=PKW(P0,8), pw1[1]=PKW(P0,10), pw1); \
    VRD(5); SBAR(); GAPA(C1=__builtin_amdgcn_mfma_f32_32x32x16_bf16(kf[3],qr[1],C1,0,0,0),   P0[14],P0[15],P1[0],P1[1],   pw1[2]=PKW(P0,12),pw1[3]=PKW(P0,14), pw1); \
    VRD(2); SBAR(); GAPA(C0=__builtin_amdgcn_mfma_f32_32x32x16_bf16(kf[4],qr[2],C0,0,0,0),   P1[2],P1[3],P1[4],P1[5],     pw2[0]=PKW(P1,0), pw2[1]=PKW(P1,2), pw2); \
    VRD(6); SBAR(); GAPA(C1=__builtin_amdgcn_mfma_f32_32x32x16_bf16(kf[5],qr[2],C1,0,0,0),   P1[6],P1[7],P1[8],P1[9],     pw2[2]=PKW(P1,4), pw2[3]=PKW(P1,6), pw2); \
    VRD(3); SBAR(); GAPA(C0=__builtin_amdgcn_mfma_f32_32x32x16_bf16(kf[6],qr[3],C0,0,0,0),   P1[10],P1[11],P1[12],P1[13], pw3[0]=PKW(P1,8), pw3[1]=PKW(P1,10), pw3); \
    VRD(7); SBAR(); GAPA(C1=__builtin_amdgcn_mfma_f32_32x32x16_bf16(kf[7],qr[3],C1,0,0,0),   P1[14],P1[15],0.f,0.f,       pw3[2]=PKW(P1,12),pw3[3]=PKW(P1,14), pw3); \
    l_reg+=sacc; \
    if(GK){DMA_K((t)+3,sl_cur);} if(GV){DMA_V((t)+1,sl_next);} \
    CMASK(C0,C1,t); \
    { float a=MX3(C0[0],C0[1],C1[0]),b=MX3(C0[2],C0[3],C1[1]); a=MX3(a,C1[2],C1[3]); \
      _Pragma("unroll") for(int r=4;r<16;r+=4){a=MX3(a,C0[r],C0[r+1]);b=MX3(b,C0[r+2],C0[r+3]);a=MX3(a,C1[r],C1[r+1]);b=MX3(b,C1[r+2],C1[r+3]);} \
      float rm=__builtin_fmaxf(a,b); { auto rr=__builtin_amdgcn_permlane32_swap(__float_as_uint(rm),__float_as_uint(rm),false,false); rm=__builtin_fmaxf(__uint_as_float(rr[0]),__uint_as_float(rr[1])); } \
      resc=false; \
      if(__builtin_expect(__any(rm>(float)THRL),0)){ const float dl=__builtin_fmaxf(rm,0.f); mhat+=dl; \
        _Pragma("unroll") for(int r=0;r<16;++r){C0[r]-=dl;C1[r]-=dl;} \
        _Pragma("unroll") for(int r=0;r<16;++r)negm[r]=-mhat; asm volatile("":"+v"(negm)); \
        const float f=__builtin_amdgcn_exp2f(-dl); l_reg*=f; if(hi==0)wsf[r32]=f; resc=true; } } \
    SBAR(); \
    GAPB(o[0]=__builtin_amdgcn_mfma_f32_32x32x16_bf16(PAF(0),VFR(0),o[0],0,0,0), C0,0); \
    GAPB(o[1]=__builtin_amdgcn_mfma_f32_32x32x16_bf16(PAF(0),VFR(4),o[1],0,0,0), C0,4); \
    KRD(GL,0); GAPB(o[0]=__builtin_amdgcn_mfma_f32_32x32x16_bf16(PAF(1),VFR(1),o[0],0,0,0), C0,8); \
    KRD(GL,1); GAPB(o[1]=__builtin_amdgcn_mfma_f32_32x32x16_bf16(PAF(1),VFR(5),o[1],0,0,0), C0,12); \
    KRD(GL,2); GAPB(o[0]=__builtin_amdgcn_mfma_f32_32x32x16_bf16(PAF(2),VFR(2),o[0],0,0,0), C1,0); \
    KRD(GL,3); GAPB(o[1]=__builtin_amdgcn_mfma_f32_32x32x16_bf16(PAF(2),VFR(6),o[1],0,0,0), C1,4); \
    GAPB(o[0]=__builtin_amdgcn_mfma_f32_32x32x16_bf16(PAF(3),VFR(3),o[0],0,0,0), C1,8); \
    GAPB(o[1]=__builtin_amdgcn_mfma_f32_32x32x16_bf16(PAF(3),VFR(7),o[1],0,0,0), C1,12); \
    }while(0)
  int t=1;
  #undef CMASK
  #define CMASK(P0,P1,t) do{}while(0)
  for(;t+5<NT;t+=2){
    STEP(pB0,pB1,pA0,pA1,t,true,true,true);     WAIT_BAR(2); RESC(); ROT();
    STEP(pA0,pA1,pB0,pB1,t+1,true,true,true);   WAIT_BAR(2); RESC(); ROT();
  }
  #undef CMASK
  #define CMASK(P0,P1,t) do{}while(0)
  #define ENDW(tt) do{ if((tt)+3<NT){WAIT_BAR(2);} else if((tt)+2<NT){WAIT_BAR(1);} else {WAIT_BAR(0);} }while(0)
  for(;t+1<NT;t+=2){
    STEP(pB0,pB1,pA0,pA1,t,(t+3<NT),(t+1<NT),(t+1<NT));       ENDW(t);   RESC(); ROT();
    STEP(pA0,pA1,pB0,pB1,t+1,(t+4<NT),(t+2<NT),(t+2<NT));     ENDW(t+1); RESC(); ROT();
  }
  STEP(pB0,pB1,pA0,pA1,NT-1,false,false,false); RESC();
  { float sacc=pB0[0]+pB0[1]; _Pragma("unroll") for(int r=2;r<16;++r)sacc+=pB0[r]; _Pragma("unroll") for(int r=0;r<16;++r)sacc+=pB1[r]; l_reg+=sacc;
    pw0=(u32x4){PKW(pB0,0),PKW(pB0,2),PKW(pB0,4),PKW(pB0,6)};pw1=(u32x4){PKW(pB0,8),PKW(pB0,10),PKW(pB0,12),PKW(pB0,14)};pw2=(u32x4){PKW(pB1,0),PKW(pB1,2),PKW(pB1,4),PKW(pB1,6)};pw3=(u32x4){PKW(pB1,8),PKW(pB1,10),PKW(pB1,12),PKW(pB1,14)};
    SBAR(); pv(o,vb0+sl_cur,PAF(0),PAF(1),PAF(2),PAF(3)); }
  #undef PKW
  #undef PAF
  #undef VFR
  #undef PIN
  #undef MX3
  #undef GAPA
  #undef GAPB
  #undef EX
  #undef VRD
  #undef KRD
  #undef STEP
  #undef ENDW
  {auto rr=__builtin_amdgcn_permlane32_swap(__float_as_uint(l_reg),__float_as_uint(l_reg),false,false);l_reg=__uint_as_float(rr[0])+__uint_as_float(rr[1]);}
  if(hi==0)wsf[32+r32]=l_reg;asm volatile("s_waitcnt lgkmcnt(0)":::"memory");
  float rli[16];
  #pragma unroll
  for(int r=0;r<16;++r)rli[r]=__builtin_amdgcn_rcpf(wsf[32+crow(r,hi)]);
  bf16*Ow=Ou+(long)(wid*QBLK)*QP;
  { bf16*stg=(bf16*)(shm+LDS_OST)+wid*2048;
    #pragma unroll
    for(int r=0;r<16;++r){const int orow=crow(r,hi);
      #pragma unroll
      for(int d0=0;d0<2;++d0)stg[orow*64+d0*32+r32]=__float2bfloat16(o[d0][r]*rli[r]);}
    asm volatile("s_waitcnt lgkmcnt(0)":::"memory");
    #pragma unroll
    for(int i=0;i<4;++i){const int row=i*8+(lane>>3),ch=lane&7; const u32x4 v=*(const u32x4*)(stg+row*64+ch*8); ATTN_STORE16(Ow+(long)row*QP+ch*8,v);} }
  asm volatile("s_waitcnt lgkmcnt(0)\n\ts_barrier":::"memory");
  #undef DMA_K
  #undef DMA_V
  #undef CMASK
  #undef START
  #undef RESC
  #undef ROT
}
constexpr int ATTN_LDS_BYTES=LDS_BYTES;
#undef SBAR
#undef WAIT_BAR
}

DEV void lru_chunk_item(const P& p, int l, int item, LAS unsigned char* lds, int tid);
DEV void phase_attn_lru(const P& p, int l, LAS unsigned char* lds, volatile LAS unsigned* misc, int tid) {
    const int nattn = (l == 0) ? 512 + 64 : 512, nitems = nattn + NB * 8 * 18;
    for (;;) {
        __syncthreads();
        if (tid == 0) misc[4] = (unsigned)atomicAdd(p.qctr + l, 1);
        __syncthreads();
        const int u = (int)misc[4];
        if (u >= nitems) break;
        int t2 = tid; asm volatile("" : "+v"(t2));
        if (u >= nattn) { lru_chunk_item(p, l, u - nattn, lds, t2); continue; }
        int b, h, qrow0, nt;
        if (u < 512) { b = u >> 6; h = (u >> 3) & 7; qrow0 = b * S + (u & 7) * 256; nt = KVS / 64; }
        else { const int u2 = u - 512; b = u2 >> 3; h = u2 & 7; qrow0 = TL + b * CL; nt = CL / 64; }
        attn_body::bf16* qp = (attn_body::bf16*)(p.q + (size_t)qrow0 * 512 + h * 64);
        const attn_body::bf16* kp = (const attn_body::bf16*)(p.k + (size_t)b * KVS * 128 + (h >> 2) * 64);
        const attn_body::bf16* vp = (const attn_body::bf16*)(p.v + (size_t)b * KVS * 128 + (h >> 2) * 64);
        attn_body::attn_unit<8>(qp, kp, vp, qp, nt, (char*)lds, t2);
    }
}

constexpr int NCHK = 18;
constexpr int LRU_URAW = 0  , LRU_UB = 16896  , LRU_A = LRU_UB + 18432, LRU_B = LRU_A + 32768, LRU_SEG = LRU_B + 32768  ,
              LRU_PAR = LRU_SEG + 4096  , LRU_END = LRU_PAR + 1280;
static_assert(LRU_END <= RING_BYTES, "LRU LDS map");
DEV void lru_chunk_item(const P& p, int l, int item, LAS unsigned char* lds, int tid) {
    const int c = item % NCHK, n = (item / NCHK) & 7, b = item / (NCHK * 8);
    const int lane = tid & 63, w = __builtin_amdgcn_readfirstlane(tid >> 6), q = lane & 15, cg = lane >> 4;
    LAS bf16_t* Uraw = (LAS bf16_t*)(lds + LRU_URAW);
    LAS bf16_t* Ub = (LAS bf16_t*)(lds + LRU_UB);
    LAS float* Aa = (LAS float*)(lds + LRU_A);
    LAS float* Bb = (LAS float*)(lds + LRU_B);
    LAS float* seg = (LAS float*)(lds + LRU_SEG);
    LAS float* par = (LAS float*)(lds + LRU_PAR);
    const bool isctx = c < 2;
    const int seqbase = isctx ? TL + b * CL : b * S, seqlen = isctx ? CL : S, t0 = isctx ? 128 * c : 128 * (c - 2);
    __syncthreads();
    for (int i = tid; i < 131 * 8; i += NTHR) {
        const int r = i >> 3, pc = i & 7, tok = t0 - 2 + r;
        u32x4 v = (u32x4){0u, 0u, 0u, 0u};
        if (tok >= 0 && tok < seqlen) v = *(const u32x4*)(p.u + (size_t)(seqbase + tok) * 512 + n * 64 + pc * 8);
        *(LAS u32x4*)(Uraw + r * 64 + pc * 8) = v;
    }
    if (tid < 64) {
        par[tid] = p.conv_b[l * 512 + n * 64 + tid];
#pragma unroll
        for (int j = 0; j < 4; ++j) par[64 + j * 64 + tid] = p.conv_w[(l * 4 + j) * 512 + n * 64 + tid];
    }
    __syncthreads();
    float uc[4][4];
#pragma unroll
    for (int ct = 0; ct < 4; ++ct) {
        const int ch0 = ct * 16 + cg * 4;
        f32x4 acc = *(const LAS f32x4*)(par + ch0);
#pragma unroll
        for (int j = 0; j < 4; ++j) {
            const u32x2 raw = *(const LAS u32x2*)(Uraw + (16 * w + q + j) * 64 + ch0); const f32x4 cw = *(const LAS f32x4*)(par + 64 + j * 64 + ch0);
            acc[0] += bflo(raw.x) * cw[0]; acc[1] += bfhi(raw.x) * cw[1]; acc[2] += bflo(raw.y) * cw[2]; acc[3] += bfhi(raw.y) * cw[3];
        }
        uc[ct][0] = acc[0]; uc[ct][1] = acc[1]; uc[ct][2] = acc[2]; uc[ct][3] = acc[3];
        *(LAS u32x2*)(Ub + (16 * w + q) * 72 + ch0) = (u32x2){pack2(acc[0], acc[1]), pack2(acc[2], acc[3])};
    }
    asm volatile("s_waitcnt lgkmcnt(0)" ::: "memory");
    bf16x8 bu[2];
#pragma unroll
    for (int ks = 0; ks < 2; ++ks) bu[ks] = *(const LAS bf16x8*)(Ub + (16 * w + q) * 72 + ks * 32 + cg * 8);
#pragma unroll 1
    for (int d = 0; d < 2; ++d) {
        const int pbase = (l * 2 + d) * 512 + n * 64;
        const bf16_t* wl = p.wt_lru + (size_t)(((l * 2 + d) * 8 + n) * 2) * 4096;
        f32x4 pre[2][4];
#pragma unroll
        for (int g = 0; g < 2; ++g)
#pragma unroll
            for (int ct = 0; ct < 4; ++ct) {
                f32x4 a4 = (f32x4){0.f, 0.f, 0.f, 0.f};
#pragma unroll
                for (int ks = 0; ks < 2; ++ks) { const bf16x8 wv = *(const bf16x8*)(wl + (g * 64 + ct * 16 + q) * 64 + (ks * 4 + cg) * 8); a4 = __builtin_amdgcn_mfma_f32_16x16x32_bf16(wv, bu[ks], a4, 0, 0, 0); }
                pre[g][ct] = a4;
            }
#pragma unroll
        for (int ct = 0; ct < 4; ++ct) {
            const int ch0 = ct * 16 + cg * 4;
            const f32x4 ba = *(const f32x4*)(p.lru_ba + pbase + ch0), bx = *(const f32x4*)(p.lru_bx + pbase + ch0), sp = *(const f32x4*)(p.sptab + pbase + ch0);
            f32x4 av, bv;
#pragma unroll
            for (int j = 0; j < 4; ++j) {
                const float r = sigmoidf_(pre[0][ct][j] + ba[j]), ig = sigmoidf_(pre[1][ct][j] + bx[j]);
                const float log_a = -8.f * r * sp[j];
                av[j] = __expf(log_a);
                bv[j] = __builtin_amdgcn_sqrtf(fmaxf(1.f - __expf(2.f * log_a), 0.f)) * (ig * uc[ct][j]);
            }
            *(LAS f32x4*)(Aa + (16 * w + q) * 64 + ch0) = av; *(LAS f32x4*)(Bb + (16 * w + q) * 64 + ch0) = bv;
        }
        asm volatile("s_waitcnt lgkmcnt(0)" ::: "memory");
        {
            float A = 1.f, H = 0.f;
#pragma unroll
            for (int kk = 0; kk < 16; ++kk) {
                const int pp = d == 0 ? kk : 15 - kk;
                const float a = Aa[(16 * w + pp) * 64 + lane], bb = Bb[(16 * w + pp) * 64 + lane];
                H = a * H + bb; A = A * a;
                Aa[(16 * w + pp) * 64 + lane] = A; Bb[(16 * w + pp) * 64 + lane] = H;
            }
            seg[w * 64 + lane] = A; seg[512 + w * 64 + lane] = H;
        }
        __syncthreads();
        float hin = 0.f, apre = 1.f;
        if (d == 0) { for (int sgi = 0; sgi < w; ++sgi) { const float sa = seg[sgi * 64 + lane]; hin = sa * hin + seg[512 + sgi * 64 + lane]; apre *= sa; } }
        else { for (int sgi = 7; sgi > w; --sgi) { const float sa = seg[sgi * 64 + lane]; hin = sa * hin + seg[512 + sgi * 64 + lane]; apre *= sa; } }
        if (w == (d == 0 ? 7 : 0)) {
            const float sa = seg[w * 64 + lane]; const size_t ti = ((size_t)((b * 2 + d) * NCHK + c)) * 512 + n * 64 + lane;
            p.totA[ti] = apre * sa; p.totH[ti] = sa * hin + seg[512 + w * 64 + lane];
        }
        {
            const size_t o0 = ((size_t)d * TT + seqbase + t0 + 16 * w) * 512 + n * 64 + lane;
            bf16_t* hp = p.hl + o0; bf16_t* ap = p.ac + o0;
#pragma unroll
            for (int pp = 0; pp < 16; ++pp) {
                const float aq = Aa[(16 * w + pp) * 64 + lane];
                hp[(size_t)pp * 512] = (bf16_t)f2bf(Bb[(16 * w + pp) * 64 + lane] + aq * hin); ap[(size_t)pp * 512] = (bf16_t)f2bf(aq * apre);
            }
        }
        __syncthreads();
    }
}

DEV void phase_mix(const P& p, int l, int bid, int nb, LAS unsigned char* lds) {
    const int tid = otid(), lane = tid & 63, wv = tid >> 6;
    LAS float* cin = (LAS float*)lds;
    const int nitems = NB * NCHK;
    for (int it = bid; it < nitems; it += nb) {
        const int b = it / NCHK, c = it - b * NCHK;
        if (l == 1 && c < 2) continue;
        __syncthreads();
        {
            const int ch = tid;
            const float* tA = p.totA + (size_t)(b * 2) * NCHK * 512 + ch; const float* tH = p.totH + (size_t)(b * 2) * NCHK * 512 + ch;
            float fa[NCHK], fh[NCHK], ba_[NCHK], bh[NCHK];
#pragma unroll
            for (int cc = 0; cc < NCHK; ++cc) { fa[cc] = tA[cc * 512]; fh[cc] = tH[cc * 512]; ba_[cc] = tA[(NCHK + cc) * 512]; bh[cc] = tH[(NCHK + cc) * 512]; }
            float h = 0.f;
#pragma unroll
            for (int cc = 0; cc < NCHK; ++cc) if (cc < c) h = fa[cc] * h + fh[cc];
            cin[ch] = h;
            const int pos = c == 1 ? 0 : (c == 0 ? 1 : 2 + (NCHK - 1 - c));
            h = 0.f;
            if (0 < pos) h = bh[1];
            if (1 < pos) h = ba_[0] * h + bh[0];
#pragma unroll
            for (int k = 2; k < NCHK; ++k) if (k < pos) h = ba_[NCHK + 1 - k] * h + bh[NCHK + 1 - k];
            cin[512 + ch] = h;
        }
        __syncthreads();
        const int tbase = (c < 2) ? TL + b * CL + 128 * c : b * S + 128 * (c - 2);
        const int c0 = lane * 8;
        float gaq[8], grq[8];
#pragma unroll
        for (int i = 0; i < 8; ++i) { gaq[i] = p.attn_out_g[l * 512 + c0 + i]; grq[i] = p.lru_out_g[l * 512 + c0 + i]; }
        for (int r = wv; r < 128; r += 16) {
            uint4 a4[2], g4[2], hf4[2], hb4[2], af4[2], ab4[2];
#pragma unroll
            for (int rr = 0; rr < 2; ++rr) {
                const size_t t = (size_t)(tbase + r + 8 * rr);
                a4[rr] = *(const uint4*)(p.q + t * 512 + c0); g4[rr] = *(const uint4*)(p.gb + t * 512 + c0);
                hf4[rr] = *(const uint4*)(p.hl + t * 512 + c0); hb4[rr] = *(const uint4*)(p.hl + ((size_t)TT + t) * 512 + c0);
                af4[rr] = *(const uint4*)(p.ac + t * 512 + c0); ab4[rr] = *(const uint4*)(p.ac + ((size_t)TT + t) * 512 + c0);
            }
#pragma unroll
            for (int rr = 0; rr < 2; ++rr) {
                const size_t t = (size_t)(tbase + r + 8 * rr);
                float av[8] = {bflo(a4[rr].x), bfhi(a4[rr].x), bflo(a4[rr].y), bfhi(a4[rr].y), bflo(a4[rr].z), bfhi(a4[rr].z), bflo(a4[rr].w), bfhi(a4[rr].w)};
                const float gv[8] = {bflo(g4[rr].x), bfhi(g4[rr].x), bflo(g4[rr].y), bfhi(g4[rr].y), bflo(g4[rr].z), bfhi(g4[rr].z), bflo(g4[rr].w), bfhi(g4[rr].w)};
                const float hf[8] = {bflo(hf4[rr].x), bfhi(hf4[rr].x), bflo(hf4[rr].y), bfhi(hf4[rr].y), bflo(hf4[rr].z), bfhi(hf4[rr].z), bflo(hf4[rr].w), bfhi(hf4[rr].w)};
                const float hb[8] = {bflo(hb4[rr].x), bfhi(hb4[rr].x), bflo(hb4[rr].y), bfhi(hb4[rr].y), bflo(hb4[rr].z), bfhi(hb4[rr].z), bflo(hb4[rr].w), bfhi(hb4[rr].w)};
                const float af[8] = {bflo(af4[rr].x), bfhi(af4[rr].x), bflo(af4[rr].y), bfhi(af4[rr].y), bflo(af4[rr].z), bfhi(af4[rr].z), bflo(af4[rr].w), bfhi(af4[rr].w)};
                const float ab[8] = {bflo(ab4[rr].x), bfhi(ab4[rr].x), bflo(ab4[rr].y), bfhi(ab4[rr].y), bflo(ab4[rr].z), bfhi(ab4[rr].z), bflo(ab4[rr].w), bfhi(ab4[rr].w)};
                float rv[8]; float sa = 0.f, sr = 0.f;
#pragma unroll
                for (int i = 0; i < 8; ++i) { rv[i] = (hf[i] + af[i] * cin[c0 + i] + hb[i] + ab[i] * cin[512 + c0 + i]) * gelu_tanh(gv[i]); sa += av[i] * av[i]; sr += rv[i] * rv[i]; }
                sa = wave_sum(sa); sr = wave_sum(sr);
                const float ra = rsqrtf(sa * (1.f / 512.f) + EPS), rrs = rsqrtf(sr * (1.f / 512.f) + EPS);
#pragma unroll
                for (int i = 0; i < 8; ++i) { av[i] = av[i] * ra * gaq[i]; rv[i] = rv[i] * rrs * grq[i]; }
                uint4 o; o.x = pack2(av[0], av[1]); o.y = pack2(av[2], av[3]); o.z = pack2(av[4], av[5]); o.w = pack2(av[6], av[7]);
                *(uint4*)(p.xn + t * D + c0) = o;
                o.x = pack2(rv[0], rv[1]); o.y = pack2(rv[2], rv[3]); o.z = pack2(rv[4], rv[5]); o.w = pack2(rv[6], rv[7]);
                *(uint4*)(p.xn + t * D + 512 + c0) = o;
            }
        }
    }
}

DEV void route_select(const float (&lg)[16], const float* rb, int& e1, int& e2, float& w1n, float& w2n) {
    float sc_[16], bi[16];
#pragma unroll
    for (int e = 0; e < 16; ++e) { sc_[e] = __builtin_amdgcn_rcpf(1.f + __expf(-lg[e])); bi[e] = sc_[e] + rb[e]; }
    float gs[4];
#pragma unroll
    for (int g = 0; g < 4; ++g) {
        const float a = bi[g * 4], b = bi[g * 4 + 1], c = bi[g * 4 + 2], d = bi[g * 4 + 3];
        const float m1 = fmaxf(fmaxf(a, b), fmaxf(c, d));
        const float m2 = fmaxf(fmaxf(fminf(a, b), fminf(c, d)), fminf(fmaxf(a, b), fmaxf(c, d)));
        gs[g] = m1 + m2;
    }
    int bg = 0; float bgs = gs[0];
#pragma unroll
    for (int g = 1; g < 4; ++g) if (gs[g] > bgs) { bgs = gs[g]; bg = g; }
    float v0 = 0.f, v1 = 0.f, v2 = 0.f, v3 = 0.f, s0 = 0.f, s1 = 0.f, s2 = 0.f, s3 = 0.f;
#pragma unroll
    for (int g = 0; g < 4; ++g) if (bg == g) { v0 = bi[g * 4]; v1 = bi[g * 4 + 1]; v2 = bi[g * 4 + 2]; v3 = bi[g * 4 + 3]; s0 = sc_[g * 4]; s1 = sc_[g * 4 + 1]; s2 = sc_[g * 4 + 2]; s3 = sc_[g * 4 + 3]; }
    int i1 = 0; float b1 = v0, w1 = s0;
    if (v1 > b1) { b1 = v1; i1 = 1; w1 = s1; }
    if (v2 > b1) { b1 = v2; i1 = 2; w1 = s2; }
    if (v3 > b1) { b1 = v3; i1 = 3; w1 = s3; }
    int i2 = -1; float b2 = -1e30f, w2 = 0.f;
    if (i1 != 0 && v0 > b2) { b2 = v0; i2 = 0; w2 = s0; }
    if (i1 != 1 && v1 > b2) { b2 = v1; i2 = 1; w2 = s1; }
    if (i1 != 2 && v2 > b2) { b2 = v2; i2 = 2; w2 = s2; }
    if (i1 != 3 && v3 > b2) { b2 = v3; i2 = 3; w2 = s3; }
    const float inv = __builtin_amdgcn_rcpf(w1 + w2);
    e1 = bg * 4 + i1; e2 = bg * 4 + i2; w1n = w1 * inv; w2n = w2 * inv;
}
DEV void phase_route(const P& p, int l, int bid, int nb, LAS unsigned char* lds) {
    const int tid = otid(), lane = tid & 63, wv = tid >> 6;
    const int nrows = l == 0 ? TT : TL;
    const int rpw = (nrows + nb * 8 - 1) / (nb * 8);
    const int r0 = (bid * 8 + wv) * rpw, r1 = min(r0 + rpw, nrows);
    LAS int* lcnt = (LAS int*)lds;
    LAS int* lbase = (LAS int*)(lds + 64);
    LAS i32x2* ent = (LAS i32x2*)(lds + 128);
    LAS float* rwT = (LAS float*)(lds + 4096);
    __syncthreads();
    if (tid < NE) lcnt[tid] = 0;
    {
        f32x4 rwv[8];
#pragma unroll
        for (int k = 0; k < 8; ++k) rwv[k] = *(const f32x4*)(p.router_w + (size_t)(tid + NTHR * k) * 4);
#pragma unroll
        for (int k = 0; k < 8; ++k) { const int i4 = tid + NTHR * k, d = i4 >> 2, e0 = (i4 & 3) * 4;
#pragma unroll
            for (int j = 0; j < 4; ++j) rwT[(e0 + j) * 1024 + d] = rwv[k][j]; }
    }
    __syncthreads();
    f32x4 ng[4];
#pragma unroll
    for (int i = 0; i < 4; ++i) ng[i] = *(const f32x4*)(p.norm2_g + l * D + i * 256 + lane * 4);
    for (int t0 = r0; t0 < r1; t0 += 2) {
        f32x4 xr[2][4], sh[2][4], sc[2][4];
#pragma unroll
        for (int rr = 0; rr < 2; ++rr) {
            const int t = min(t0 + rr, r1 - 1);
            const float* src = p.xres + (size_t)t * D; const float* mm = p.mod + (size_t)(l * 9 + mod_row(t)) * 6144;
#pragma unroll
            for (int i = 0; i < 4; ++i) { const int c0 = i * 256 + lane * 4; xr[rr][i] = *(const f32x4*)(src + c0); sh[rr][i] = *(const f32x4*)(mm + 3072 + c0); sc[rr][i] = *(const f32x4*)(mm + 4096 + c0); }
        }
#pragma unroll
        for (int rr = 0; rr < 2; ++rr) {
            const int t = t0 + rr;
            if (t < r1) {
                float ss = 0.f;
#pragma unroll
                for (int i = 0; i < 4; ++i)
#pragma unroll
                    for (int j = 0; j < 4; ++j) ss += xr[rr][i][j] * xr[rr][i][j];
                ss = wave_sum(ss);
                const float rstd = rsqrtf(ss * (1.f / D) + EPS);
                float lg[16];
#pragma unroll
                for (int e = 0; e < 16; ++e) lg[e] = 0.f;
#pragma unroll
                for (int i = 0; i < 4; ++i) {
                    const int c0 = i * 256 + lane * 4;
                    const f32x4 o = xr[rr][i] * rstd * ng[i] * (sc[rr][i] + 1.f) + sh[rr][i];
                    *(uint2*)(p.xn + (size_t)t * D + c0) = make_uint2(pack2(o[0], o[1]), pack2(o[2], o[3]));
#pragma unroll
                    for (int e = 0; e < 16; ++e) { const f32x4 r4 = *(const LAS f32x4*)(rwT + e * 1024 + c0); lg[e] += o[0] * r4[0] + o[1] * r4[1] + o[2] * r4[2] + o[3] * r4[3]; }
                }
#pragma unroll
                for (int e = 0; e < 16; ++e) lg[e] = wave_sum(lg[e]);
                int e1, e2; float w1, w2;
                route_select(lg, p.router_b, e1, e2, w1, w2);
                if (lane == 0) {
                    p.tokw[2 * t] = w1; p.tokw[2 * t + 1] = w2;
                    const int p1 = __hip_atomic_fetch_add(&lcnt[e1], 1, __ATOMIC_RELAXED, __HIP_MEMORY_SCOPE_WORKGROUP);
                    const int p2 = __hip_atomic_fetch_add(&lcnt[e2], 1, __ATOMIC_RELAXED, __HIP_MEMORY_SCOPE_WORKGROUP);
                    const int nloc = wv * rpw + (t - r0);
                    ent[2 * nloc] = (i32x2){2 * t, (e1 << 16) | p1}; ent[2 * nloc + 1] = (i32x2){2 * t + 1, (e2 << 16) | p2};
                }
            }
        }
    }
    __syncthreads();
    if (tid < NE) lbase[tid] = atomicAdd(&p.cnt[l * 16 + tid], lcnt[tid]);
    __syncthreads();
    for (int i = tid; i < 8 * rpw * 2; i += NTHR) {
        const int nloc = i >> 1, wq = nloc / rpw, k = nloc - wq * rpw;
        if ((bid * 8 + wq) * rpw + k < nrows) { const i32x2 en = ent[i]; const int e = en.y >> 16; p.list[e * TT + lbase[e] + (en.y & 0xffff)] = en.x; }
    }
}

__global__ void __launch_bounds__(NTHR, 2) fwd_megakernel(P p) {
    extern __shared__ __attribute__((aligned(16))) unsigned char lds_raw[];
    LAS unsigned char* lds = (LAS unsigned char*)lds_raw;
    volatile LAS unsigned* misc = (volatile LAS unsigned*)(lds + MISC_OFF);
    if (threadIdx.x < 16) misc[threadIdx.x] = 0u;
    __syncthreads();
    XcdBarrier gbar = xcd_barrier_post(p.bar, misc);
    const int bid = blockIdx.x, nb = gridDim.x;
    LAS float* rope_l = (LAS float*)(lds + MISC_OFF + MISC_ROPE);
    LAS i32x2* ptab = (LAS i32x2*)(lds + MISC_OFF + MISC_PTAB);
    {
        const int tid = otid();
        for (int i = tid; i < 1024; i += NTHR) {
            const int pos = i >> 4, f = i & 15;
            const float inv = exp2f(-(float)(2 * f) / 32.f * 13.287712379549449f);
            const float ang = (float)pos * inv;
            rope_l[i] = __cosf(ang); rope_l[1024 + i] = __sinf(ang);
        }
    }
    phase_prologue(p, bid, nb, lds);
    xcd_barrier(gbar);
#pragma unroll
    for (int l = 0; l < 2; ++l) {
        if (l == 0) phase_rowA<0>(p, l, bid, nb);
        else {
            phase_rowA<1>(p, l, bid, nb);
            const int tid = otid();
            convert_experts(p, 1, bid * 8 + (tid >> 6), nb * 8, (LAS float*)(lds + (tid >> 6) * 16384), tid & 63);
        }
        xcd_barrier(gbar);
        {
            const int tid = otid();
            pg8::GemmPlain g{p.xn, p.wt_in + (size_t)l * INW * D, D};
            pg8::RowMajorOrder so{7, (TT / 256) * 7, nb, bid};
            EpiIn E{&p, l, rope_l};
            pg8::gemm_phase<EpiIn, pg8::GemmPlain, pg8::RowMajorOrder, true>(lds, g, so, E, tid);
        }
        xcd_barrier(gbar);
        { const int tid = otid(); phase_attn_lru(p, l, lds, misc, tid); }
        xcd_barrier(gbar);
        phase_mix(p, l, bid, nb, lds);
        xcd_barrier(gbar);
        {
            const int tid = otid();
            pg8::GemmPlain g{p.xn, p.wt_out + (size_t)l * D * D, D};
            pg8::RowMajorOrder so{4, ((l == 0 ? TT : TL) / 256) * 4, nb, bid};
            EpiOut E{&p, l};
            pg8::gemm_phase<EpiOut, pg8::GemmPlain, pg8::RowMajorOrder, true>(lds, g, so, E, tid);
        }
        xcd_barrier(gbar);
        phase_route(p, l, bid, nb, lds);
        xcd_barrier(gbar);
        {
            const int tid = otid();
            const int np = moe_build_ptab(p.cnt + l * 16, ptab, tid);
            MoeUpDesc g{p.xn, p.wt_gu, D, ptab, p.cnt + l * 16, p.list};
            pg8::RowMajorOrder so{4, np * 4, nb, bid};
            EpiMoeUp E{p.hid};
            pg8::gemm_phase<EpiMoeUp, MoeUpDesc, pg8::RowMajorOrder, true>(lds, g, so, E, tid);
        }
        xcd_barrier(gbar);
        {
            const int tid = otid();
            const int np = ptab[MAXPANELS].x;
            MoeDownDesc g{p.hid, p.wt_d, DE, ptab};
            pg8::RowMajorOrder so{4, np * 4, nb, bid};
            EpiMoeDown E{p.y, p.tokw, ptab, p.cnt + l * 16, p.list};
            pg8::gemm_phase<EpiMoeDown, MoeDownDesc, pg8::RowMajorOrder, true>(lds, g, so, E, tid);
        }
        xcd_barrier(gbar);
    }
    phase_rowA<2>(p, 1, bid, nb);
}

extern "C" void kernel_launch(void* const* d_in, const int* in_sizes, int n_in, void* d_out, int out_size, void* d_ws, size_t ws_size, hipStream_t stream) {
    P p{};
    const float* const* in = (const float* const*)d_in;
    p.x = in[0]; p.c = in[1]; p.ctx = in[2]; p.c_ctx = in[3]; p.ada_w = in[4]; p.ada_b = in[5]; p.norm1_g = in[6]; p.w_in = in[7]; p.q_norm_g = in[8]; p.k_norm_g = in[9];
    p.conv_w = in[10]; p.conv_b = in[11]; p.lru_wa = in[12]; p.lru_ba = in[13]; p.lru_wx = in[14]; p.lru_bx = in[15]; p.lru_lambda = in[16]; p.attn_out_g = in[17];
    p.lru_out_g = in[18]; p.w_out = in[19]; p.norm2_g = in[20]; p.router_w = in[21]; p.router_b = in[22]; p.w_gate = in[23]; p.w_up = in[24]; p.w_down = in[25]; p.final_g = in[26];
    p.out = (float*)d_out;
    char* ws = (char*)d_ws; size_t off = 0;
    auto carve = [&](size_t bytes) { void* r = ws + off; off += (bytes + 255) & ~(size_t)255; return r; };
    p.bar = (unsigned*)carve(XCD_BAR_WORDS * 4);
    p.cnt = (int*)carve(32 * 4);
    p.qctr = (int*)carve(64 * 4);
    const size_t ctl_bytes = off;
    p.mod = (float*)carve((size_t)2 * 9 * 6144 * 4);
    p.tokw = (float*)carve((size_t)2 * TT * 4);
    p.list = (int*)carve((size_t)NE * TT * 4);
    p.sptab = (float*)carve(2 * 2 * 512 * 4);
    p.totA = (float*)carve((size_t)NB * 2 * NCHK * 512 * 4);
    p.totH = (float*)carve((size_t)NB * 2 * NCHK * 512 * 4);
    p.wt_lru = (bf16_t*)carve((size_t)2 * 2 * 8 * 2 * 4096 * 2);
    p.wt_in = (bf16_t*)carve((size_t)2 * INW * D * 2);
    p.wt_out = (bf16_t*)carve((size_t)2 * D * D * 2);
    p.wt_gu = (bf16_t*)carve((size_t)NE * D * D * 2);
    p.wt_d = (bf16_t*)carve((size_t)NE * D * DE * 2);
    p.xres = (float*)carve((size_t)TT * D * 4);
    p.xn = (bf16_t*)carve((size_t)TT * D * 2);
    p.hid = (bf16_t*)carve((size_t)MAXPANELS * 256 * DE * 2);
    p.q = (bf16_t*)carve((size_t)TT * 512 * 2);
    p.y = p.q;
    p.k = (bf16_t*)carve((size_t)TT * 128 * 2);
    p.v = (bf16_t*)carve((size_t)TT * 128 * 2);
    p.u = (bf16_t*)carve((size_t)TT * 512 * 2);
    p.gb = (bf16_t*)carve((size_t)TT * 512 * 2);
    p.hl = (bf16_t*)carve((size_t)2 * TT * 512 * 2);
    p.ac = p.hid;
    if (off > ws_size) { fprintf(stderr, "workspace too small: need %zu have %zu\n", off, ws_size); return; }
    static int grid_blocks = 0;
    if (!grid_blocks) {
        int dev = 0, cus = 0;
        (void)hipGetDevice(&dev);
        (void)hipDeviceGetAttribute(&cus, hipDeviceAttributeMultiprocessorCount, dev);
        if (hipFuncSetAttribute((const void*)fwd_megakernel, hipFuncAttributeMaxDynamicSharedMemorySize, LDS_BYTES) != hipSuccess) { fprintf(stderr, "hipFuncSetAttribute failed\n"); grid_blocks = -1; return; }
        grid_blocks = cus > 0 ? cus : 256;
    }
    if (grid_blocks < 0) return;
    (void)hipMemsetAsync(ws, 0, ctl_bytes, stream);
    hipLaunchKernelGGL(fwd_megakernel, dim3(grid_blocks), dim3(NTHR), LDS_BYTES, stream, p);
}
```

```cpp
#include <hip/hip_runtime.h>
#include <stdint.h>
#include <cstdio>

#define DEV __device__ __forceinline__
#define LAS __attribute__((address_space(3)))
typedef unsigned short bf16_t;
typedef short bf16x8 __attribute__((ext_vector_type(8)));
typedef float f32x4 __attribute__((ext_vector_type(4)));
typedef unsigned u32x4 __attribute__((ext_vector_type(4)));
typedef unsigned u32x2 __attribute__((ext_vector_type(2)));
typedef int i32x2 __attribute__((ext_vector_type(2)));

constexpr int D = 1024, NB = 8, S = 2048, CL = 256, TL = NB * S, TC = NB * CL, TT = TL + TC, KVS = CL + S;
constexpr int INW = 1792, NE = 16, DE = 512;
constexpr float EPS = 1e-6f;
constexpr int NTHR = 512;
constexpr int RING_BYTES = 131072, MISC_OFF = RING_BYTES, LDS_BYTES = 147456;
constexpr int MAXPANELS = 2 * TT / 256 + NE;
constexpr int MISC_ROPE = 64, MISC_PTAB = 64 + 8192;

DEV float bf2f(bf16_t v) { return __uint_as_float(((unsigned)v) << 16); }
DEV unsigned f2bf(float f) { unsigned u = __float_as_uint(f); return (u + 0x7fffu + ((u >> 16) & 1u)) >> 16; }
DEV float bflo(unsigned w) { return __uint_as_float(w << 16); }
DEV float bfhi(unsigned w) { return __uint_as_float(w & 0xffff0000u); }
DEV unsigned pack2(float lo, float hi) { return f2bf(lo) | (f2bf(hi) << 16); }
template <int CTRL> DEV float dpp_mov(float v) { return __builtin_bit_cast(float, __builtin_amdgcn_update_dpp(0, __builtin_bit_cast(int, v), CTRL, 0xf, 0xf, true)); }
DEV float wave_sum(float v) {
    v += dpp_mov<0xB1>(v);
    v += dpp_mov<0x4E>(v);
    v += dpp_mov<0x141>(v);
    v += dpp_mov<0x140>(v);
    auto r = __builtin_amdgcn_permlane16_swap(__float_as_uint(v), __float_as_uint(v), false, false);
    v = __uint_as_float(r[0]) + __uint_as_float(r[1]);
    r = __builtin_amdgcn_permlane32_swap(__float_as_uint(v), __float_as_uint(v), false, false);
    return __uint_as_float(r[0]) + __uint_as_float(r[1]);
}
DEV float sigmoidf_(float x) { return __builtin_amdgcn_rcpf(1.f + __expf(-x)); }
DEV float gelu_tanh(float x) {
    const float u = 0.7978845608028654f * (x + 0.044715f * x * x * x);
    const float e = __expf(2.f * u);
    const float th = 1.f - 2.f * __builtin_amdgcn_rcpf(e + 1.f);
    return 0.5f * x * (1.f + th);
}
constexpr float attn_body_C2 = 0.125f * 1.4426950408889634f;
DEV int otid() { int t = threadIdx.x; asm volatile("" : "+v"(t)); return t; }
DEV int mod_row(int t) { return t < TL ? (t >> 11) : 8; }
DEV int kv_row(int t) { return t < TL ? (t >> 11) * KVS + CL + (t & 2047) : ((t - TL) >> 8) * KVS + ((t - TL) & 255); }

struct P {
    const float *x, *c, *ctx, *c_ctx, *ada_w, *ada_b, *norm1_g, *w_in, *q_norm_g, *k_norm_g, *conv_w, *conv_b, *lru_wa, *lru_ba, *lru_wx, *lru_bx,
        *lru_lambda, *attn_out_g, *lru_out_g, *w_out, *norm2_g, *router_w, *router_b, *w_gate, *w_up, *w_down, *final_g;
    float* out;
    float *mod, *xres, *tokw, *sptab, *totA, *totH;
    bf16_t *xn, *q, *k, *v, *u, *gb, *hl, *ac, *hid, *y;
    bf16_t *wt_in, *wt_out, *wt_gu, *wt_d, *wt_lru;
    int *cnt, *list, *qctr;
    unsigned* bar;
};

#define XB_TMO      128
#define XB_XCNT(j)  (256  + 64 * (j))
#define XB_XSUB(j)  (1280 + 64 * (j))
#define XB_XGEN(j)  (2304 + 64 * (j))
#define XB_TOP      3328
#define XB_TOPGEN   3392
#define XCD_BAR_WORDS 3456
#define XB_SPIN_CAP (1u << 20)
DEV unsigned xb_ld(unsigned* p) { return __hip_atomic_load(p, __ATOMIC_RELAXED, __HIP_MEMORY_SCOPE_AGENT); }
DEV unsigned xb_add(unsigned* p, unsigned v) { return __hip_atomic_fetch_add(p, v, __ATOMIC_RELAXED, __HIP_MEMORY_SCOPE_AGENT); }
DEV unsigned xb_xcc_id() { return (unsigned)__builtin_amdgcn_s_getreg((3 << 11) | 20) & 0xFu; }
#define XB_SPIN(cond, bar) do { unsigned _sp = 0; while (cond) { __builtin_amdgcn_s_sleep(1); \
    if ((++_sp & 255u) == 0u) { if (xb_ld(&(bar)[XB_TMO])) break; if (_sp > XB_SPIN_CAP) { atomicAdd(&(bar)[XB_TMO], 1u); break; } } } } while (0)
struct XcdBarrier { unsigned* bar; unsigned x; volatile LAS unsigned* st; };
DEV XcdBarrier xcd_barrier_post(unsigned* bar, volatile LAS unsigned* st) {
    XcdBarrier b; b.bar = bar; b.x = xb_xcc_id(); b.st = st;
    if (threadIdx.x == 0) { (void)xb_add(&bar[XB_XCNT(b.x)], 1u); st[2] = b.x; }
    return b;
}
DEV void xcd_barrier_complete(unsigned* bar, unsigned x, unsigned& nloc, unsigned& nx) {
    const unsigned G = gridDim.x * gridDim.y * gridDim.z;
    unsigned sum, cnt, mine, sp = 0u;
    for (;;) {
        sum = 0u; cnt = 0u; mine = 0u;
#pragma unroll
        for (unsigned j = 0; j < 16; ++j) { const unsigned c = xb_ld(&bar[XB_XCNT(j)]); sum += c; cnt += (c > 0u) ? 1u : 0u; mine = (j == x) ? c : mine; }
        if (sum == G) break;
        __builtin_amdgcn_s_sleep(1);
        if ((++sp & 255u) == 0u) { if (xb_ld(&bar[XB_TMO])) break; if (sp > XB_SPIN_CAP) { atomicAdd(&bar[XB_TMO], 1u); break; } }
    }
    nloc = mine > 0u ? mine : 1u; nx = cnt > 0u ? cnt : 1u;
}
DEV void xcd_barrier(const XcdBarrier& b) {
    asm volatile("s_waitcnt vmcnt(0)" ::: "memory");
    __syncthreads();
    if (threadIdx.x == 0) {
        unsigned* bar = b.bar;
        __builtin_amdgcn_s_waitcnt(0);
        unsigned nloc = b.st[0], nx = b.st[1]; const unsigned bx = b.st[2];
        if (nloc == 0u) { xcd_barrier_complete(bar, bx, nloc, nx); b.st[0] = nloc; b.st[1] = nx; }
        const unsigned old = xb_add(&bar[XB_XSUB(bx)], 1u);
        const unsigned gen = old / nloc;
        if (old + 1u == (gen + 1u) * nloc) {
            __builtin_amdgcn_fence(__ATOMIC_RELEASE, "agent");
            asm volatile("s_waitcnt vmcnt(0)" ::: "memory");
            const unsigned og = xb_add(&bar[XB_TOP], 1u);
            const unsigned tg = og / nx;
            if (og + 1u == (tg + 1u) * nx) xb_add(&bar[XB_TOPGEN], 1u);
            else XB_SPIN(xb_ld(&bar[XB_TOPGEN]) == tg, bar);
            __builtin_amdgcn_fence(__ATOMIC_ACQUIRE, "agent");
            xb_add(&bar[XB_XGEN(bx)], 1u);
            asm volatile("s_waitcnt vmcnt(0)" ::: "memory");
        } else {
            XB_SPIN(xb_ld(&bar[XB_XGEN(bx)]) == gen, bar);
            __builtin_amdgcn_fence(__ATOMIC_ACQUIRE, "agent");
            asm volatile("s_waitcnt vmcnt(0)" ::: "memory");
        }
    }
    __syncthreads();
}

namespace pg8 {
constexpr int BM = 256, BK = 64, HALF = 128, HTB = HALF * BK * 2, STAGE_BYTES = 8 * HTB;
DEV int lds_byte(int r, int c) { const int st = (r >> 4) * 2 + (c >> 5), rr = r & 15, cc = c & 31, ob = rr * 64 + cc * 2; return st * 1024 + (ob ^ (((ob >> 9) & 1) << 5)); }
DEV void stage_rc(int b, int& R, int& C) { const int st = b / 1024, sb = b % 1024, swz = sb ^ (((sb >> 9) & 1) << 5); R = (st >> 1) * 16 + swz / 64; C = (st & 1) * 32 + (swz % 64) / 2; }
DEV int perm32(int rho) { const int n = rho >> 4, i = rho & 15; return 8 * (i >> 2) + 4 * n + (i & 3); }
struct Unit { int pm, pn; };

template <class Epi, class G, class Sched, bool ALIGN_EPI>
DEV void gemm_phase(LAS unsigned char* lds, const G& g, const Sched& S, const Epi& E, const int tid) {
    const int wid = __builtin_amdgcn_readfirstlane(tid >> 6), lane = tid & 63, wr = wid >> 2, wc = wid & 3, fr = lane & 15, fq = lane >> 4;
    const int K = g.K, nt = K / BK;
    int sR[2], sC[2]; unsigned voffB[2];
#pragma unroll
    for (int i = 0; i < 2; ++i) { stage_rc(tid * 16 + i * 8192, sR[i], sC[i]); const int Rb = Epi::PERM ? ((sR[i] & ~31) + perm32(sR[i] & 31)) : sR[i];
        voffB[i] = (unsigned)(Rb * K + sC[i]) * 2u; }
    const size_t kstep = (size_t)(BK * 2);
    const size_t hstep = (size_t)HALF * K * 2;
    const unsigned ldsw = (unsigned)wid * 1024u;
    const int aoff = lds_byte(wr * 64 + fr, fq * 8), boff = lds_byte(wc * 32 + fr, fq * 8);
#define PG8_SA(b, h) (((b) * 2 + (h)) * HTB)
#define PG8_SB(b, h) ((4 + (b) * 2 + (h)) * HTB)
#define PG8_STAGE(bufoff, gbase, voff) do { _Pragma("unroll") for (int _i = 0; _i < 2; ++_i) \
        __builtin_amdgcn_global_load_lds((const unsigned*)((const char*)(gbase) + (voff)[_i]), (LAS unsigned*)(lds + (bufoff) + ldsw + _i * 8192), 16, 0, 0); } while (0)
#define PG8_LDA(dst, b, h) do { _Pragma("unroll") for (int m = 0; m < 4; ++m) _Pragma("unroll") for (int k = 0; k < 2; ++k) dst[m][k] = *(const LAS bf16x8*)(lds + PG8_SA(b, h) + aoff + m * 2048 + k * 1024); } while (0)
#define PG8_LDB(dst, b, h) do { _Pragma("unroll") for (int n = 0; n < 2; ++n) _Pragma("unroll") for (int k = 0; k < 2; ++k) dst[n][k] = *(const LAS bf16x8*)(lds + PG8_SB(b, h) + boff + n * 2048 + k * 1024); } while (0)
#define PG8_MMA(ai, bj, At, Bt) do { __builtin_amdgcn_s_setprio(1); _Pragma("unroll") for (int m = 0; m < 4; ++m) _Pragma("unroll") for (int n = 0; n < 2; ++n) _Pragma("unroll") for (int k = 0; k < 2; ++k) \
        acc[ai][bj][m][n] = __builtin_amdgcn_mfma_f32_16x16x32_bf16(Bt[n][k], At[m][k], acc[ai][bj][m][n], 0, 0, 0); __builtin_amdgcn_s_setprio(0); } while (0)
#define PG8_WAIT_V(n) asm volatile("s_waitcnt vmcnt(" #n ")" ::: "memory")
#define PG8_WAIT_L(n) asm volatile("s_waitcnt lgkmcnt(" #n ")" ::: "memory")
#define PG8_BAR __builtin_amdgcn_s_barrier()
#define PG8_SCHED __builtin_amdgcn_sched_barrier(0)
    Unit cur, nxt; int ui = 0;
    if (!S.next(0, cur)) return;
    f32x4 acc[2][2][4][2];
#pragma unroll
    for (int a = 0; a < 2; ++a)
#pragma unroll
        for (int b = 0; b < 2; ++b)
#pragma unroll
            for (int m = 0; m < 4; ++m)
#pragma unroll
                for (int n = 0; n < 2; ++n) acc[a][b][m][n] = (f32x4){0.f, 0.f, 0.f, 0.f};
    bf16x8 At[4][2], B0[2][2], B1[2][2];
    unsigned oc[2][2], on[2][2];
#pragma unroll
    for (int h = 0; h < 2; ++h)
#pragma unroll
        for (int i = 0; i < 2; ++i) oc[h][i] = g.a_off(cur, h, sR[i], sC[i]);
    const char* cA = g.a_base(cur); const char* cB = g.b_base(cur);
    PG8_STAGE(PG8_SB(0, 0), cB, voffB); PG8_STAGE(PG8_SB(0, 1), cB + hstep, voffB); PG8_STAGE(PG8_SA(0, 0), cA, oc[0]); PG8_STAGE(PG8_SA(0, 1), cA, oc[1]);
    if (wr == 1) PG8_BAR;
    PG8_WAIT_V(2); PG8_BAR;
    PG8_STAGE(PG8_SB(1, 0), cB + kstep, voffB); PG8_STAGE(PG8_SA(1, 0), cA + kstep, oc[0]); PG8_STAGE(PG8_SB(1, 1), cB + hstep + kstep, voffB);
    PG8_WAIT_V(6); PG8_BAR;
    for (;;) {
        const bool has_next = S.next(ui + 1, nxt);
#pragma unroll
        for (int h = 0; h < 2; ++h)
#pragma unroll
            for (int i = 0; i < 2; ++i) on[h][i] = has_next ? g.a_off(nxt, h, sR[i], sC[i]) : oc[h][i];
        const char* nA = has_next ? g.a_base(nxt) : cA; const char* nB = has_next ? g.b_base(nxt) : cB;
        for (int t = 0; t < nt; t += 2) {
            const bool last = (t == nt - 2);
            const char* a1 = cA + (size_t)(t + 1) * kstep;
            const char* a2 = last ? nA : cA + (size_t)(t + 2) * kstep; const char* b2 = last ? nB : cB + (size_t)(t + 2) * kstep;
            const char* a3 = a2 + kstep; const char* b3 = b2 + kstep;
            unsigned o2[2][2];
#pragma unroll
            for (int h = 0; h < 2; ++h)
#pragma unroll
                for (int i = 0; i < 2; ++i) o2[h][i] = last ? on[h][i] : oc[h][i];
            PG8_LDB(B0, 0, 0); PG8_LDB(B1, 0, 1); PG8_SCHED; PG8_LDA(At, 0, 0); PG8_STAGE(PG8_SA(1, 1), a1, oc[1]);
            PG8_WAIT_V(8); PG8_WAIT_L(0); PG8_BAR; PG8_MMA(0, 0, At, B0); PG8_MMA(0, 1, At, B1); PG8_BAR; PG8_SCHED;
            PG8_LDA(At, 0, 1); PG8_STAGE(PG8_SB(0, 0), b2, voffB); PG8_STAGE(PG8_SB(0, 1), b2 + hstep, voffB); PG8_STAGE(PG8_SA(0, 0), a2, o2[0]);
            PG8_WAIT_V(8); PG8_WAIT_L(0); PG8_BAR; PG8_MMA(1, 0, At, B0); PG8_MMA(1, 1, At, B1); PG8_BAR; PG8_SCHED;
            PG8_LDB(B0, 1, 0); PG8_LDB(B1, 1, 1); PG8_SCHED; PG8_LDA(At, 1, 0); PG8_STAGE(PG8_SA(0, 1), a2, o2[1]);
            PG8_WAIT_V(8); PG8_WAIT_L(0); PG8_BAR; PG8_MMA(0, 0, At, B0); PG8_MMA(0, 1, At, B1); PG8_BAR; PG8_SCHED;
            PG8_LDA(At, 1, 1); PG8_STAGE(PG8_SB(1, 0), b3, voffB); PG8_STAGE(PG8_SB(1, 1), b3 + hstep, voffB); PG8_STAGE(PG8_SA(1, 0), a3, o2[0]);
            PG8_WAIT_V(8); PG8_WAIT_L(0); PG8_BAR; PG8_MMA(1, 0, At, B0); PG8_MMA(1, 1, At, B1); PG8_BAR; PG8_SCHED;
        }
        if (ALIGN_EPI) { if (wr == 0) PG8_BAR; }
        E(acc, cur, wr, wc, fr, fq);
        if (!has_next) break;
#pragma unroll
        for (int a = 0; a < 2; ++a)
#pragma unroll
            for (int b = 0; b < 2; ++b)
#pragma unroll
                for (int m = 0; m < 4; ++m)
#pragma unroll
                    for (int n = 0; n < 2; ++n) acc[a][b][m][n] = (f32x4){0.f, 0.f, 0.f, 0.f};
        cur = nxt; cA = nA; cB = nB; ++ui;
#pragma unroll
        for (int h = 0; h < 2; ++h)
#pragma unroll
            for (int i = 0; i < 2; ++i) oc[h][i] = on[h][i];
        if (ALIGN_EPI) { if (wr == 1) PG8_BAR; }
    }
    PG8_WAIT_V(0);
    if (!ALIGN_EPI) { if (wr == 0) PG8_BAR; }
    PG8_BAR;
#undef PG8_SA
#undef PG8_SB
#undef PG8_STAGE
#undef PG8_LDA
#undef PG8_LDB
#undef PG8_MMA
#undef PG8_WAIT_V
#undef PG8_WAIT_L
#undef PG8_BAR
#undef PG8_SCHED
}

struct GemmPlain {
    const bf16_t* A; const bf16_t* Bt; int K;
    DEV const char* a_base(const Unit& u) const { return (const char*)A + (size_t)u.pm * (256 * K * 2); }
    DEV const char* b_base(const Unit& u) const { return (const char*)Bt + (size_t)u.pn * (256 * K * 2); }
    DEV unsigned a_off(const Unit&, int h, int R, int C) const { return (unsigned)((h * 128 + R) * K + C) * 2u; }
};
struct RowMajorOrder {
    int nN, nunits, G, c;
    DEV bool next(int i, Unit& u) const { const int L = i * G + c; if (L >= nunits) return false; u.pm = L / nN; u.pn = L - u.pm * nN; return true; }
};
}

template <class RowMap>
DEV void transpose_item(const float* W, int K, int N, bf16_t* WT, LAS float* scr, int item, int lane, const RowMap& rm) {
    const int nblk = N / 32, kb = item / nblk, nbk = item % nblk, k0 = 64 * kb, n0 = 32 * nbk;
    float wr[32];
#pragma unroll
    for (int i = 0; i < 32; ++i) wr[i] = W[(size_t)(k0 + 2 * i + (lane >> 5)) * N + n0 + (lane & 31)];
#pragma unroll
    for (int i = 0; i < 32; ++i) scr[(2 * i + (lane >> 5)) * 33 + (lane & 31)] = wr[i];
    asm volatile("s_waitcnt lgkmcnt(0)" ::: "memory");
    const int c = lane & 7;
#pragma unroll
    for (int j = 0; j < 4; ++j) { const int n = (lane >> 3) + 8 * j; const LAS float* s = scr + (8 * c) * 33 + n;
        u32x4 o; o.x = pack2(s[0 * 33], s[1 * 33]); o.y = pack2(s[2 * 33], s[3 * 33]); o.z = pack2(s[4 * 33], s[5 * 33]); o.w = pack2(s[6 * 33], s[7 * 33]);
        *(u32x4*)(WT + (size_t)rm(n0 + n) * K + k0 + 8 * c) = o; }
    asm volatile("s_waitcnt lgkmcnt(0)" ::: "memory");
}
struct MapId { DEV int operator()(int n) const { return n; } };
struct MapIn { DEV int operator()(int n) const { return (n & ~255) | ((n & 32) << 2) | ((n & 192) >> 1) | (n & 31); } };
template <int NSEL> struct MapGU { DEV int operator()(int h) const { return ((h >> 7) << 8) | (((h >> 6) & 1) << 7) | (((h >> 4) & 3) << 5) | (((h >> 2) & 3) << 3) | (NSEL << 2) | (h & 3); } };

constexpr int IT_IN = (D / 64) * (INW / 32), IT_OUT = (D / 64) * (D / 32), IT_G = (D / 64) * (DE / 32), IT_D = (DE / 64) * (D / 32), IT_EXP = 2 * IT_G + IT_D;
DEV void convert_experts(const P& p, int l, int gw, int ngw, LAS float* scr, int lane) {
    for (int it = gw; it < NE * IT_EXP; it += ngw) {
        const int e = it / IT_EXP; int r = it - e * IT_EXP;
        const size_t le = (size_t)(l * NE + e);
        if (r < IT_G) { transpose_item(p.w_gate + le * D * DE, D, DE, p.wt_gu + (size_t)e * D * D, scr, r, lane, MapGU<0>()); continue; } r -= IT_G;
        if (r < IT_G) { transpose_item(p.w_up + le * D * DE, D, DE, p.wt_gu + (size_t)e * D * D, scr, r, lane, MapGU<1>()); continue; } r -= IT_G;
        transpose_item(p.w_down + le * DE * D, DE, D, p.wt_d + (size_t)e * D * DE, scr, r, lane, MapId());
    }
}
DEV void phase_prologue(const P& p, int bid, int nb, LAS unsigned char* lds) {
    const int tid = otid(), lane = tid & 63, wv = tid >> 6;
    {
        LAS float* sil = (LAS float*)lds;
        LAS float* red = (LAS float*)(lds + 9 * 1024 * 4);
        bool have = false;
        for (int w = bid; w < 2 * 96; w += nb) {
            if (!have) {
                for (int i = tid; i < 9 * 1024; i += NTHR) { const int r = i >> 10, d = i & 1023; const float v = r < 8 ? p.c[r * 1024 + d] : p.c_ctx[d]; sil[i] = v * sigmoidf_(v); }
                have = true;
            }
            __syncthreads();
            const int l = w / 96, col0 = (w % 96) * 64, kq = tid >> 4, c4 = (tid & 15) * 4;
            const float* wp = p.ada_w + (size_t)l * 1024 * 6144 + col0 + c4;
            float acc[9][4];
#pragma unroll
            for (int r = 0; r < 9; ++r)
#pragma unroll
                for (int j = 0; j < 4; ++j) acc[r][j] = 0.f;
#pragma unroll 16
            for (int i = 0; i < 32; ++i) {
                const int k = kq + 32 * i;
                const float4 w4 = *(const float4*)(wp + (size_t)k * 6144);
#pragma unroll
                for (int r = 0; r < 9; ++r) { const float sv = sil[r * 1024 + k]; acc[r][0] += sv * w4.x; acc[r][1] += sv * w4.y; acc[r][2] += sv * w4.z; acc[r][3] += sv * w4.w; }
            }
#pragma unroll
            for (int r = 0; r < 9; ++r)
#pragma unroll
                for (int j = 0; j < 4; ++j) red[(kq * 64 + c4 + j) * 9 + r] = acc[r][j];
            __syncthreads();
            for (int o = tid; o < 64 * 9; o += NTHR) {
                const int cc = o / 9, r = o - cc * 9; float s = 0.f;
#pragma unroll 8
                for (int g = 0; g < 32; ++g) s += red[(g * 64 + cc) * 9 + r];
                p.mod[(size_t)(l * 9 + r) * 6144 + col0 + cc] = s + p.ada_b[l * 6144 + col0 + cc];
            }
        }
        __syncthreads();
    }
    {
        LAS float* scr = (LAS float*)(lds + wv * 16384);
        const int gw = bid * 8 + wv, ngw = nb * 8;
        for (int it = gw; it < 2 * (IT_IN + IT_OUT); it += ngw) {
            const int l = it / (IT_IN + IT_OUT); int r = it - l * (IT_IN + IT_OUT);
            if (r < IT_IN) transpose_item(p.w_in + (size_t)l * D * INW, D, INW, p.wt_in + (size_t)l * INW * D, scr, r, lane, MapIn());
            else transpose_item(p.w_out + (size_t)l * D * D, D, D, p.wt_out + (size_t)l * D * D, scr, r - IT_IN, lane, MapId());
        }
        for (int it = gw; it < 2 * 2 * 8 * 2 * 2; it += ngw) {
            const int m = it >> 2, g = (it >> 1) & 1, r = it & 1;
            transpose_item((g ? p.lru_wx : p.lru_wa) + (size_t)m * 4096, 64, 64, p.wt_lru + (size_t)(m * 2 + g) * 4096, scr, r, lane, MapId());
        }
        convert_experts(p, 0, gw, ngw, scr, lane);
        if (bid == nb - 1) for (int i = tid; i < 2 * 2 * 512; i += NTHR) { const float lam = p.lru_lambda[i]; p.sptab[i] = (-lam > 20.f) ? -lam : log1pf(__expf(-lam)); }
    }
}

DEV void unpack8(const uint2 a, float (&o)[4]) { o[0] = bflo(a.x); o[1] = bfhi(a.x); o[2] = bflo(a.y); o[3] = bfhi(a.y); }
template <int MODE>
DEV void phase_rowA(const P& p, int l, int bid, int nb) {
    const int tid = otid(), lane = tid & 63, wv = tid >> 6;
    const int nrows = (MODE == 2) ? TL : TT;
    const int rpw = (nrows + nb * 8 - 1) / (nb * 8);
    const int r0 = (bid * 8 + wv) * rpw, r1 = min(r0 + rpw, nrows);
    const int lp = (MODE == 2) ? 1 : 0;
    f32x4 ng[4];
#pragma unroll
    for (int i = 0; i < 4; ++i) ng[i] = *(const f32x4*)((MODE == 2 ? p.final_g : p.norm1_g + l * D) + i * 256 + lane * 4);
    for (int t0 = r0; t0 < r1; t0 += 2) {
        f32x4 xr[2][4], g2[2][4], sh[2][4], sc[2][4]; uint2 ya[2][4], yb[2][4];
#pragma unroll
        for (int rr = 0; rr < 2; ++rr) {
            const int t = min(t0 + rr, r1 - 1), mr = mod_row(t);
            const float* src = (MODE == 0) ? (t < TL ? p.x + (size_t)t * D : p.ctx + (size_t)(t - TL) * D) : p.xres + (size_t)t * D;
            const float* mm = p.mod + (size_t)(l * 9 + mr) * 6144;
#pragma unroll
            for (int i = 0; i < 4; ++i) {
                const int c0 = i * 256 + lane * 4;
                xr[rr][i] = *(const f32x4*)(src + c0);
                if (MODE != 0) { g2[rr][i] = *(const f32x4*)(p.mod + (size_t)(lp * 9 + mr) * 6144 + 5 * 1024 + c0); ya[rr][i] = *(const uint2*)(p.y + (size_t)(2 * t) * D + c0); yb[rr][i] = *(const uint2*)(p.y + (size_t)(2 * t + 1) * D + c0); }
                if (MODE != 2) { sh[rr][i] = *(const f32x4*)(mm + c0); sc[rr][i] = *(const f32x4*)(mm + 1024 + c0); }
            }
        }
#pragma unroll
        for (int rr = 0; rr < 2; ++rr) {
            const int t = t0 + rr;
            if (t < r1) {
                float ss = 0.f;
#pragma unroll
                for (int i = 0; i < 4; ++i) {
                    if (MODE != 0) { float a[4], b[4]; unpack8(ya[rr][i], a); unpack8(yb[rr][i], b);
#pragma unroll
                        for (int j = 0; j < 4; ++j) xr[rr][i][j] += g2[rr][i][j] * (a[j] + b[j]); }
#pragma unroll
                    for (int j = 0; j < 4; ++j) ss += xr[rr][i][j] * xr[rr][i][j];
                }
                if (MODE == 1) {
#pragma unroll
                    for (int i = 0; i < 4; ++i) *(f32x4*)(p.xres + (size_t)t * D + i * 256 + lane * 4) = xr[rr][i];
                }
                ss = wave_sum(ss);
                const float rstd = rsqrtf(ss * (1.f / D) + EPS);
#pragma unroll
                for (int i = 0; i < 4; ++i) {
                    const int c0 = i * 256 + lane * 4;
                    if (MODE == 2) *(f32x4*)(p.out + (size_t)t * D + c0) = xr[rr][i] * rstd * ng[i];
                    else {
                        const f32x4 o = xr[rr][i] * rstd * ng[i] * (sc[rr][i] + 1.f) + sh[rr][i];
                        *(uint2*)(p.xn + (size_t)t * D + c0) = make_uint2(pack2(o[0], o[1]), pack2(o[2], o[3]));
                    }
                }
            }
        }
    }
}

struct EpiIn {
    static constexpr bool PERM = true;
    const P* pp; int l; const LAS float* rope;
    DEV void operator()(const f32x4 (&acc)[2][2][4][2], const pg8::Unit& u, int wr, int wc, int fr, int fq) const {
        const P& p = *pp;
        const int pn = u.pn;
        const bool lat = u.pm < TL / 256;
        const bool is_qk = (pn < 2) || (pn == 2 && wc < 2);
        const float qs = pn < 2 ? attn_body_C2 : 1.f;
        bf16_t* dst; int ld; bool kvmap = false;
        if (pn < 2) { dst = p.q + (pn * 4 + wc) * 64; ld = 512; }
        else if (pn == 2) { dst = (wc < 2 ? p.k + wc * 64 : p.v + (wc - 2) * 64); ld = 128; kvmap = true; }
        else if (pn < 5) { dst = p.u + (pn - 3) * 256 + wc * 64; ld = 512; }
        else { dst = p.gb + (pn - 5) * 256 + wc * 64; ld = 512; }
        float gq[2][2][4];
#pragma unroll
        for (int bj = 0; bj < 2; ++bj)
#pragma unroll
            for (int n = 0; n < 2; ++n)
#pragma unroll
                for (int j = 0; j < 4; ++j) gq[bj][n][j] = 1.f;
        if (is_qk) {
            const float* g = (pn < 2 ? p.q_norm_g : p.k_norm_g) + l * 64;
#pragma unroll
            for (int bj = 0; bj < 2; ++bj)
#pragma unroll
                for (int n = 0; n < 2; ++n) { const float4 g4 = *(const float4*)(g + 32 * bj + 8 * fq + 4 * n); gq[bj][n][0] = g4.x; gq[bj][n][1] = g4.y; gq[bj][n][2] = g4.z; gq[bj][n][3] = g4.w; }
        }
#pragma unroll
        for (int ai = 0; ai < 2; ++ai)
#pragma unroll
            for (int m = 0; m < 4; ++m) {
                const int t = u.pm * 256 + ai * 128 + wr * 64 + m * 16 + fr;
                float v[2][2][4];
#pragma unroll
                for (int bj = 0; bj < 2; ++bj)
#pragma unroll
                    for (int n = 0; n < 2; ++n)
#pragma unroll
                        for (int j = 0; j < 4; ++j) v[bj][n][j] = acc[ai][bj][m][n][j];
                if (is_qk) {
                    float ss = 0.f;
#pragma unroll
                    for (int bj = 0; bj < 2; ++bj)
#pragma unroll
                        for (int n = 0; n < 2; ++n)
#pragma unroll
                            for (int j = 0; j < 4; ++j) ss += v[bj][n][j] * v[bj][n][j];
                    ss += __shfl_xor(ss, 16); ss += __shfl_xor(ss, 32);
                    const float rstd = rsqrtf(ss * (1.f / 64.f) + EPS);
                    const int s = t & 2047;
#pragma unroll
                    for (int bj = 0; bj < 2; ++bj) {
                        const int pos = bj ? (s & 63) : (s >> 6);
#pragma unroll
                        for (int n = 0; n < 2; ++n) {
                            float cs4[4] = {1.f, 1.f, 1.f, 1.f}, sn4[4] = {0.f, 0.f, 0.f, 0.f};
                            if (lat) {
                                const int f0 = 8 * (fq & 1) + 4 * n;
                                const f32x4 c4 = *(const LAS f32x4*)(rope + pos * 16 + f0), s4 = *(const LAS f32x4*)(rope + 1024 + pos * 16 + f0);
                                cs4[0] = c4.x; cs4[1] = c4.y; cs4[2] = c4.z; cs4[3] = c4.w; sn4[0] = s4.x; sn4[1] = s4.y; sn4[2] = s4.z; sn4[3] = s4.w;
                            }
#pragma unroll
                            for (int j = 0; j < 4; ++j) {
                                const float w = v[bj][n][j] * gq[bj][n][j];
                                const float pw = __shfl_xor(w, 32);
                                const float o = (fq & 2) ? (w * cs4[j] + pw * sn4[j]) : (w * cs4[j] - pw * sn4[j]);
                                v[bj][n][j] = o * rstd * qs;
                            }
                        }
                    }
                }
                bf16_t* rowp = dst + (size_t)(kvmap ? kv_row(t) : t) * ld;
#pragma unroll
                for (int bj = 0; bj < 2; ++bj) {
                    u32x4 w; w.x = pack2(v[bj][0][0], v[bj][0][1]); w.y = pack2(v[bj][0][2], v[bj][0][3]); w.z = pack2(v[bj][1][0], v[bj][1][1]); w.w = pack2(v[bj][1][2], v[bj][1][3]);
                    *(u32x4*)(rowp + 32 * bj + 8 * fq) = w;
                }
            }
    }
};
struct EpiOut {
    static constexpr bool PERM = false;
    const P* pp; int l;
    DEV void operator()(const f32x4 (&acc)[2][2][4][2], const pg8::Unit& u, int wr, int wc, int fr, int fq) const {
        const P& p = *pp;
        const int col0 = u.pn * 256 + wc * 32 + 4 * fq;
        const int mr = u.pm < TL / 256 ? (u.pm >> 3) : 8;
        const float* g1 = p.mod + (size_t)(l * 9 + mr) * 6144 + 2048 + col0;
        f32x4 gv[2][2];
#pragma unroll
        for (int bj = 0; bj < 2; ++bj)
#pragma unroll
            for (int n = 0; n < 2; ++n) gv[bj][n] = *(const f32x4*)(g1 + bj * 128 + n * 16);
#pragma unroll
        for (int ai = 0; ai < 2; ++ai)
#pragma unroll
            for (int m = 0; m < 4; ++m) {
                const int t = u.pm * 256 + ai * 128 + wr * 64 + m * 16 + fr;
                const float* res = (l == 0) ? (t < TL ? p.x + (size_t)t * D : p.ctx + (size_t)(t - TL) * D) : p.xres + (size_t)t * D;
                float* o = p.xres + (size_t)t * D + col0;
#pragma unroll
                for (int bj = 0; bj < 2; ++bj)
#pragma unroll
                    for (int n = 0; n < 2; ++n) { const f32x4 r4 = *(const f32x4*)(res + col0 + bj * 128 + n * 16); *(f32x4*)(o + bj * 128 + n * 16) = r4 + gv[bj][n] * acc[ai][bj][m][n]; }
            }
    }
};
struct MoeUpDesc {
    const bf16_t* A; const bf16_t* Bt; int K; const LAS i32x2* ptab; const int* cnt; const int* list;
    DEV const char* a_base(const pg8::Unit&) const { return (const char*)A; }
    DEV const char* b_base(const pg8::Unit& u) const { const int e = ptab[u.pm].x; return (const char*)Bt + ((size_t)e * D + (size_t)u.pn * 256) * (D * 2); }
    DEV unsigned a_off(const pg8::Unit& u, int h, int R, int C) const {
        const i32x2 pe = ptab[u.pm]; const int pos = pe.y + h * 128 + R;
        const int tok = pos < cnt[pe.x] ? (list[pe.x * TT + pos] >> 1) : 0;
        return (unsigned)(tok * D + C) * 2u;
    }
};
struct MoeDownDesc {
    const bf16_t* A; const bf16_t* Bt; int K; const LAS i32x2* ptab;
    DEV const char* a_base(const pg8::Unit& u) const { return (const char*)A + (size_t)u.pm * (256 * DE * 2); }
    DEV const char* b_base(const pg8::Unit& u) const { const int e = ptab[u.pm].x; return (const char*)Bt + ((size_t)e * D + (size_t)u.pn * 256) * (DE * 2); }
    DEV unsigned a_off(const pg8::Unit&, int h, int R, int C) const { return (unsigned)((h * 128 + R) * DE + C) * 2u; }
};
struct EpiMoeUp {
    static constexpr bool PERM = true;
    bf16_t* hid;
    DEV void operator()(const f32x4 (&acc)[2][2][4][2], const pg8::Unit& u, int wr, int wc, int fr, int fq) const {
#pragma unroll
        for (int ai = 0; ai < 2; ++ai)
#pragma unroll
            for (int m = 0; m < 4; ++m) {
                bf16_t* rowp = hid + (size_t)(u.pm * 256 + ai * 128 + wr * 64 + m * 16 + fr) * DE + u.pn * 128 + wc * 16 + fq * 4;
#pragma unroll
                for (int bj = 0; bj < 2; ++bj) {
                    const f32x4 g = acc[ai][bj][m][0], up = acc[ai][bj][m][1];
                    float h[4];
#pragma unroll
                    for (int j = 0; j < 4; ++j) h[j] = g[j] * sigmoidf_(g[j]) * up[j];
                    *(u32x2*)(rowp + bj * 64) = (u32x2){pack2(h[0], h[1]), pack2(h[2], h[3])};
                }
            }
    }
};
struct EpiMoeDown {
    static constexpr bool PERM = true;
    bf16_t* y; const float* tokw; const LAS i32x2* ptab; const int* cnt; const int* list;
    DEV void operator()(const f32x4 (&acc)[2][2][4][2], const pg8::Unit& u, int wr, int wc, int fr, int fq) const {
        const i32x2 pe = ptab[u.pm]; const int ce = cnt[pe.x];
#pragma unroll
        for (int ai = 0; ai < 2; ++ai)
#pragma unroll
            for (int m = 0; m < 4; ++m) {
                const int pos = pe.y + ai * 128 + wr * 64 + m * 16 + fr;
                if (pos < ce) {
                    const int pair = list[pe.x * TT + pos]; const float wt = tokw[pair];
                    bf16_t* rowp = y + (size_t)pair * D + u.pn * 256 + wc * 32 + 8 * fq;
#pragma unroll
                    for (int bj = 0; bj < 2; ++bj) {
                        const f32x4 a0 = acc[ai][bj][m][0] * wt, a1 = acc[ai][bj][m][1] * wt;
                        *(u32x4*)(rowp + bj * 128) = (u32x4){pack2(a0[0], a0[1]), pack2(a0[2], a0[3]), pack2(a1[0], a1[1]), pack2(a1[2], a1[3])};
                    }
                }
            }
    }
};
DEV int moe_build_ptab(const int* cnt, LAS i32x2* ptab, int tid) {
    __syncthreads();
    if (tid < 64) {
        const int c = tid < NE ? cnt[tid] : 0;
        const int npan = (c + 255) >> 8;
        int incl = npan;
#pragma unroll
        for (int o = 1; o < 16; o <<= 1) { const int v = __shfl_up(incl, o); if (tid >= o) incl += v; }
        int base = incl - npan;
#pragma unroll 1
        for (int r0 = 0; r0 < c; r0 += 256) { ptab[base] = (i32x2){tid, r0}; ++base; }
        if (tid == NE - 1) ptab[MAXPANELS] = (i32x2){incl, 0};
    }
    __syncthreads();
    return ptab[MAXPANELS].x;
}

#include <hip/hip_bf16.h>
namespace attn_body {
using bf16=__hip_bfloat16;
using bf16x8=__attribute__((ext_vector_type(8)))short;
using s16x4=__attribute__((ext_vector_type(4)))short;
using f32x16=__attribute__((ext_vector_type(16)))float;
using u32x4=__attribute__((ext_vector_type(4)))unsigned;
constexpr int D=64,QP=512,KP=128;
constexpr int NW=8,QBLK=32,QB=QBLK*NW,KVBLK=64;
__device__ __forceinline__ int crow(int r,int hi){return (r&3)+8*(r>>2)+4*hi;}
#define SBAR() __builtin_amdgcn_sched_barrier(0)
constexpr int NSLOT=3, SLOTB=8192;
constexpr int LDS_K=0, LDS_V=NSLOT*SLOTB, LDS_WS=2*NSLOT*SLOTB, LDS_OST=LDS_WS+NW*64*4, LDS_BYTES=LDS_OST+NW*4096;
constexpr float C2=0.125f*1.4426950408889634f;
__device__ __forceinline__ void glds16(const void*gsrc,unsigned lds_dst){unsigned keep;
  asm volatile("s_mov_b32 %0, m0\n\ts_mov_b32 m0, %2\n\ts_nop 0\n\tglobal_load_lds_dwordx4 %1, off\n\ts_mov_b32 m0, %0":"=&s"(keep):"v"(gsrc),"s"(lds_dst):"memory");}
__device__ __forceinline__ float max3f(float a,float b,float c){float r;asm("v_max3_f32 %0, %1, %2, %3":"=v"(r):"v"(a),"v"(b),"v"(c));return r;}
__device__ __forceinline__ float max2f(float a,float b){float r;asm("v_max_f32_e32 %0, %1, %2":"=v"(r):"v"(a),"v"(b));return r;}
__device__ __forceinline__ float fadd_s(float a,float b){float r;asm("v_add_f32_e32 %0, %1, %2":"=v"(r):"v"(a),"v"(b));return r;}
__device__ __forceinline__ float fsub_s(float a,float b){float r;asm("v_sub_f32_e32 %0, %1, %2":"=v"(r):"v"(a),"v"(b));return r;}
typedef float f32x2_t __attribute__((ext_vector_type(2))); typedef __bf16 bf16x2_t __attribute__((ext_vector_type(2)));
__device__ __forceinline__ unsigned cvtpk_s(float lo,float hi){f32x2_t v={lo,hi};bf16x2_t b=__builtin_convertvector(v,bf16x2_t);return __builtin_bit_cast(unsigned,b);}
#define WAIT_BAR(N) asm volatile("s_waitcnt vmcnt(" #N ") lgkmcnt(0)\n\ts_barrier":::"memory")

__device__ __forceinline__ void qkt(f32x16&p0,f32x16&p1,const char*Kslot,const bf16x8*qr,const f32x16&negm,int r32,int hi){
  const char*kb=Kslot+hi*1024+r32*16;
  #pragma unroll
  for(int d0=0;d0<4;++d0){
    const bf16x8 b0=*reinterpret_cast<const bf16x8*>(kb+d0*2048);
    const bf16x8 b1=*reinterpret_cast<const bf16x8*>(kb+d0*2048+512);
    if(d0==0){p0=__builtin_amdgcn_mfma_f32_32x32x16_bf16(b0,qr[0],negm,0,0,0);p1=__builtin_amdgcn_mfma_f32_32x32x16_bf16(b1,qr[0],negm,0,0,0);}
    else{p0=__builtin_amdgcn_mfma_f32_32x32x16_bf16(b0,qr[d0],p0,0,0,0);p1=__builtin_amdgcn_mfma_f32_32x32x16_bf16(b1,qr[d0],p1,0,0,0);}}
}
typedef __attribute__((address_space(3))) const char* lds_cptr;
typedef short v4i16_t __attribute__((ext_vector_type(4)));
__device__ __forceinline__ void kload8(bf16x8*kf,lds_cptr kp){
  kf[0]=*(const __attribute__((address_space(3))) bf16x8*)(kp);      kf[1]=*(const __attribute__((address_space(3))) bf16x8*)(kp+512);
  kf[2]=*(const __attribute__((address_space(3))) bf16x8*)(kp+2048); kf[3]=*(const __attribute__((address_space(3))) bf16x8*)(kp+2560);
  kf[4]=*(const __attribute__((address_space(3))) bf16x8*)(kp+4096); kf[5]=*(const __attribute__((address_space(3))) bf16x8*)(kp+4608);
  kf[6]=*(const __attribute__((address_space(3))) bf16x8*)(kp+6144); kf[7]=*(const __attribute__((address_space(3))) bf16x8*)(kp+6656);
}
__device__ __forceinline__ void kload2(bf16x8*kf,lds_cptr kp,int j){ kf[2*j]=*(const __attribute__((address_space(3))) bf16x8*)(kp+j*2048); kf[2*j+1]=*(const __attribute__((address_space(3))) bf16x8*)(kp+j*2048+512); }
__device__ __forceinline__ s16x4 vtr(lds_cptr p){ return __builtin_bit_cast(s16x4,__builtin_amdgcn_ds_read_tr16_b64_v4i16((__attribute__((address_space(3))) v4i16_t*)p)); }
__device__ __forceinline__ float rowmax(const f32x16&p0,const f32x16&p1){
  float a=max3f(p0[0],p0[1],p1[0]),b=max3f(p0[2],p0[3],p1[1]);a=max3f(a,p1[2],p1[3]);
  #pragma unroll
  for(int r=4;r<16;r+=4){a=max3f(a,p0[r],p0[r+1]);b=max3f(b,p0[r+2],p0[r+3]);a=max3f(a,p1[r],p1[r+1]);b=max3f(b,p1[r+2],p1[r+3]);}
  const float m=max2f(a,b);
  auto rr=__builtin_amdgcn_permlane32_swap(__float_as_uint(m),__float_as_uint(m),false,false);
  return max2f(__uint_as_float(rr[0]),__uint_as_float(rr[1]));
}
__device__ __forceinline__ void pv(f32x16*o,int vb,bf16x8 pa0,bf16x8 pa1,bf16x8 pa2,bf16x8 pa3){
  #pragma unroll
  for(int d0=0;d0<2;++d0){s16x4 lo[4],hi[4];
    #pragma unroll
    for(int ks=0;ks<4;++ks){
      asm volatile("ds_read_b64_tr_b16 %0,%1 offset:%c2":"=&v"(lo[ks]):"v"(vb),"i"(d0*4096+ks*1024):"memory");
      asm volatile("ds_read_b64_tr_b16 %0,%1 offset:%c2":"=&v"(hi[ks]):"v"(vb),"i"(d0*4096+ks*1024+512):"memory");}
    asm volatile("s_waitcnt lgkmcnt(0)":::"memory");SBAR();
    #define PK(k) (bf16x8){lo[k][0],lo[k][1],lo[k][2],lo[k][3],hi[k][0],hi[k][1],hi[k][2],hi[k][3]}
    o[d0]=__builtin_amdgcn_mfma_f32_32x32x16_bf16(pa0,PK(0),o[d0],0,0,0);
    o[d0]=__builtin_amdgcn_mfma_f32_32x32x16_bf16(pa1,PK(1),o[d0],0,0,0);
    o[d0]=__builtin_amdgcn_mfma_f32_32x32x16_bf16(pa2,PK(2),o[d0],0,0,0);
    o[d0]=__builtin_amdgcn_mfma_f32_32x32x16_bf16(pa3,PK(3),o[d0],0,0,0);
    #undef PK
  }
}

#ifndef ATTN_STORE16
#define ATTN_STORE16(p,v) (*(u32x4*)(p)=(v))
#endif
template<int THRL> __device__ __forceinline__ void attn_unit(const bf16*Qu,const bf16*__restrict__ Kh,const bf16*__restrict__ Vh,bf16*Ou,const int NT,char*shm,const int tid){
  const int lane=tid&63,r32=lane&31,hi=lane>>5; const int wid=__builtin_amdgcn_readfirstlane(tid>>6);
  const bf16*Qw=Qu+(long)(wid*QBLK)*QP;
  const unsigned lds0=(unsigned)(uintptr_t)shm;
  float*wsf=(float*)(shm+LDS_WS)+wid*64;
  const bf16*ksrc=Kh+(long)lane*KP+wid*8;
  const bf16*vsrc=Vh+(long)(16*(wid&3)+(lane>>2))*KP+(wid>>2)*32+(lane&3)*8;
  const unsigned kdst=lds0+LDS_K+wid*1024, vdst=lds0+LDS_V+wid*1024;
  #define DMA_K(t,slot) glds16(ksrc+(long)(t)*KVBLK*KP,(unsigned)__builtin_amdgcn_readfirstlane(kdst+(slot)))
  #define DMA_V(t,slot) glds16(vsrc+(long)(t)*KVBLK*KP,(unsigned)__builtin_amdgcn_readfirstlane(vdst+(slot)))
  const int vb0=(int)(lds0+LDS_V)+((lane>>4)&1)*32+(lane&3)*8+(4*hi+((lane&15)>>2))*64;
  const char*Kbase=shm+LDS_K; bf16x8 kf[8];
  const lds_cptr shm3=(lds_cptr)shm; const lds_cptr kp0=shm3+LDS_K+hi*1024+r32*16; const lds_cptr vp0=shm3+LDS_V+((lane>>4)&1)*32+(lane&3)*8+(4*hi+((lane&15)>>2))*64;
  DMA_K(0,0);DMA_V(0,0);DMA_K(1,SLOTB);
  bf16x8 qr[4];
  #pragma unroll
  for(int d0=0;d0<4;++d0)qr[d0]=*reinterpret_cast<const bf16x8*>(&Qw[(long)r32*QP+d0*16+hi*8]);
  float mhat=0.f,l_reg=0.f;f32x16 o[2];o[0]=f32x16{};o[1]=f32x16{};f32x16 negm=f32x16{};asm volatile("":"+v"(negm));
  #define CMASK(P0,P1,t) do{}while(0)
  bool resc=false;
  #define START(P0,P1) do{ const float rm=rowmax(P0,P1); resc=false; \
    { const float dl=rm; mhat=fadd_s(mhat,dl); \
      _Pragma("unroll") for(int r=0;r<16;++r){P0[r]=fsub_s(P0[r],dl);P1[r]=fsub_s(P1[r],dl);} \
      _Pragma("unroll") for(int r=0;r<16;++r)negm[r]=-mhat; asm volatile("":"+v"(negm)); } \
    _Pragma("unroll") for(int r=0;r<16;++r)P0[r]=__builtin_amdgcn_exp2f(P0[r]); }while(0)
  #define RESC() do{ if(resc){ asm volatile("s_waitcnt lgkmcnt(0)":::"memory"); \
      _Pragma("unroll") for(int d_=0;d_<2;++d_) _Pragma("unroll") for(int r=0;r<16;++r)o[d_][r]*=wsf[crow(r,hi)]; } }while(0)
  f32x16 pA0,pA1,pB0,pB1;
  int sl_prev=0,sl_cur=0,sl_next=SLOTB;
  #define ROT() do{sl_prev=sl_cur;sl_cur=sl_next;sl_next=(sl_next==(NSLOT-1)*SLOTB)?0:sl_next+SLOTB;}while(0)
  DMA_K(2,2*SLOTB);
  WAIT_BAR(3);
  qkt(pA0,pA1,Kbase,qr,negm,r32,hi);asm volatile("s_nop 15\n\ts_nop 7":"+v"(pA0),"+v"(pA1));CMASK(pA0,pA1,0);
  START(pA0,pA1);
  _Pragma("unroll") for(int r=0;r<16;++r)pA1[r]=__builtin_amdgcn_exp2f(pA1[r]);
  WAIT_BAR(0);
  DMA_K(3,0);DMA_V(1,SLOTB);
  ROT();
  kload8(kf,kp0+sl_cur);
  WAIT_BAR(2);
  s16x4 vlo[8],vhi[8]; u32x4 pw0,pw1,pw2,pw3;
  #define PKW(P,B) cvtpk_s(P[B],P[B+1])
  #define PAF(k) __builtin_bit_cast(bf16x8,pw##k)
  #define VFR(i) (bf16x8){vlo[i][0],vlo[i][1],vlo[i][2],vlo[i][3],vhi[i][0],vhi[i][1],vhi[i][2],vhi[i][3]}
  #define PIN(x) asm volatile("":"+v"(x))
  #define MX3(a,b,c) __builtin_fmaxf(__builtin_fmaxf((a),(b)),(c))
  #define GAPA(MF,A0,A1,A2,A3,W0,W1,PW) do{ MF; sacc+=A0; sacc+=A1; sacc+=A2; sacc+=A3; PIN(sacc); W0; W1; PIN(PW); SBAR(); }while(0)
  #define EX(v) __builtin_amdgcn_exp2f(v)
  #define GAPB(MF,X,B) do{ MF; X[B]=EX(X[B]); X[B+1]=EX(X[B+1]); X[B+2]=EX(X[B+2]); X[B+3]=EX(X[B+3]); PIN(X); SBAR(); }while(0)
  #define VRD(i) do{ vlo[i]=vtr(vp_+(((i)>>2)*4096+((i)&3)*1024)); vhi[i]=vtr(vp_+(((i)>>2)*4096+((i)&3)*1024+512)); }while(0)
  #define KRD(G,j) do{ if(G){ kload2(kf,kp0+sl_next,j); SBAR(); } }while(0)
  #define STEP(C0,C1,P0,P1,t,GK,GV,GL) do{ SBAR(); \
    const lds_cptr vp_=vp0+sl_prev; \
    VRD(0); SBAR(); float sacc=(P0[0]+P0[1]); \
    GAPA(C0=__builtin_amdgcn_mfma_f32_32x32x16_bf16(kf[0],qr[0],negm,0,0,0), P0[2],P0[3],P0[4],P0[5],     pw0[0]=PKW(P0,0), pw0[1]=PKW(P0,2), pw0); \
    VRD(4); SBAR(); GAPA(C1=__builtin_amdgcn_mfma_f32_32x32x16_bf16(kf[1],qr[0],negm,0,0,0), P0[6],P0[7],P0[8],P0[9],     pw0[2]=PKW(P0,4), pw0[3]=PKW(P0,6), pw0); \
    VRD(1); SBAR(); GAPA(C0=__builtin_amdgcn_mfma_f32_32x32x16_bf16(kf[2],qr[1],C0,0,0,0),   P0[10],P0[11],P0[12],P0[13], pw1[0]=PKW(P0,8), pw1[1]=PKW(P0,10), pw1); \
    VRD(5); SBAR(); GAPA(C1=__builtin_amdgcn_mfma_f32_32x32x16_bf16(kf[3],qr[1],C1,0,0,0),   P0[14],P0[15],P1[0],P1[1],   pw1[2]=PKW(P0,12),pw1[3]=PKW(P0,14), pw1); \
    VRD(2); SBAR(); GAPA(C0=__builtin_amdgcn_mfma_f32_32x32x16_bf16(kf[4],qr[2],C0,0,0,0),   P1[2],P1[3],P1[4],P1[5],     pw2[0]=PKW(P1,0), pw2[1]=PKW(P1,2), pw2); \
    VRD(6); SBAR(); GAPA(C1=__builtin_amdgcn_mfma_f32_32x32x16_bf16(kf[5],qr[2],C1,0,0,0),   P1[6],P1[7],P1[8],P1[9],     pw2[2]=PKW(P1,4), pw2[3]=PKW(P1,6), pw2); \
    VRD(3); SBAR(); GAPA(C0=__builtin_amdgcn_mfma_f32_32x32x16_bf16(kf[6],qr[3],C0,0,0,0),   P1[10],P1[11],P1[12],P1[13], pw3[0]=PKW(P1,8), pw3[1]=PKW(P1,10), pw3); \
    VRD(7); SBAR(); GAPA(C1=__builtin_amdgcn_mfma_f32_32x32x16_bf16(kf[7],qr[3],C1,0,0,0),   P1[14],P1[15],0.f,0.f,       pw3[2]=PKW(P1,12),pw3[3]=PKW(P1,14), pw3); \
    l_reg+=sacc; \
    if(GK){DMA_K((t)+3,sl_cur);} if(GV){DMA_V((t)+1,sl_next);} \
    CMASK(C0,C1,t); \
    { float a=MX3(C0[0],C0[1],C1[0]),b=MX3(C0[2],C0[3],C1[1]); a=MX3(a,C1[2],C1[3]); \
      _Pragma("unroll") for(int r=4;r<16;r+=4){a=MX3(a,C0[r],C0[r+1]);b=MX3(b,C0[r+2],C0[r+3]);a=MX3(a,C1[r],C1[r+1]);b=MX3(b,C1[r+2],C1[r+3]);} \
      float rm=__builtin_fmaxf(a,b); { auto rr=__builtin_amdgcn_permlane32_swap(__float_as_uint(rm),__float_as_uint(rm),false,false); rm=__builtin_fmaxf(__uint_as_float(rr[0]),__uint_as_float(rr[1])); } \
      resc=false; \
      if(__builtin_expect(__any(rm>(float)THRL),0)){ const float dl=__builtin_fmaxf(rm,0.f); mhat+=dl; \
        _Pragma("unroll") for(int r=0;r<16;++r){C0[r]-=dl;C1[r]-=dl;} \
        _Pragma("unroll") for(int r=0;r<16;++r)negm[r]=-mhat; asm volatile("":"+v"(negm)); \
        const float f=__builtin_amdgcn_exp2f(-dl); l_reg*=f; if(hi==0)wsf[r32]=f; resc=true; } } \
    SBAR(); \
    GAPB(o[0]=__builtin_amdgcn_mfma_f32_32x32x16_bf16(PAF(0),VFR(0),o[0],0,0,0), C0,0); \
    GAPB(o[1]=__builtin_amdgcn_mfma_f32_32x32x16_bf16(PAF(0),VFR(4),o[1],0,0,0), C0,4); \
    KRD(GL,0); GAPB(o[0]=__builtin_amdgcn_mfma_f32_32x32x16_bf16(PAF(1),VFR(1),o[0],0,0,0), C0,8); \
    KRD(GL,1); GAPB(o[1]=__builtin_amdgcn_mfma_f32_32x32x16_bf16(PAF(1),VFR(5),o[1],0,0,0), C0,12); \
    KRD(GL,2); GAPB(o[0]=__builtin_amdgcn_mfma_f32_32x32x16_bf16(PAF(2),VFR(2),o[0],0,0,0), C1,0); \
    KRD(GL,3); GAPB(o[1]=__builtin_amdgcn_mfma_f32_32x32x16_bf16(PAF(2),VFR(6),o[1],0,0,0), C1,4); \
    GAPB(o[0]=__builtin_amdgcn_mfma_f32_32x32x16_bf16(PAF(3),VFR(3),o[0],0,0,0), C1,8); \
    GAPB(o[1]=__builtin_amdgcn_mfma_f32_32x32x16_bf16(PAF(3),VFR(7),o[1],0,0,0), C1,12); \
    }while(0)
  int t=1;
  #undef CMASK
  #define CMASK(P0,P1,t) do{}while(0)
  for(;t+5<NT;t+=2){
    STEP(pB0,pB1,pA0,pA1,t,true,true,true);     WAIT_BAR(2); RESC(); ROT();
    STEP(pA0,pA1,pB0,pB1,t+1,true,true,true);   WAIT_BAR(2); RESC(); ROT();
  }
  #undef CMASK
  #define CMASK(P0,P1,t) do{}while(0)
  #define ENDW(tt) do{ if((tt)+3<NT){WAIT_BAR(2);} else if((tt)+2<NT){WAIT_BAR(1);} else {WAIT_BAR(0);} }while(0)
  for(;t+1<NT;t+=2){
    STEP(pB0,pB1,pA0,pA1,t,(t+3<NT),(t+1<NT),(t+1<NT));       ENDW(t);   RESC(); ROT();
    STEP(pA0,pA1,pB0,pB1,t+1,(t+4<NT),(t+2<NT),(t+2<NT));     ENDW(t+1); RESC(); ROT();
  }
  STEP(pB0,pB1,pA0,pA1,NT-1,false,false,false); RESC();
  { float sacc=pB0[0]+pB0[1]; _Pragma("unroll") for(int r=2;r<16;++r)sacc+=pB0[r]; _Pragma("unroll") for(int r=0;r<16;++r)sacc+=pB1[r]; l_reg+=sacc;
    pw0=(u32x4){PKW(pB0,0),PKW(pB0,2),PKW(pB0,4),PKW(pB0,6)};pw1=(u32x4){PKW(pB0,8),PKW(pB0,10),PKW(pB0,12),PKW(pB0,14)};pw2=(u32x4){PKW(pB1,0),PKW(pB1,2),PKW(pB1,4),PKW(pB1,6)};pw3=(u32x4){PKW(pB1,8),PKW(pB1,10),PKW(pB1,12),PKW(pB1,14)};
    SBAR(); pv(o,vb0+sl_cur,PAF(0),PAF(1),PAF(2),PAF(3)); }
  #undef PKW
  #undef PAF
  #undef VFR
  #undef PIN
  #undef MX3
  #undef GAPA
  #undef GAPB
  #undef EX
  #undef VRD
  #undef KRD
  #undef STEP
  #undef ENDW
  {auto rr=__builtin_amdgcn_permlane32_swap(__float_as_uint(l_reg),__float_as_uint(l_reg),false,false);l_reg=__uint_as_float(rr[0])+__uint_as_float(rr[1]);}
  if(hi==0)wsf[32+r32]=l_reg;asm volatile("s_waitcnt lgkmcnt(0)":::"memory");
  float rli[16];
  #pragma unroll
  for(int r=0;r<16;++r)rli[r]=__builtin_amdgcn_rcpf(wsf[32+crow(r,hi)]);
  bf16*Ow=Ou+(long)(wid*QBLK)*QP;
  { bf16*stg=(bf16*)(shm+LDS_OST)+wid*2048;
    #pragma unroll
    for(int r=0;r<16;++r){const int orow=crow(r,hi);
      #pragma unroll
      for(int d0=0;d0<2;++d0)stg[orow*64+d0*32+r32]=__float2bfloat16(o[d0][r]*rli[r]);}
    asm volatile("s_waitcnt lgkmcnt(0)":::"memory");
    #pragma unroll
    for(int i=0;i<4;++i){const int row=i*8+(lane>>3),ch=lane&7; const u32x4 v=*(const u32x4*)(stg+row*64+ch*8); ATTN_STORE16(Ow+(long)row*QP+ch*8,v);} }
  asm volatile("s_waitcnt lgkmcnt(0)\n\ts_barrier":::"memory");
  #undef DMA_K
  #undef DMA_V
  #undef CMASK
  #undef START
  #undef RESC
  #undef ROT
}
constexpr int ATTN_LDS_BYTES=LDS_BYTES;
#undef SBAR
#undef WAIT_BAR
}

DEV void lru_loop(const P& p, int l, int first, int nlru, int nattn, LAS unsigned char* lds, volatile LAS unsigned* misc, int tid);
DEV void phase_attn_lru(const P& p, int l, LAS unsigned char* lds, volatile LAS unsigned* misc, int tid) {
    const int nattn = (l == 0) ? 512 + 64 : 512, nlru = NB * 8 * 18;
    int u;
    for (;;) {
        __syncthreads();
        if (tid == 0) misc[4] = (unsigned)atomicAdd(p.qctr + l, 1);
        __syncthreads();
        u = (int)misc[4];
        if (u >= nattn) break;
        int t2 = tid; asm volatile("" : "+v"(t2));
        int b, h, qrow0, nt;
        if (u < 512) { b = u >> 6; h = (u >> 3) & 7; qrow0 = b * S + (u & 7) * 256; nt = KVS / 64; }
        else { const int u2 = u - 512; b = u2 >> 3; h = u2 & 7; qrow0 = TL + b * CL; nt = CL / 64; }
        attn_body::bf16* qp = (attn_body::bf16*)(p.q + (size_t)qrow0 * 512 + h * 64);
        const attn_body::bf16* kp = (const attn_body::bf16*)(p.k + (size_t)b * KVS * 128 + (h >> 2) * 64);
        const attn_body::bf16* vp = (const attn_body::bf16*)(p.v + (size_t)b * KVS * 128 + (h >> 2) * 64);
        attn_body::attn_unit<8>(qp, kp, vp, qp, nt, (char*)lds, t2);
    }
    { int t2 = tid; asm volatile("" : "+v"(t2)); lru_loop(p, l, u - nattn, nlru, nattn, lds, misc, t2); }
}

constexpr int NCHK = 18;
constexpr int LRU_SEG = 0  , LRU_WAVE = 16384, LRU_WAVE_BYTES = 2432   + 2304   + 512   + 2816  ;
static_assert(LRU_WAVE + 8 * LRU_WAVE_BYTES <= RING_BYTES, "LRU LDS map");
template <int CTRL> DEV float dpp_keep(float oldv, float src) { return __builtin_bit_cast(float, __builtin_amdgcn_update_dpp(__builtin_bit_cast(int, oldv), __builtin_bit_cast(int, src), CTRL, 0xf, 0xf, false)); }
template <int D> DEV void row_scan(float& A, float& H) {
#define LRU_STEP(SH) { const float Ap = dpp_keep<(D == 0 ? 0x110 : 0x100) + SH>(1.f, A), Hp = dpp_keep<(D == 0 ? 0x110 : 0x100) + SH>(0.f, H); H = A * Hp + H; A = A * Ap; }
    LRU_STEP(1) LRU_STEP(2) LRU_STEP(4) LRU_STEP(8)
#undef LRU_STEP
}
DEV void lru_load_w(const P& p, int l, int d, int n, int q, int cg, bf16x8 (&wv)[2][4][2]) {
    const bf16_t* wl = p.wt_lru + (size_t)(((l * 2 + d) * 8 + n) * 2) * 4096;
#pragma unroll
    for (int g = 0; g < 2; ++g)
#pragma unroll
        for (int ct = 0; ct < 4; ++ct)
#pragma unroll
            for (int ks = 0; ks < 2; ++ks) wv[g][ct][ks] = *(const bf16x8*)(wl + (g * 64 + ct * 16 + q) * 64 + (ks * 4 + cg) * 8);
}
DEV void lru_mfma(const bf16x8 (&wv)[2][4][2], const bf16x8 (&bu)[2], f32x4 (&pre)[2][4]) {
#pragma unroll
    for (int g = 0; g < 2; ++g)
#pragma unroll
        for (int ct = 0; ct < 4; ++ct) {
            f32x4 a4 = (f32x4){0.f, 0.f, 0.f, 0.f};
#pragma unroll
            for (int ks = 0; ks < 2; ++ks) a4 = __builtin_amdgcn_mfma_f32_16x16x32_bf16(wv[g][ct][ks], bu[ks], a4, 0, 0, 0);
            pre[g][ct] = a4;
        }
}
template <int D>
DEV void lru_ew_scan(const LAS float* par, const f32x4 (&pre)[2][4], const float (&uc)[4][4], float (&SA)[4][4], float (&SH)[4][4], LAS float* seg, int w, int q, int cg) {
#pragma unroll
    for (int ct = 0; ct < 4; ++ct) {
        const int ch0 = ct * 16 + cg * 4;
        const f32x4 ba = *(const LAS f32x4*)(par + (5 + 3 * D) * 64 + ch0), bx = *(const LAS f32x4*)(par + (6 + 3 * D) * 64 + ch0), sp = *(const LAS f32x4*)(par + (7 + 3 * D) * 64 + ch0);
#pragma unroll
        for (int j = 0; j < 4; ++j) {
            const float r = sigmoidf_(pre[0][ct][j] + ba[j]), ig = sigmoidf_(pre[1][ct][j] + bx[j]);
            float A = __expf(-8.f * r * sp[j]);
            float H = __builtin_amdgcn_sqrtf(fmaxf(1.f - A * A, 0.f)) * (ig * uc[ct][j]);
            row_scan<D>(A, H);
            SA[ct][j] = A; SH[ct][j] = H;
        }
        if (q == (D == 0 ? 15 : 0)) {
            *(LAS f32x4*)(seg + ((D * 2 + 0) * 8 + w) * 64 + ch0) = (f32x4){SA[ct][0], SA[ct][1], SA[ct][2], SA[ct][3]};
            *(LAS f32x4*)(seg + ((D * 2 + 1) * 8 + w) * 64 + ch0) = (f32x4){SH[ct][0], SH[ct][1], SH[ct][2], SH[ct][3]};
        }
    }
}
template <int D>
DEV void lru_apply(const P& p, int b, int n, int c, size_t tok0, const float (&SA)[4][4], const float (&SH)[4][4], LAS float* seg, LAS float* xch, int w, int lane, int q, int cg) {
    const LAS float* sA = seg + (D * 2 + 0) * 512; const LAS float* sH = seg + (D * 2 + 1) * 512;
    float ta[8], th[8];
#pragma unroll
    for (int sgi = 0; sgi < 8; ++sgi) { ta[sgi] = sA[sgi * 64 + lane]; th[sgi] = sH[sgi * 64 + lane]; }
    float hin = 0.f, apre = 1.f;
#pragma unroll
    for (int k = 0; k < 8; ++k) { const int sgi = D == 0 ? k : 7 - k; if (D == 0 ? (sgi < w) : (sgi > w)) { hin = ta[sgi] * hin + th[sgi]; apre *= ta[sgi]; } }
    if (w == (D == 0 ? 7 : 0)) {
        const float sa = D == 0 ? ta[7] : ta[0], sh = D == 0 ? th[7] : th[0]; const size_t ti = ((size_t)((b * 2 + D) * NCHK + c)) * 512 + n * 64 + lane;
        p.totA[ti] = apre * sa; p.totH[ti] = sa * hin + sh;
    }
    xch[lane] = hin; xch[64 + lane] = apre;
    asm volatile("s_waitcnt lgkmcnt(0)" ::: "memory");
    bf16_t* hp = p.hl + ((size_t)D * TT + tok0 + q) * 512 + n * 64 + cg * 4; bf16_t* ap = p.ac + ((size_t)D * TT + tok0 + q) * 512 + n * 64 + cg * 4;
#pragma unroll
    for (int ct = 0; ct < 4; ++ct) {
        const f32x4 h4 = *(const LAS f32x4*)(xch + ct * 16 + cg * 4), a4 = *(const LAS f32x4*)(xch + 64 + ct * 16 + cg * 4);
        *(u32x2*)(hp + ct * 16) = (u32x2){pack2(SH[ct][0] + SA[ct][0] * h4[0], SH[ct][1] + SA[ct][1] * h4[1]), pack2(SH[ct][2] + SA[ct][2] * h4[2], SH[ct][3] + SA[ct][3] * h4[3])};
        *(u32x2*)(ap + ct * 16) = (u32x2){pack2(SA[ct][0] * a4[0], SA[ct][1] * a4[1]), pack2(SA[ct][2] * a4[2], SA[ct][3] * a4[3])};
    }
}
DEV void lru_issue(const P& p, int item, int w, int lane, u32x4 (&uv)[3]) {
    const int c = item % NCHK, n = (item / NCHK) & 7, b = item / (NCHK * 8);
    const bool isctx = c < 2;
    const int seqbase = isctx ? TL + b * CL : b * S, seqlen = isctx ? CL : S, p0 = (isctx ? 128 * c : 128 * (c - 2)) + 16 * w;
#pragma unroll
    for (int i = 0; i < 3; ++i) {
        const int r = (lane >> 3) + 8 * i, tok = p0 - 2 + r;
        uv[i] = (u32x4){0u, 0u, 0u, 0u};
        if (r < 19 && tok >= 0 && tok < seqlen) uv[i] = *(const u32x4*)(p.u + (size_t)(seqbase + tok) * 512 + n * 64 + (lane & 7) * 8);
    }
}
DEV int lru_compute(const P& p, int l, int item, const u32x4 (&uv)[3], int nxt, int nlru, int nattn, u32x4 (&uvn)[3], int par, int pub, int& pubn, volatile LAS unsigned* misc, LAS unsigned char* lds, int tid) {
    const int c = item % NCHK, n = (item / NCHK) & 7, b = item / (NCHK * 8);
    const int lane = tid & 63, w = __builtin_amdgcn_readfirstlane(tid >> 6), q = lane & 15, cg = lane >> 4;
    LAS float* seg = (LAS float*)(lds + LRU_SEG) + par * 2048;
    LAS bf16_t* Uraw = (LAS bf16_t*)(lds + LRU_WAVE + w * LRU_WAVE_BYTES);
    LAS bf16_t* Ub = (LAS bf16_t*)(lds + LRU_WAVE + w * LRU_WAVE_BYTES + 2432);
    LAS float* xch = (LAS float*)(lds + LRU_WAVE + w * LRU_WAVE_BYTES + 2432 + 2304);
    LAS float* prm = (LAS float*)(lds + LRU_WAVE + w * LRU_WAVE_BYTES + 2432 + 2304 + 512);
    const bool isctx = c < 2;
    const int seqbase = isctx ? TL + b * CL : b * S, p0 = (isctx ? 128 * c : 128 * (c - 2)) + 16 * w;
    bf16x8 wv0[2][4][2], wv1[2][4][2];
    float pv[11];
    {
        const int ch = n * 64 + lane;
        pv[0] = p.conv_b[l * 512 + ch];
#pragma unroll
        for (int j = 0; j < 4; ++j) pv[1 + j] = p.conv_w[(l * 4 + j) * 512 + ch];
#pragma unroll
        for (int d = 0; d < 2; ++d) { const int pi = (l * 2 + d) * 512 + ch; pv[5 + 3 * d] = p.lru_ba[pi]; pv[6 + 3 * d] = p.lru_bx[pi]; pv[7 + 3 * d] = p.sptab[pi]; }
    }
    lru_load_w(p, l, 0, n, q, cg, wv0);
    lru_load_w(p, l, 1, n, q, cg, wv1);
    if (nxt < nlru) lru_issue(p, nxt, w, lane, uvn);
    pubn = 0;
    if (tid == 0) pubn = atomicAdd(p.qctr + l, 1) - nattn;
    __builtin_amdgcn_sched_barrier(0);
#pragma unroll
    for (int i = 0; i < 3; ++i) { const int r = (lane >> 3) + 8 * i; if (r < 19) *(LAS u32x4*)(Uraw + r * 64 + (lane & 7) * 8) = uv[i]; }
#pragma unroll
    for (int k = 0; k < 11; ++k) prm[k * 64 + lane] = pv[k];
    asm volatile("s_waitcnt lgkmcnt(0)" ::: "memory");
    float uc[4][4];
#pragma unroll
    for (int ct = 0; ct < 4; ++ct) {
        const int ch0 = ct * 16 + cg * 4;
        f32x4 acc = *(const LAS f32x4*)(prm + ch0);
#pragma unroll
        for (int j = 0; j < 4; ++j) {
            const u32x2 raw = *(const LAS u32x2*)(Uraw + (q + j) * 64 + ch0); const f32x4 cw = *(const LAS f32x4*)(prm + (1 + j) * 64 + ch0);
            acc[0] += bflo(raw.x) * cw[0]; acc[1] += bfhi(raw.x) * cw[1]; acc[2] += bflo(raw.y) * cw[2]; acc[3] += bfhi(raw.y) * cw[3];
        }
        uc[ct][0] = acc[0]; uc[ct][1] = acc[1]; uc[ct][2] = acc[2]; uc[ct][3] = acc[3];
        *(LAS u32x2*)(Ub + q * 72 + ch0) = (u32x2){pack2(acc[0], acc[1]), pack2(acc[2], acc[3])};
    }
    asm volatile("s_waitcnt lgkmcnt(0)" ::: "memory");
    bf16x8 bu[2];
#pragma unroll
    for (int ks = 0; ks < 2; ++ks) bu[ks] = *(const LAS bf16x8*)(Ub + q * 72 + ks * 32 + cg * 8);
    float SA0[4][4], SH0[4][4], SA1[4][4], SH1[4][4];
    f32x4 pre0[2][4], pre1[2][4];
    lru_mfma(wv0, bu, pre0);
    lru_mfma(wv1, bu, pre1);
    lru_ew_scan<0>(prm, pre0, uc, SA0, SH0, seg, w, q, cg);
    lru_ew_scan<1>(prm, pre1, uc, SA1, SH1, seg, w, q, cg);
    if (tid == 0) misc[8 + par] = (unsigned)pub;
    __syncthreads();
    const int nn = (int)misc[8 + par];
    const size_t tok0 = (size_t)seqbase + p0;
    lru_apply<0>(p, b, n, c, tok0, SA0, SH0, seg, xch, w, lane, q, cg);
    lru_apply<1>(p, b, n, c, tok0, SA1, SH1, seg, xch, w, lane, q, cg);
    return nn;
}

DEV void lru_loop(const P& p, int l, int first, int nlru, int nattn, LAS unsigned char* lds, volatile LAS unsigned* misc, int tid) {
    const int lane = tid & 63, w = __builtin_amdgcn_readfirstlane(tid >> 6);
    int cur = first;
    if (cur >= nlru) return;
    u32x4 uvA[3], uvB[3];
    lru_issue(p, cur, w, lane, uvA);
    __syncthreads();
    if (tid == 0) { misc[4] = (unsigned)atomicAdd(p.qctr + l, 1); }
    __syncthreads();
    int nxt = (int)misc[4] - nattn, par = 0;
    int pub = 0;
    if (tid == 0) pub = atomicAdd(p.qctr + l, 1) - nattn;
    for (;;) {
        int pubn;
        const int nn = lru_compute(p, l, cur, uvA, nxt, nlru, nattn, uvB, par, pub, pubn, misc, lds, tid);
        if (nxt >= nlru) break;
        cur = nxt; nxt = nn; pub = pubn; par ^= 1;
#pragma unroll
        for (int i = 0; i < 3; ++i) uvA[i] = uvB[i];
    }
}

DEV void phase_mix(const P& p, int l, int bid, int nb, LAS unsigned char* lds) {
    const int tid = otid(), lane = tid & 63, wv = tid >> 6;
    LAS float* cin = (LAS float*)lds;
    const int nitems = NB * NCHK;
    for (int it = bid; it < nitems; it += nb) {
        const int b = it / NCHK, c = it - b * NCHK;
        if (l == 1 && c < 2) continue;
        __syncthreads();
        {
            const int ch = tid;
            const float* tA = p.totA + (size_t)(b * 2) * NCHK * 512 + ch; const float* tH = p.totH + (size_t)(b * 2) * NCHK * 512 + ch;
            float fa[NCHK], fh[NCHK], ba_[NCHK], bh[NCHK];
#pragma unroll
            for (int cc = 0; cc < NCHK; ++cc) { fa[cc] = tA[cc * 512]; fh[cc] = tH[cc * 512]; ba_[cc] = tA[(NCHK + cc) * 512]; bh[cc] = tH[(NCHK + cc) * 512]; }
            float h = 0.f;
#pragma unroll
            for (int cc = 0; cc < NCHK; ++cc) if (cc < c) h = fa[cc] * h + fh[cc];
            cin[ch] = h;
            const int pos = c == 1 ? 0 : (c == 0 ? 1 : 2 + (NCHK - 1 - c));
            h = 0.f;
            if (0 < pos) h = bh[1];
            if (1 < pos) h = ba_[0] * h + bh[0];
#pragma unroll
            for (int k = 2; k < NCHK; ++k) if (k < pos) h = ba_[NCHK + 1 - k] * h + bh[NCHK + 1 - k];
            cin[512 + ch] = h;
        }
        __syncthreads();
        const int tbase = (c < 2) ? TL + b * CL + 128 * c : b * S + 128 * (c - 2);
        const int c0 = lane * 8;
        float gaq[8], grq[8];
#pragma unroll
        for (int i = 0; i < 8; ++i) { gaq[i] = p.attn_out_g[l * 512 + c0 + i]; grq[i] = p.lru_out_g[l * 512 + c0 + i]; }
        for (int r = wv; r < 128; r += 16) {
            uint4 a4[2], g4[2], hf4[2], hb4[2], af4[2], ab4[2];
#pragma unroll
            for (int rr = 0; rr < 2; ++rr) {
                const size_t t = (size_t)(tbase + r + 8 * rr);
                a4[rr] = *(const uint4*)(p.q + t * 512 + c0); g4[rr] = *(const uint4*)(p.gb + t * 512 + c0);
                hf4[rr] = *(const uint4*)(p.hl + t * 512 + c0); hb4[rr] = *(const uint4*)(p.hl + ((size_t)TT + t) * 512 + c0);
                af4[rr] = *(const uint4*)(p.ac + t * 512 + c0); ab4[rr] = *(const uint4*)(p.ac + ((size_t)TT + t) * 512 + c0);
            }
#pragma unroll
            for (int rr = 0; rr < 2; ++rr) {
                const size_t t = (size_t)(tbase + r + 8 * rr);
                float av[8] = {bflo(a4[rr].x), bfhi(a4[rr].x), bflo(a4[rr].y), bfhi(a4[rr].y), bflo(a4[rr].z), bfhi(a4[rr].z), bflo(a4[rr].w), bfhi(a4[rr].w)};
                const float gv[8] = {bflo(g4[rr].x), bfhi(g4[rr].x), bflo(g4[rr].y), bfhi(g4[rr].y), bflo(g4[rr].z), bfhi(g4[rr].z), bflo(g4[rr].w), bfhi(g4[rr].w)};
                const float hf[8] = {bflo(hf4[rr].x), bfhi(hf4[rr].x), bflo(hf4[rr].y), bfhi(hf4[rr].y), bflo(hf4[rr].z), bfhi(hf4[rr].z), bflo(hf4[rr].w), bfhi(hf4[rr].w)};
                const float hb[8] = {bflo(hb4[rr].x), bfhi(hb4[rr].x), bflo(hb4[rr].y), bfhi(hb4[rr].y), bflo(hb4[rr].z), bfhi(hb4[rr].z), bflo(hb4[rr].w), bfhi(hb4[rr].w)};
                const float af[8] = {bflo(af4[rr].x), bfhi(af4[rr].x), bflo(af4[rr].y), bfhi(af4[rr].y), bflo(af4[rr].z), bfhi(af4[rr].z), bflo(af4[rr].w), bfhi(af4[rr].w)};
                const float ab[8] = {bflo(ab4[rr].x), bfhi(ab4[rr].x), bflo(ab4[rr].y), bfhi(ab4[rr].y), bflo(ab4[rr].z), bfhi(ab4[rr].z), bflo(ab4[rr].w), bfhi(ab4[rr].w)};
                float rv[8]; float sa = 0.f, sr = 0.f;
#pragma unroll
                for (int i = 0; i < 8; ++i) { rv[i] = (hf[i] + af[i] * cin[c0 + i] + hb[i] + ab[i] * cin[512 + c0 + i]) * gelu_tanh(gv[i]); sa += av[i] * av[i]; sr += rv[i] * rv[i]; }
                sa = wave_sum(sa); sr = wave_sum(sr);
                const float ra = rsqrtf(sa * (1.f / 512.f) + EPS), rrs = rsqrtf(sr * (1.f / 512.f) + EPS);
#pragma unroll
                for (int i = 0; i < 8; ++i) { av[i] = av[i] * ra * gaq[i]; rv[i] = rv[i] * rrs * grq[i]; }
                uint4 o; o.x = pack2(av[0], av[1]); o.y = pack2(av[2], av[3]); o.z = pack2(av[4], av[5]); o.w = pack2(av[6], av[7]);
                *(uint4*)(p.xn + t * D + c0) = o;
                o.x = pack2(rv[0], rv[1]); o.y = pack2(rv[2], rv[3]); o.z = pack2(rv[4], rv[5]); o.w = pack2(rv[6], rv[7]);
                *(uint4*)(p.xn + t * D + 512 + c0) = o;
            }
        }
    }
}

DEV void route_select(const float (&lg)[16], const float* rb, int& e1, int& e2, float& w1n, float& w2n) {
    float sc_[16], bi[16];
#pragma unroll
    for (int e = 0; e < 16; ++e) { sc_[e] = __builtin_amdgcn_rcpf(1.f + __expf(-lg[e])); bi[e] = sc_[e] + rb[e]; }
    float gs[4];
#pragma unroll
    for (int g = 0; g < 4; ++g) {
        const float a = bi[g * 4], b = bi[g * 4 + 1], c = bi[g * 4 + 2], d = bi[g * 4 + 3];
        const float m1 = fmaxf(fmaxf(a, b), fmaxf(c, d));
        const float m2 = fmaxf(fmaxf(fminf(a, b), fminf(c, d)), fminf(fmaxf(a, b), fmaxf(c, d)));
        gs[g] = m1 + m2;
    }
    int bg = 0; float bgs = gs[0];
#pragma unroll
    for (int g = 1; g < 4; ++g) if (gs[g] > bgs) { bgs = gs[g]; bg = g; }
    float v0 = 0.f, v1 = 0.f, v2 = 0.f, v3 = 0.f, s0 = 0.f, s1 = 0.f, s2 = 0.f, s3 = 0.f;
#pragma unroll
    for (int g = 0; g < 4; ++g) if (bg == g) { v0 = bi[g * 4]; v1 = bi[g * 4 + 1]; v2 = bi[g * 4 + 2]; v3 = bi[g * 4 + 3]; s0 = sc_[g * 4]; s1 = sc_[g * 4 + 1]; s2 = sc_[g * 4 + 2]; s3 = sc_[g * 4 + 3]; }
    int i1 = 0; float b1 = v0, w1 = s0;
    if (v1 > b1) { b1 = v1; i1 = 1; w1 = s1; }
    if (v2 > b1) { b1 = v2; i1 = 2; w1 = s2; }
    if (v3 > b1) { b1 = v3; i1 = 3; w1 = s3; }
    int i2 = -1; float b2 = -1e30f, w2 = 0.f;
    if (i1 != 0 && v0 > b2) { b2 = v0; i2 = 0; w2 = s0; }
    if (i1 != 1 && v1 > b2) { b2 = v1; i2 = 1; w2 = s1; }
    if (i1 != 2 && v2 > b2) { b2 = v2; i2 = 2; w2 = s2; }
    if (i1 != 3 && v3 > b2) { b2 = v3; i2 = 3; w2 = s3; }
    const float inv = __builtin_amdgcn_rcpf(w1 + w2);
    e1 = bg * 4 + i1; e2 = bg * 4 + i2; w1n = w1 * inv; w2n = w2 * inv;
}
DEV void phase_route(const P& p, int l, int bid, int nb, LAS unsigned char* lds) {
    const int tid = otid(), lane = tid & 63, wv = tid >> 6;
    const int nrows = l == 0 ? TT : TL;
    const int rpw = (nrows + nb * 8 - 1) / (nb * 8);
    const int r0 = (bid * 8 + wv) * rpw, r1 = min(r0 + rpw, nrows);
    LAS int* lcnt = (LAS int*)lds;
    LAS int* lbase = (LAS int*)(lds + 64);
    LAS i32x2* ent = (LAS i32x2*)(lds + 128);
    LAS float* rwT = (LAS float*)(lds + 4096);
    __syncthreads();
    if (tid < NE) lcnt[tid] = 0;
    {
        f32x4 rwv[8];
#pragma unroll
        for (int k = 0; k < 8; ++k) rwv[k] = *(const f32x4*)(p.router_w + (size_t)(tid + NTHR * k) * 4);
#pragma unroll
        for (int k = 0; k < 8; ++k) { const int i4 = tid + NTHR * k, d = i4 >> 2, e0 = (i4 & 3) * 4;
#pragma unroll
            for (int j = 0; j < 4; ++j) rwT[(e0 + j) * 1024 + d] = rwv[k][j]; }
    }
    __syncthreads();
    f32x4 ng[4];
#pragma unroll
    for (int i = 0; i < 4; ++i) ng[i] = *(const f32x4*)(p.norm2_g + l * D + i * 256 + lane * 4);
    for (int t0 = r0; t0 < r1; t0 += 2) {
        f32x4 xr[2][4], sh[2][4], sc[2][4];
#pragma unroll
        for (int rr = 0; rr < 2; ++rr) {
            const int t = min(t0 + rr, r1 - 1);
            const float* src = p.xres + (size_t)t * D; const float* mm = p.mod + (size_t)(l * 9 + mod_row(t)) * 6144;
#pragma unroll
            for (int i = 0; i < 4; ++i) { const int c0 = i * 256 + lane * 4; xr[rr][i] = *(const f32x4*)(src + c0); sh[rr][i] = *(const f32x4*)(mm + 3072 + c0); sc[rr][i] = *(const f32x4*)(mm + 4096 + c0); }
        }
#pragma unroll
        for (int rr = 0; rr < 2; ++rr) {
            const int t = t0 + rr;
            if (t < r1) {
                float ss = 0.f;
#pragma unroll
                for (int i = 0; i < 4; ++i)
#pragma unroll
                    for (int j = 0; j < 4; ++j) ss += xr[rr][i][j] * xr[rr][i][j];
                ss = wave_sum(ss);
                const float rstd = rsqrtf(ss * (1.f / D) + EPS);
                float lg[16];
#pragma unroll
                for (int e = 0; e < 16; ++e) lg[e] = 0.f;
#pragma unroll
                for (int i = 0; i < 4; ++i) {
                    const int c0 = i * 256 + lane * 4;
                    const f32x4 o = xr[rr][i] * rstd * ng[i] * (sc[rr][i] + 1.f) + sh[rr][i];
                    *(uint2*)(p.xn + (size_t)t * D + c0) = make_uint2(pack2(o[0], o[1]), pack2(o[2], o[3]));
#pragma unroll
                    for (int e = 0; e < 16; ++e) { const f32x4 r4 = *(const LAS f32x4*)(rwT + e * 1024 + c0); lg[e] += o[0] * r4[0] + o[1] * r4[1] + o[2] * r4[2] + o[3] * r4[3]; }
                }
#pragma unroll
                for (int e = 0; e < 16; ++e) lg[e] = wave_sum(lg[e]);
                int e1, e2; float w1, w2;
                route_select(lg, p.router_b, e1, e2, w1, w2);
                if (lane == 0) {
                    p.tokw[2 * t] = w1; p.tokw[2 * t + 1] = w2;
                    const int p1 = __hip_atomic_fetch_add(&lcnt[e1], 1, __ATOMIC_RELAXED, __HIP_MEMORY_SCOPE_WORKGROUP);
                    const int p2 = __hip_atomic_fetch_add(&lcnt[e2], 1, __ATOMIC_RELAXED, __HIP_MEMORY_SCOPE_WORKGROUP);
                    const int nloc = wv * rpw + (t - r0);
                    ent[2 * nloc] = (i32x2){2 * t, (e1 << 16) | p1}; ent[2 * nloc + 1] = (i32x2){2 * t + 1, (e2 << 16) | p2};
                }
            }
        }
    }
    __syncthreads();
    if (tid < NE) lbase[tid] = atomicAdd(&p.cnt[l * 16 + tid], lcnt[tid]);
    __syncthreads();
    for (int i = tid; i < 8 * rpw * 2; i += NTHR) {
        const int nloc = i >> 1, wq = nloc / rpw, k = nloc - wq * rpw;
        if ((bid * 8 + wq) * rpw + k < nrows) { const i32x2 en = ent[i]; const int e = en.y >> 16; p.list[e * TT + lbase[e] + (en.y & 0xffff)] = en.x; }
    }
}

__global__ void __launch_bounds__(NTHR, 2) fwd_megakernel(P p) {
    extern __shared__ __attribute__((aligned(16))) unsigned char lds_raw[];
    LAS unsigned char* lds = (LAS unsigned char*)lds_raw;
    volatile LAS unsigned* misc = (volatile LAS unsigned*)(lds + MISC_OFF);
    if (threadIdx.x < 16) misc[threadIdx.x] = 0u;
    __syncthreads();
    XcdBarrier gbar = xcd_barrier_post(p.bar, misc);
    const int bid = blockIdx.x, nb = gridDim.x;
    LAS float* rope_l = (LAS float*)(lds + MISC_OFF + MISC_ROPE);
    LAS i32x2* ptab = (LAS i32x2*)(lds + MISC_OFF + MISC_PTAB);
    {
        const int tid = otid();
        for (int i = tid; i < 1024; i += NTHR) {
            const int pos = i >> 4, f = i & 15;
            const float inv = exp2f(-(float)(2 * f) / 32.f * 13.287712379549449f);
            const float ang = (float)pos * inv;
            rope_l[i] = __cosf(ang); rope_l[1024 + i] = __sinf(ang);
        }
    }
    phase_prologue(p, bid, nb, lds);
    xcd_barrier(gbar);
#pragma unroll
    for (int l = 0; l < 2; ++l) {
        if (l == 0) phase_rowA<0>(p, l, bid, nb);
        else {
            phase_rowA<1>(p, l, bid, nb);
            const int tid = otid();
            convert_experts(p, 1, bid * 8 + (tid >> 6), nb * 8, (LAS float*)(lds + (tid >> 6) * 16384), tid & 63);
        }
        xcd_barrier(gbar);
        {
            const int tid = otid();
            pg8::GemmPlain g{p.xn, p.wt_in + (size_t)l * INW * D, D};
            pg8::RowMajorOrder so{7, (TT / 256) * 7, nb, bid};
            EpiIn E{&p, l, rope_l};
            pg8::gemm_phase<EpiIn, pg8::GemmPlain, pg8::RowMajorOrder, true>(lds, g, so, E, tid);
        }
        xcd_barrier(gbar);
        { const int tid = otid(); phase_attn_lru(p, l, lds, misc, tid); }
        xcd_barrier(gbar);
        phase_mix(p, l, bid, nb, lds);
        xcd_barrier(gbar);
        {
            const int tid = otid();
            pg8::GemmPlain g{p.xn, p.wt_out + (size_t)l * D * D, D};
            pg8::RowMajorOrder so{4, ((l == 0 ? TT : TL) / 256) * 4, nb, bid};
            EpiOut E{&p, l};
            pg8::gemm_phase<EpiOut, pg8::GemmPlain, pg8::RowMajorOrder, true>(lds, g, so, E, tid);
        }
        xcd_barrier(gbar);
        phase_route(p, l, bid, nb, lds);
        xcd_barrier(gbar);
        {
            const int tid = otid();
            const int np = moe_build_ptab(p.cnt + l * 16, ptab, tid);
            MoeUpDesc g{p.xn, p.wt_gu, D, ptab, p.cnt + l * 16, p.list};
            pg8::RowMajorOrder so{4, np * 4, nb, bid};
            EpiMoeUp E{p.hid};
            pg8::gemm_phase<EpiMoeUp, MoeUpDesc, pg8::RowMajorOrder, true>(lds, g, so, E, tid);
        }
        xcd_barrier(gbar);
        {
            const int tid = otid();
            const int np = ptab[MAXPANELS].x;
            MoeDownDesc g{p.hid, p.wt_d, DE, ptab};
            pg8::RowMajorOrder so{4, np * 4, nb, bid};
            EpiMoeDown E{p.y, p.tokw, ptab, p.cnt + l * 16, p.list};
            pg8::gemm_phase<EpiMoeDown, MoeDownDesc, pg8::RowMajorOrder, true>(lds, g, so, E, tid);
        }
        xcd_barrier(gbar);
    }
    phase_rowA<2>(p, 1, bid, nb);
}

extern "C" void kernel_launch(void* const* d_in, const int* in_sizes, int n_in, void* d_out, int out_size, void* d_ws, size_t ws_size, hipStream_t stream) {
    P p{};
    const float* const* in = (const float* const*)d_in;
    p.x = in[0]; p.c = in[1]; p.ctx = in[2]; p.c_ctx = in[3]; p.ada_w = in[4]; p.ada_b = in[5]; p.norm1_g = in[6]; p.w_in = in[7]; p.q_norm_g = in[8]; p.k_norm_g = in[9];
    p.conv_w = in[10]; p.conv_b = in[11]; p.lru_wa = in[12]; p.lru_ba = in[13]; p.lru_wx = in[14]; p.lru_bx = in[15]; p.lru_lambda = in[16]; p.attn_out_g = in[17];
    p.lru_out_g = in[18]; p.w_out = in[19]; p.norm2_g = in[20]; p.router_w = in[21]; p.router_b = in[22]; p.w_gate = in[23]; p.w_up = in[24]; p.w_down = in[25]; p.final_g = in[26];
    p.out = (float*)d_out;
    char* ws = (char*)d_ws; size_t off = 0;
    auto carve = [&](size_t bytes) { void* r = ws + off; off += (bytes + 255) & ~(size_t)255; return r; };
    p.bar = (unsigned*)carve(XCD_BAR_WORDS * 4);
    p.cnt = (int*)carve(32 * 4);
    p.qctr = (int*)carve(64 * 4);
    const size_t ctl_bytes = off;
    p.mod = (float*)carve((size_t)2 * 9 * 6144 * 4);
    p.tokw = (float*)carve((size_t)2 * TT * 4);
    p.list = (int*)carve((size_t)NE * TT * 4);
    p.sptab = (float*)carve(2 * 2 * 512 * 4);
    p.totA = (float*)carve((size_t)NB * 2 * NCHK * 512 * 4);
    p.totH = (float*)carve((size_t)NB * 2 * NCHK * 512 * 4);
    p.wt_lru = (bf16_t*)carve((size_t)2 * 2 * 8 * 2 * 4096 * 2);
    p.wt_in = (bf16_t*)carve((size_t)2 * INW * D * 2);
    p.wt_out = (bf16_t*)carve((size_t)2 * D * D * 2);
    p.wt_gu = (bf16_t*)carve((size_t)NE * D * D * 2);
    p.wt_d = (bf16_t*)carve((size_t)NE * D * DE * 2);
    p.xres = (float*)carve((size_t)TT * D * 4);
    p.xn = (bf16_t*)carve((size_t)TT * D * 2);
    p.hid = (bf16_t*)carve((size_t)MAXPANELS * 256 * DE * 2);
    p.q = (bf16_t*)carve((size_t)TT * 512 * 2);
    p.y = p.q;
    p.k = (bf16_t*)carve((size_t)TT * 128 * 2);
    p.v = (bf16_t*)carve((size_t)TT * 128 * 2);
    p.u = (bf16_t*)carve((size_t)TT * 512 * 2);
    p.gb = (bf16_t*)carve((size_t)TT * 512 * 2);
    p.hl = (bf16_t*)carve((size_t)2 * TT * 512 * 2);
    p.ac = p.hid;
    if (off > ws_size) { fprintf(stderr, "workspace too small: need %zu have %zu\n", off, ws_size); return; }
    static int grid_blocks = 0;
    if (!grid_blocks) {
        int dev = 0, cus = 0;
        (void)hipGetDevice(&dev);
        (void)hipDeviceGetAttribute(&cus, hipDeviceAttributeMultiprocessorCount, dev);
        if (hipFuncSetAttribute((const void*)fwd_megakernel, hipFuncAttributeMaxDynamicSharedMemorySize, LDS_BYTES) != hipSuccess) { fprintf(stderr, "hipFuncSetAttribute failed\n"); grid_blocks = -1; return; }
        grid_blocks = cus > 0 ? cus : 256;
    }
    if (grid_blocks < 0) return;
    (void)hipMemsetAsync(ws, 0, ctl_bytes, stream);
    hipLaunchKernelGGL(fwd_megakernel, dim3(grid_blocks), dim3(NTHR), LDS_BYTES, stream, p);
}
```

```cpp
#include <hip/hip_runtime.h>
#include <stdint.h>
#include <cstdio>

#define DEV __device__ __forceinline__
#define LAS __attribute__((address_space(3)))
typedef unsigned short bf16_t;
typedef short bf16x8 __attribute__((ext_vector_type(8)));
typedef float f32x4 __attribute__((ext_vector_type(4)));
typedef unsigned u32x4 __attribute__((ext_vector_type(4)));
typedef unsigned u32x2 __attribute__((ext_vector_type(2)));
typedef int i32x2 __attribute__((ext_vector_type(2)));

constexpr int D = 1024, NB = 8, S = 2048, CL = 256, TL = NB * S, TC = NB * CL, TT = TL + TC, KVS = CL + S;
constexpr int INW = 1792, NE = 16, DE = 512;
constexpr float EPS = 1e-6f;
constexpr int NTHR = 512;
constexpr int RING_BYTES = 131072, MISC_OFF = RING_BYTES, LDS_BYTES = 147456;
constexpr int MAXPANELS = 2 * TT / 256 + NE;
constexpr int MISC_ROPE = 64, MISC_PTAB = 64 + 8192;

DEV float bf2f(bf16_t v) { return __uint_as_float(((unsigned)v) << 16); }
DEV unsigned f2bf(float f) { unsigned u = __float_as_uint(f); return (u + 0x7fffu + ((u >> 16) & 1u)) >> 16; }
DEV float bflo(unsigned w) { return __uint_as_float(w << 16); }
DEV float bfhi(unsigned w) { return __uint_as_float(w & 0xffff0000u); }
DEV unsigned pack2(float lo, float hi) { return f2bf(lo) | (f2bf(hi) << 16); }
template <int CTRL> DEV float dpp_mov(float v) { return __builtin_bit_cast(float, __builtin_amdgcn_update_dpp(0, __builtin_bit_cast(int, v), CTRL, 0xf, 0xf, true)); }
DEV float wave_sum(float v) {
    v += dpp_mov<0xB1>(v);
    v += dpp_mov<0x4E>(v);
    v += dpp_mov<0x141>(v);
    v += dpp_mov<0x140>(v);
    auto r = __builtin_amdgcn_permlane16_swap(__float_as_uint(v), __float_as_uint(v), false, false);
    v = __uint_as_float(r[0]) + __uint_as_float(r[1]);
    r = __builtin_amdgcn_permlane32_swap(__float_as_uint(v), __float_as_uint(v), false, false);
    return __uint_as_float(r[0]) + __uint_as_float(r[1]);
}
DEV float sigmoidf_(float x) { return __builtin_amdgcn_rcpf(1.f + __expf(-x)); }
DEV float gelu_tanh(float x) {
    const float u = 0.7978845608028654f * (x + 0.044715f * x * x * x);
    const float e = __expf(2.f * u);
    const float th = 1.f - 2.f * __builtin_amdgcn_rcpf(e + 1.f);
    return 0.5f * x * (1.f + th);
}
constexpr float attn_body_C2 = 0.125f * 1.4426950408889634f;
DEV int otid() { int t = threadIdx.x; asm volatile("" : "+v"(t)); return t; }
DEV int mod_row(int t) { return t < TL ? (t >> 11) : 8; }
DEV int kv_row(int t) { return t < TL ? (t >> 11) * KVS + CL + (t & 2047) : ((t - TL) >> 8) * KVS + ((t - TL) & 255); }

struct P {
    const float *x, *c, *ctx, *c_ctx, *ada_w, *ada_b, *norm1_g, *w_in, *q_norm_g, *k_norm_g, *conv_w, *conv_b, *lru_wa, *lru_ba, *lru_wx, *lru_bx,
        *lru_lambda, *attn_out_g, *lru_out_g, *w_out, *norm2_g, *router_w, *router_b, *w_gate, *w_up, *w_down, *final_g;
    float* out;
    float *mod, *xres, *tokw, *sptab, *totA, *totH;
    bf16_t *xn, *q, *k, *v, *u, *gb, *hl, *ac, *hid, *y;
    bf16_t *wt_in, *wt_out, *wt_gu, *wt_d, *wt_lru;
    int *cnt, *list, *qctr;
    unsigned* bar;
};

#define XB_TMO      128
#define XB_XCNT(j)  (256  + 64 * (j))
#define XB_XSUB(j)  (1280 + 64 * (j))
#define XB_XGEN(j)  (2304 + 64 * (j))
#define XB_TOP      3328
#define XB_TOPGEN   3392
#define XCD_BAR_WORDS 3456
#define XB_SPIN_CAP (1u << 20)
DEV unsigned xb_ld(unsigned* p) { return __hip_atomic_load(p, __ATOMIC_RELAXED, __HIP_MEMORY_SCOPE_AGENT); }
DEV unsigned xb_add(unsigned* p, unsigned v) { return __hip_atomic_fetch_add(p, v, __ATOMIC_RELAXED, __HIP_MEMORY_SCOPE_AGENT); }
DEV unsigned xb_xcc_id() { return (unsigned)__builtin_amdgcn_s_getreg((3 << 11) | 20) & 0xFu; }
#define XB_SPIN(cond, bar) do { unsigned _sp = 0; while (cond) { __builtin_amdgcn_s_sleep(1); \
    if ((++_sp & 255u) == 0u) { if (xb_ld(&(bar)[XB_TMO])) break; if (_sp > XB_SPIN_CAP) { atomicAdd(&(bar)[XB_TMO], 1u); break; } } } } while (0)
struct XcdBarrier { unsigned* bar; unsigned x; volatile LAS unsigned* st; };
DEV XcdBarrier xcd_barrier_post(unsigned* bar, volatile LAS unsigned* st) {
    XcdBarrier b; b.bar = bar; b.x = xb_xcc_id(); b.st = st;
    if (threadIdx.x == 0) { (void)xb_add(&bar[XB_XCNT(b.x)], 1u); st[2] = b.x; }
    return b;
}
DEV void xcd_barrier_complete(unsigned* bar, unsigned x, unsigned& nloc, unsigned& nx) {
    const unsigned G = gridDim.x * gridDim.y * gridDim.z;
    unsigned sum, cnt, mine, sp = 0u;
    for (;;) {
        sum = 0u; cnt = 0u; mine = 0u;
#pragma unroll
        for (unsigned j = 0; j < 16; ++j) { const unsigned c = xb_ld(&bar[XB_XCNT(j)]); sum += c; cnt += (c > 0u) ? 1u : 0u; mine = (j == x) ? c : mine; }
        if (sum == G) break;
        __builtin_amdgcn_s_sleep(1);
        if ((++sp & 255u) == 0u) { if (xb_ld(&bar[XB_TMO])) break; if (sp > XB_SPIN_CAP) { atomicAdd(&bar[XB_TMO], 1u); break; } }
    }
    nloc = mine > 0u ? mine : 1u; nx = cnt > 0u ? cnt : 1u;
}
DEV void xcd_barrier(const XcdBarrier& b) {
    asm volatile("s_waitcnt vmcnt(0)" ::: "memory");
    __syncthreads();
    if (threadIdx.x == 0) {
        unsigned* bar = b.bar;
        __builtin_amdgcn_s_waitcnt(0);
        unsigned nloc = b.st[0], nx = b.st[1]; const unsigned bx = b.st[2];
        if (nloc == 0u) { xcd_barrier_complete(bar, bx, nloc, nx); b.st[0] = nloc; b.st[1] = nx; }
        const unsigned old = xb_add(&bar[XB_XSUB(bx)], 1u);
        const unsigned gen = old / nloc;
        if (old + 1u == (gen + 1u) * nloc) {
            __builtin_amdgcn_fence(__ATOMIC_RELEASE, "agent");
            asm volatile("s_waitcnt vmcnt(0)" ::: "memory");
            const unsigned og = xb_add(&bar[XB_TOP], 1u);
            const unsigned tg = og / nx;
            if (og + 1u == (tg + 1u) * nx) xb_add(&bar[XB_TOPGEN], 1u);
            else XB_SPIN(xb_ld(&bar[XB_TOPGEN]) == tg, bar);
            __builtin_amdgcn_fence(__ATOMIC_ACQUIRE, "agent");
            xb_add(&bar[XB_XGEN(bx)], 1u);
            asm volatile("s_waitcnt vmcnt(0)" ::: "memory");
        } else {
            XB_SPIN(xb_ld(&bar[XB_XGEN(bx)]) == gen, bar);
            __builtin_amdgcn_fence(__ATOMIC_ACQUIRE, "agent");
            asm volatile("s_waitcnt vmcnt(0)" ::: "memory");
        }
    }
    __syncthreads();
}

namespace pg8 {
constexpr int BM = 256, BK = 64, HALF = 128, HTB = HALF * BK * 2, STAGE_BYTES = 8 * HTB;
DEV int lds_byte(int r, int c) { const int st = (r >> 4) * 2 + (c >> 5), rr = r & 15, cc = c & 31, ob = rr * 64 + cc * 2; return st * 1024 + (ob ^ (((ob >> 9) & 1) << 5)); }
DEV void stage_rc(int b, int& R, int& C) { const int st = b / 1024, sb = b % 1024, swz = sb ^ (((sb >> 9) & 1) << 5); R = (st >> 1) * 16 + swz / 64; C = (st & 1) * 32 + (swz % 64) / 2; }
DEV int perm32(int rho) { const int n = rho >> 4, i = rho & 15; return 8 * (i >> 2) + 4 * n + (i & 3); }
struct Unit { int pm, pn; };

template <class Epi, class G, class Sched, bool ALIGN_EPI>
DEV void gemm_phase(LAS unsigned char* lds, const G& g, const Sched& S, const Epi& E, const int tid) {
    const int wid = __builtin_amdgcn_readfirstlane(tid >> 6), lane = tid & 63, wr = wid >> 2, wc = wid & 3, fr = lane & 15, fq = lane >> 4;
    const int K = g.K, nt = K / BK;
    int sR[2], sC[2]; unsigned voffB[2];
#pragma unroll
    for (int i = 0; i < 2; ++i) { stage_rc(tid * 16 + i * 8192, sR[i], sC[i]); const int Rb = Epi::PERM ? ((sR[i] & ~31) + perm32(sR[i] & 31)) : sR[i];
        voffB[i] = (unsigned)(Rb * K + sC[i]) * 2u; }
    const size_t kstep = (size_t)(BK * 2);
    const size_t hstep = (size_t)HALF * K * 2;
    const unsigned ldsw = (unsigned)wid * 1024u;
    const int aoff = lds_byte(wr * 64 + fr, fq * 8), boff = lds_byte(wc * 32 + fr, fq * 8);
#define PG8_SA(b, h) (((b) * 2 + (h)) * HTB)
#define PG8_SB(b, h) ((4 + (b) * 2 + (h)) * HTB)
#define PG8_STAGE(bufoff, gbase, voff) do { _Pragma("unroll") for (int _i = 0; _i < 2; ++_i) \
        __builtin_amdgcn_global_load_lds((const unsigned*)((const char*)(gbase) + (voff)[_i]), (LAS unsigned*)(lds + (bufoff) + ldsw + _i * 8192), 16, 0, 0); } while (0)
#define PG8_LDA(dst, b, h) do { _Pragma("unroll") for (int m = 0; m < 4; ++m) _Pragma("unroll") for (int k = 0; k < 2; ++k) dst[m][k] = *(const LAS bf16x8*)(lds + PG8_SA(b, h) + aoff + m * 2048 + k * 1024); } while (0)
#define PG8_LDB(dst, b, h) do { _Pragma("unroll") for (int n = 0; n < 2; ++n) _Pragma("unroll") for (int k = 0; k < 2; ++k) dst[n][k] = *(const LAS bf16x8*)(lds + PG8_SB(b, h) + boff + n * 2048 + k * 1024); } while (0)
#define PG8_MMA(ai, bj, At, Bt) do { __builtin_amdgcn_s_setprio(1); _Pragma("unroll") for (int m = 0; m < 4; ++m) _Pragma("unroll") for (int n = 0; n < 2; ++n) _Pragma("unroll") for (int k = 0; k < 2; ++k) \
        acc[ai][bj][m][n] = __builtin_amdgcn_mfma_f32_16x16x32_bf16(Bt[n][k], At[m][k], acc[ai][bj][m][n], 0, 0, 0); __builtin_amdgcn_s_setprio(0); } while (0)
#define PG8_WAIT_V(n) asm volatile("s_waitcnt vmcnt(" #n ")" ::: "memory")
#define PG8_WAIT_L(n) asm volatile("s_waitcnt lgkmcnt(" #n ")" ::: "memory")
#define PG8_BAR __builtin_amdgcn_s_barrier()
#define PG8_SCHED __builtin_amdgcn_sched_barrier(0)
    Unit cur, nxt; int ui = 0;
    if (!S.next(0, cur)) return;
    f32x4 acc[2][2][4][2];
#pragma unroll
    for (int a = 0; a < 2; ++a)
#pragma unroll
        for (int b = 0; b < 2; ++b)
#pragma unroll
            for (int m = 0; m < 4; ++m)
#pragma unroll
                for (int n = 0; n < 2; ++n) acc[a][b][m][n] = (f32x4){0.f, 0.f, 0.f, 0.f};
    bf16x8 At[4][2], B0[2][2], B1[2][2];
    unsigned oc[2][2], on[2][2];
#pragma unroll
    for (int h = 0; h < 2; ++h)
#pragma unroll
        for (int i = 0; i < 2; ++i) oc[h][i] = g.a_off(cur, h, sR[i], sC[i]);
    const char* cA = g.a_base(cur); const char* cB = g.b_base(cur);
    PG8_STAGE(PG8_SB(0, 0), cB, voffB); PG8_STAGE(PG8_SB(0, 1), cB + hstep, voffB); PG8_STAGE(PG8_SA(0, 0), cA, oc[0]); PG8_STAGE(PG8_SA(0, 1), cA, oc[1]);
    if (wr == 1) PG8_BAR;
    PG8_WAIT_V(2); PG8_BAR;
    PG8_STAGE(PG8_SB(1, 0), cB + kstep, voffB); PG8_STAGE(PG8_SA(1, 0), cA + kstep, oc[0]); PG8_STAGE(PG8_SB(1, 1), cB + hstep + kstep, voffB);
    PG8_WAIT_V(6); PG8_BAR;
    for (;;) {
        const bool has_next = S.next(ui + 1, nxt);
#pragma unroll
        for (int h = 0; h < 2; ++h)
#pragma unroll
            for (int i = 0; i < 2; ++i) on[h][i] = has_next ? g.a_off(nxt, h, sR[i], sC[i]) : oc[h][i];
        const char* nA = has_next ? g.a_base(nxt) : cA; const char* nB = has_next ? g.b_base(nxt) : cB;
        for (int t = 0; t < nt; t += 2) {
            const bool last = (t == nt - 2);
            const char* a1 = cA + (size_t)(t + 1) * kstep;
            const char* a2 = last ? nA : cA + (size_t)(t + 2) * kstep; const char* b2 = last ? nB : cB + (size_t)(t + 2) * kstep;
            const char* a3 = a2 + kstep; const char* b3 = b2 + kstep;
            unsigned o2[2][2];
#pragma unroll
            for (int h = 0; h < 2; ++h)
#pragma unroll
                for (int i = 0; i < 2; ++i) o2[h][i] = last ? on[h][i] : oc[h][i];
            PG8_LDB(B0, 0, 0); PG8_LDB(B1, 0, 1); PG8_SCHED; PG8_LDA(At, 0, 0); PG8_STAGE(PG8_SA(1, 1), a1, oc[1]);
            PG8_WAIT_V(8); PG8_WAIT_L(0); PG8_BAR; PG8_MMA(0, 0, At, B0); PG8_MMA(0, 1, At, B1); PG8_BAR; PG8_SCHED;
            PG8_LDA(At, 0, 1); PG8_STAGE(PG8_SB(0, 0), b2, voffB); PG8_STAGE(PG8_SB(0, 1), b2 + hstep, voffB); PG8_STAGE(PG8_SA(0, 0), a2, o2[0]);
            PG8_WAIT_V(8); PG8_WAIT_L(0); PG8_BAR; PG8_MMA(1, 0, At, B0); PG8_MMA(1, 1, At, B1); PG8_BAR; PG8_SCHED;
            PG8_LDB(B0, 1, 0); PG8_LDB(B1, 1, 1); PG8_SCHED; PG8_LDA(At, 1, 0); PG8_STAGE(PG8_SA(0, 1), a2, o2[1]);
            PG8_WAIT_V(8); PG8_WAIT_L(0); PG8_BAR; PG8_MMA(0, 0, At, B0); PG8_MMA(0, 1, At, B1); PG8_BAR; PG8_SCHED;
            PG8_LDA(At, 1, 1); PG8_STAGE(PG8_SB(1, 0), b3, voffB); PG8_STAGE(PG8_SB(1, 1), b3 + hstep, voffB); PG8_STAGE(PG8_SA(1, 0), a3, o2[0]);
            PG8_WAIT_V(8); PG8_WAIT_L(0); PG8_BAR; PG8_MMA(1, 0, At, B0); PG8_MMA(1, 1, At, B1); PG8_BAR; PG8_SCHED;
        }
        if (ALIGN_EPI) { if (wr == 0) PG8_BAR; }
        E(acc, cur, wr, wc, fr, fq);
        if (!has_next) break;
#pragma unroll
        for (int a = 0; a < 2; ++a)
#pragma unroll
            for (int b = 0; b < 2; ++b)
#pragma unroll
                for (int m = 0; m < 4; ++m)
#pragma unroll
                    for (int n = 0; n < 2; ++n) acc[a][b][m][n] = (f32x4){0.f, 0.f, 0.f, 0.f};
        cur = nxt; cA = nA; cB = nB; ++ui;
#pragma unroll
        for (int h = 0; h < 2; ++h)
#pragma unroll
            for (int i = 0; i < 2; ++i) oc[h][i] = on[h][i];
        if (ALIGN_EPI) { if (wr == 1) PG8_BAR; }
    }
    PG8_WAIT_V(0);
    if (!ALIGN_EPI) { if (wr == 0) PG8_BAR; }
    PG8_BAR;
#undef PG8_SA
#undef PG8_SB
#undef PG8_STAGE
#undef PG8_LDA
#undef PG8_LDB
#undef PG8_MMA
#undef PG8_WAIT_V
#undef PG8_WAIT_L
#undef PG8_BAR
#undef PG8_SCHED
}

struct GemmPlain {
    const bf16_t* A; const bf16_t* Bt; int K;
    DEV const char* a_base(const Unit& u) const { return (const char*)A + (size_t)u.pm * (256 * K * 2); }
    DEV const char* b_base(const Unit& u) const { return (const char*)Bt + (size_t)u.pn * (256 * K * 2); }
    DEV unsigned a_off(const Unit&, int h, int R, int C) const { return (unsigned)((h * 128 + R) * K + C) * 2u; }
};
struct RowMajorOrder {
    int nN, nunits, G, c;
    DEV bool next(int i, Unit& u) const { const int L = i * G + c; if (L >= nunits) return false; u.pm = L / nN; u.pn = L - u.pm * nN; return true; }
};
}

template <class RowMap>
DEV void transpose_item(const float* W, int K, int N, bf16_t* WT, LAS float* scr, int item, int lane, const RowMap& rm) {
    const int nblk = N / 32, kb = item / nblk, nbk = item % nblk, k0 = 64 * kb, n0 = 32 * nbk;
    float wr[32];
#pragma unroll
    for (int i = 0; i < 32; ++i) wr[i] = W[(size_t)(k0 + 2 * i + (lane >> 5)) * N + n0 + (lane & 31)];
#pragma unroll
    for (int i = 0; i < 32; ++i) scr[(2 * i + (lane >> 5)) * 33 + (lane & 31)] = wr[i];
    asm volatile("s_waitcnt lgkmcnt(0)" ::: "memory");
    const int c = lane & 7;
#pragma unroll
    for (int j = 0; j < 4; ++j) { const int n = (lane >> 3) + 8 * j; const LAS float* s = scr + (8 * c) * 33 + n;
        u32x4 o; o.x = pack2(s[0 * 33], s[1 * 33]); o.y = pack2(s[2 * 33], s[3 * 33]); o.z = pack2(s[4 * 33], s[5 * 33]); o.w = pack2(s[6 * 33], s[7 * 33]);
        *(u32x4*)(WT + (size_t)rm(n0 + n) * K + k0 + 8 * c) = o; }
    asm volatile("s_waitcnt lgkmcnt(0)" ::: "memory");
}
struct MapId { DEV int operator()(int n) const { return n; } };
struct MapIn { DEV int operator()(int n) const { return (n & ~255) | ((n & 32) << 2) | ((n & 192) >> 1) | (n & 31); } };
template <int NSEL> struct MapGU { DEV int operator()(int h) const { return ((h >> 7) << 8) | (((h >> 6) & 1) << 7) | (((h >> 4) & 3) << 5) | (((h >> 2) & 3) << 3) | (NSEL << 2) | (h & 3); } };

constexpr int IT_IN = (D / 64) * (INW / 32), IT_OUT = (D / 64) * (D / 32), IT_G = (D / 64) * (DE / 32), IT_D = (DE / 64) * (D / 32), IT_EXP = 2 * IT_G + IT_D;
DEV void convert_experts(const P& p, int l, int gw, int ngw, LAS float* scr, int lane) {
    for (int it = gw; it < NE * IT_EXP; it += ngw) {
        const int e = it / IT_EXP; int r = it - e * IT_EXP;
        const size_t le = (size_t)(l * NE + e);
        if (r < IT_G) { transpose_item(p.w_gate + le * D * DE, D, DE, p.wt_gu + (size_t)e * D * D, scr, r, lane, MapGU<0>()); continue; } r -= IT_G;
        if (r < IT_G) { transpose_item(p.w_up + le * D * DE, D, DE, p.wt_gu + (size_t)e * D * D, scr, r, lane, MapGU<1>()); continue; } r -= IT_G;
        transpose_item(p.w_down + le * DE * D, DE, D, p.wt_d + (size_t)e * D * DE, scr, r, lane, MapId());
    }
}
DEV void phase_prologue(const P& p, int bid, int nb, LAS unsigned char* lds) {
    const int tid = otid(), lane = tid & 63, wv = tid >> 6;
    {
        LAS float* sil = (LAS float*)lds;
        LAS float* red = (LAS float*)(lds + 9 * 1024 * 4);
        bool have = false;
        for (int w = bid; w < 2 * 96; w += nb) {
            if (!have) {
                for (int i = tid; i < 9 * 1024; i += NTHR) { const int r = i >> 10, d = i & 1023; const float v = r < 8 ? p.c[r * 1024 + d] : p.c_ctx[d]; sil[i] = v * sigmoidf_(v); }
                have = true;
            }
            __syncthreads();
            const int l = w / 96, col0 = (w % 96) * 64, kq = tid >> 4, c4 = (tid & 15) * 4;
            const float* wp = p.ada_w + (size_t)l * 1024 * 6144 + col0 + c4;
            float acc[9][4];
#pragma unroll
            for (int r = 0; r < 9; ++r)
#pragma unroll
                for (int j = 0; j < 4; ++j) acc[r][j] = 0.f;
#pragma unroll 16
            for (int i = 0; i < 32; ++i) {
                const int k = kq + 32 * i;
                const float4 w4 = *(const float4*)(wp + (size_t)k * 6144);
#pragma unroll
                for (int r = 0; r < 9; ++r) { const float sv = sil[r * 1024 + k]; acc[r][0] += sv * w4.x; acc[r][1] += sv * w4.y; acc[r][2] += sv * w4.z; acc[r][3] += sv * w4.w; }
            }
#pragma unroll
            for (int r = 0; r < 9; ++r)
#pragma unroll
                for (int j = 0; j < 4; ++j) red[(kq * 64 + c4 + j) * 9 + r] = acc[r][j];
            __syncthreads();
            for (int o = tid; o < 64 * 9; o += NTHR) {
                const int cc = o / 9, r = o - cc * 9; float s = 0.f;
#pragma unroll 8
                for (int g = 0; g < 32; ++g) s += red[(g * 64 + cc) * 9 + r];
                p.mod[(size_t)(l * 9 + r) * 6144 + col0 + cc] = s + p.ada_b[l * 6144 + col0 + cc];
            }
        }
        __syncthreads();
    }
    {
        LAS float* scr = (LAS float*)(lds + wv * 16384);
        const int gw = bid * 8 + wv, ngw = nb * 8;
        for (int it = gw; it < 2 * (IT_IN + IT_OUT); it += ngw) {
            const int l = it / (IT_IN + IT_OUT); int r = it - l * (IT_IN + IT_OUT);
            if (r < IT_IN) transpose_item(p.w_in + (size_t)l * D * INW, D, INW, p.wt_in + (size_t)l * INW * D, scr, r, lane, MapIn());
            else transpose_item(p.w_out + (size_t)l * D * D, D, D, p.wt_out + (size_t)l * D * D, scr, r - IT_IN, lane, MapId());
        }
        for (int it = gw; it < 2 * 2 * 8 * 2 * 2; it += ngw) {
            const int m = it >> 2, g = (it >> 1) & 1, r = it & 1;
            transpose_item((g ? p.lru_wx : p.lru_wa) + (size_t)m * 4096, 64, 64, p.wt_lru + (size_t)(m * 2 + g) * 4096, scr, r, lane, MapId());
        }
        convert_experts(p, 0, gw, ngw, scr, lane);
        if (bid == nb - 1) for (int i = tid; i < 2 * 2 * 512; i += NTHR) { const float lam = p.lru_lambda[i]; p.sptab[i] = (-lam > 20.f) ? -lam : log1pf(__expf(-lam)); }
    }
}

DEV void unpack8(const uint2 a, float (&o)[4]) { o[0] = bflo(a.x); o[1] = bfhi(a.x); o[2] = bflo(a.y); o[3] = bfhi(a.y); }
template <int MODE>
DEV void phase_rowA(const P& p, int l, int bid, int nb) {
    const int tid = otid(), lane = tid & 63, wv = tid >> 6;
    const int nrows = (MODE == 2) ? TL : TT;
    const int rpw = (nrows + nb * 8 - 1) / (nb * 8);
    const int r0 = (bid * 8 + wv) * rpw, r1 = min(r0 + rpw, nrows);
    const int lp = (MODE == 2) ? 1 : 0;
    f32x4 ng[4];
#pragma unroll
    for (int i = 0; i < 4; ++i) ng[i] = *(const f32x4*)((MODE == 2 ? p.final_g : p.norm1_g + l * D) + i * 256 + lane * 4);
    for (int t0 = r0; t0 < r1; t0 += 2) {
        f32x4 xr[2][4], g2[2][4], sh[2][4], sc[2][4]; uint2 ya[2][4], yb[2][4];
#pragma unroll
        for (int rr = 0; rr < 2; ++rr) {
            const int t = min(t0 + rr, r1 - 1), mr = mod_row(t);
            const float* src = (MODE == 0) ? (t < TL ? p.x + (size_t)t * D : p.ctx + (size_t)(t - TL) * D) : p.xres + (size_t)t * D;
            const float* mm = p.mod + (size_t)(l * 9 + mr) * 6144;
#pragma unroll
            for (int i = 0; i < 4; ++i) {
                const int c0 = i * 256 + lane * 4;
                xr[rr][i] = *(const f32x4*)(src + c0);
                if (MODE != 0) { g2[rr][i] = *(const f32x4*)(p.mod + (size_t)(lp * 9 + mr) * 6144 + 5 * 1024 + c0); ya[rr][i] = *(const uint2*)(p.y + (size_t)(2 * t) * D + c0); yb[rr][i] = *(const uint2*)(p.y + (size_t)(2 * t + 1) * D + c0); }
                if (MODE != 2) { sh[rr][i] = *(const f32x4*)(mm + c0); sc[rr][i] = *(const f32x4*)(mm + 1024 + c0); }
            }
        }
#pragma unroll
        for (int rr = 0; rr < 2; ++rr) {
            const int t = t0 + rr;
            if (t < r1) {
                float ss = 0.f;
#pragma unroll
                for (int i = 0; i < 4; ++i) {
                    if (MODE != 0) { float a[4], b[4]; unpack8(ya[rr][i], a); unpack8(yb[rr][i], b);
#pragma unroll
                        for (int j = 0; j < 4; ++j) xr[rr][i][j] += g2[rr][i][j] * (a[j] + b[j]); }
#pragma unroll
                    for (int j = 0; j < 4; ++j) ss += xr[rr][i][j] * xr[rr][i][j];
                }
                if (MODE == 1) {
#pragma unroll
                    for (int i = 0; i < 4; ++i) *(f32x4*)(p.xres + (size_t)t * D + i * 256 + lane * 4) = xr[rr][i];
                }
                ss = wave_sum(ss);
                const float rstd = rsqrtf(ss * (1.f / D) + EPS);
#pragma unroll
                for (int i = 0; i < 4; ++i) {
                    const int c0 = i * 256 + lane * 4;
                    if (MODE == 2) *(f32x4*)(p.out + (size_t)t * D + c0) = xr[rr][i] * rstd * ng[i];
                    else {
                        const f32x4 o = xr[rr][i] * rstd * ng[i] * (sc[rr][i] + 1.f) + sh[rr][i];
                        *(uint2*)(p.xn + (size_t)t * D + c0) = make_uint2(pack2(o[0], o[1]), pack2(o[2], o[3]));
                    }
                }
            }
        }
    }
}

struct EpiIn {
    static constexpr bool PERM = true;
    const P* pp; int l; const LAS float* rope;
    DEV void operator()(const f32x4 (&acc)[2][2][4][2], const pg8::Unit& u, int wr, int wc, int fr, int fq) const {
        const P& p = *pp;
        const int pn = u.pn;
        const bool lat = u.pm < TL / 256;
        const bool is_qk = (pn < 2) || (pn == 2 && wc < 2);
        const float qs = pn < 2 ? attn_body_C2 : 1.f;
        bf16_t* dst; int ld; bool kvmap = false;
        if (pn < 2) { dst = p.q + (pn * 4 + wc) * 64; ld = 512; }
        else if (pn == 2) { dst = (wc < 2 ? p.k + wc * 64 : p.v + (wc - 2) * 64); ld = 128; kvmap = true; }
        else if (pn < 5) { dst = p.u + (pn - 3) * 256 + wc * 64; ld = 512; }
        else { dst = p.gb + (pn - 5) * 256 + wc * 64; ld = 512; }
        float gq[2][2][4];
#pragma unroll
        for (int bj = 0; bj < 2; ++bj)
#pragma unroll
            for (int n = 0; n < 2; ++n)
#pragma unroll
                for (int j = 0; j < 4; ++j) gq[bj][n][j] = 1.f;
        if (is_qk) {
            const float* g = (pn < 2 ? p.q_norm_g : p.k_norm_g) + l * 64;
#pragma unroll
            for (int bj = 0; bj < 2; ++bj)
#pragma unroll
                for (int n = 0; n < 2; ++n) { const float4 g4 = *(const float4*)(g + 32 * bj + 8 * fq + 4 * n); gq[bj][n][0] = g4.x; gq[bj][n][1] = g4.y; gq[bj][n][2] = g4.z; gq[bj][n][3] = g4.w; }
        }
#pragma unroll
        for (int ai = 0; ai < 2; ++ai)
#pragma unroll
            for (int m = 0; m < 4; ++m) {
                const int t = u.pm * 256 + ai * 128 + wr * 64 + m * 16 + fr;
                float v[2][2][4];
#pragma unroll
                for (int bj = 0; bj < 2; ++bj)
#pragma unroll
                    for (int n = 0; n < 2; ++n)
#pragma unroll
                        for (int j = 0; j < 4; ++j) v[bj][n][j] = acc[ai][bj][m][n][j];
                if (is_qk) {
                    float ss = 0.f;
#pragma unroll
                    for (int bj = 0; bj < 2; ++bj)
#pragma unroll
                        for (int n = 0; n < 2; ++n)
#pragma unroll
                            for (int j = 0; j < 4; ++j) ss += v[bj][n][j] * v[bj][n][j];
                    ss += __shfl_xor(ss, 16); ss += __shfl_xor(ss, 32);
                    const float rstd = rsqrtf(ss * (1.f / 64.f) + EPS);
                    const int s = t & 2047;
#pragma unroll
                    for (int bj = 0; bj < 2; ++bj) {
                        const int pos = bj ? (s & 63) : (s >> 6);
#pragma unroll
                        for (int n = 0; n < 2; ++n) {
                            float cs4[4] = {1.f, 1.f, 1.f, 1.f}, sn4[4] = {0.f, 0.f, 0.f, 0.f};
                            if (lat) {
                                const int f0 = 8 * (fq & 1) + 4 * n;
                                const f32x4 c4 = *(const LAS f32x4*)(rope + pos * 16 + f0), s4 = *(const LAS f32x4*)(rope + 1024 + pos * 16 + f0);
                                cs4[0] = c4.x; cs4[1] = c4.y; cs4[2] = c4.z; cs4[3] = c4.w; sn4[0] = s4.x; sn4[1] = s4.y; sn4[2] = s4.z; sn4[3] = s4.w;
                            }
#pragma unroll
                            for (int j = 0; j < 4; ++j) {
                                const float w = v[bj][n][j] * gq[bj][n][j];
                                const float pw = __shfl_xor(w, 32);
                                const float o = (fq & 2) ? (w * cs4[j] + pw * sn4[j]) : (w * cs4[j] - pw * sn4[j]);
                                v[bj][n][j] = o * rstd * qs;
                            }
                        }
                    }
                }
                bf16_t* rowp = dst + (size_t)(kvmap ? kv_row(t) : t) * ld;
#pragma unroll
                for (int bj = 0; bj < 2; ++bj) {
                    u32x4 w; w.x = pack2(v[bj][0][0], v[bj][0][1]); w.y = pack2(v[bj][0][2], v[bj][0][3]); w.z = pack2(v[bj][1][0], v[bj][1][1]); w.w = pack2(v[bj][1][2], v[bj][1][3]);
                    *(u32x4*)(rowp + 32 * bj + 8 * fq) = w;
                }
            }
    }
};
struct EpiOut {
    static constexpr bool PERM = false;
    const P* pp; int l;
    DEV void operator()(const f32x4 (&acc)[2][2][4][2], const pg8::Unit& u, int wr, int wc, int fr, int fq) const {
        const P& p = *pp;
        const int col0 = u.pn * 256 + wc * 32 + 4 * fq;
        const int mr = u.pm < TL / 256 ? (u.pm >> 3) : 8;
        const float* g1 = p.mod + (size_t)(l * 9 + mr) * 6144 + 2048 + col0;
        f32x4 gv[2][2];
#pragma unroll
        for (int bj = 0; bj < 2; ++bj)
#pragma unroll
            for (int n = 0; n < 2; ++n) gv[bj][n] = *(const f32x4*)(g1 + bj * 128 + n * 16);
#pragma unroll
        for (int ai = 0; ai < 2; ++ai)
#pragma unroll
            for (int m = 0; m < 4; ++m) {
                const int t = u.pm * 256 + ai * 128 + wr * 64 + m * 16 + fr;
                const float* res = (l == 0) ? (t < TL ? p.x + (size_t)t * D : p.ctx + (size_t)(t - TL) * D) : p.xres + (size_t)t * D;
                float* o = p.xres + (size_t)t * D + col0;
#pragma unroll
                for (int bj = 0; bj < 2; ++bj)
#pragma unroll
                    for (int n = 0; n < 2; ++n) { const f32x4 r4 = *(const f32x4*)(res + col0 + bj * 128 + n * 16); *(f32x4*)(o + bj * 128 + n * 16) = r4 + gv[bj][n] * acc[ai][bj][m][n]; }
            }
    }
};
struct MoeUpDesc {
    const bf16_t* A; const bf16_t* Bt; int K; const LAS i32x2* ptab; const int* cnt; const int* list;
    DEV const char* a_base(const pg8::Unit&) const { return (const char*)A; }
    DEV const char* b_base(const pg8::Unit& u) const { const int e = ptab[u.pm].x; return (const char*)Bt + ((size_t)e * D + (size_t)u.pn * 256) * (D * 2); }
    DEV unsigned a_off(const pg8::Unit& u, int h, int R, int C) const {
        const i32x2 pe = ptab[u.pm]; const int pos = pe.y + h * 128 + R;
        const int tok = pos < cnt[pe.x] ? (list[pe.x * TT + pos] >> 1) : 0;
        return (unsigned)(tok * D + C) * 2u;
    }
};
struct MoeDownDesc {
    const bf16_t* A; const bf16_t* Bt; int K; const LAS i32x2* ptab;
    DEV const char* a_base(const pg8::Unit& u) const { return (const char*)A + (size_t)u.pm * (256 * DE * 2); }
    DEV const char* b_base(const pg8::Unit& u) const { const int e = ptab[u.pm].x; return (const char*)Bt + ((size_t)e * D + (size_t)u.pn * 256) * (DE * 2); }
    DEV unsigned a_off(const pg8::Unit&, int h, int R, int C) const { return (unsigned)((h * 128 + R) * DE + C) * 2u; }
};
struct EpiMoeUp {
    static constexpr bool PERM = true;
    bf16_t* hid;
    DEV void operator()(const f32x4 (&acc)[2][2][4][2], const pg8::Unit& u, int wr, int wc, int fr, int fq) const {
#pragma unroll
        for (int ai = 0; ai < 2; ++ai)
#pragma unroll
            for (int m = 0; m < 4; ++m) {
                bf16_t* rowp = hid + (size_t)(u.pm * 256 + ai * 128 + wr * 64 + m * 16 + fr) * DE + u.pn * 128 + wc * 16 + fq * 4;
#pragma unroll
                for (int bj = 0; bj < 2; ++bj) {
                    const f32x4 g = acc[ai][bj][m][0], up = acc[ai][bj][m][1];
                    float h[4];
#pragma unroll
                    for (int j = 0; j < 4; ++j) h[j] = g[j] * sigmoidf_(g[j]) * up[j];
                    *(u32x2*)(rowp + bj * 64) = (u32x2){pack2(h[0], h[1]), pack2(h[2], h[3])};
                }
            }
    }
};
struct EpiMoeDown {
    static constexpr bool PERM = true;
    bf16_t* y; const float* tokw; const LAS i32x2* ptab; const int* cnt; const int* list;
    DEV void operator()(const f32x4 (&acc)[2][2][4][2], const pg8::Unit& u, int wr, int wc, int fr, int fq) const {
        const i32x2 pe = ptab[u.pm]; const int ce = cnt[pe.x];
#pragma unroll
        for (int ai = 0; ai < 2; ++ai)
#pragma unroll
            for (int m = 0; m < 4; ++m) {
                const int pos = pe.y + ai * 128 + wr * 64 + m * 16 + fr;
                if (pos < ce) {
                    const int pair = list[pe.x * TT + pos]; const float wt = tokw[pair];
                    bf16_t* rowp = y + (size_t)pair * D + u.pn * 256 + wc * 32 + 8 * fq;
#pragma unroll
                    for (int bj = 0; bj < 2; ++bj) {
                        const f32x4 a0 = acc[ai][bj][m][0] * wt, a1 = acc[ai][bj][m][1] * wt;
                        *(u32x4*)(rowp + bj * 128) = (u32x4){pack2(a0[0], a0[1]), pack2(a0[2], a0[3]), pack2(a1[0], a1[1]), pack2(a1[2], a1[3])};
                    }
                }
            }
    }
};
DEV int moe_build_ptab(const int* cnt, LAS i32x2* ptab, int tid) {
    __syncthreads();
    if (tid < 64) {
        const int c = tid < NE ? cnt[tid] : 0;
        const int npan = (c + 255) >> 8;
        int incl = npan;
#pragma unroll
        for (int o = 1; o < 16; o <<= 1) { const int v = __shfl_up(incl, o); if (tid >= o) incl += v; }
        int base = incl - npan;
#pragma unroll 1
        for (int r0 = 0; r0 < c; r0 += 256) { ptab[base] = (i32x2){tid, r0}; ++base; }
        if (tid == NE - 1) ptab[MAXPANELS] = (i32x2){incl, 0};
    }
    __syncthreads();
    return ptab[MAXPANELS].x;
}

#include <hip/hip_bf16.h>
namespace attn_body {
using bf16=__hip_bfloat16;
using bf16x8=__attribute__((ext_vector_type(8)))short;
using s16x4=__attribute__((ext_vector_type(4)))short;
using f32x16=__attribute__((ext_vector_type(16)))float;
using u32x4=__attribute__((ext_vector_type(4)))unsigned;
constexpr int D=64,QP=512,KP=128;
constexpr int NW=8,QBLK=32,QB=QBLK*NW,KVBLK=64;
__device__ __forceinline__ int crow(int r,int hi){return (r&3)+8*(r>>2)+4*hi;}
#define SBAR() __builtin_amdgcn_sched_barrier(0)
constexpr int NSLOT=3, SLOTB=8192;
constexpr int LDS_K=0, LDS_V=NSLOT*SLOTB, LDS_WS=2*NSLOT*SLOTB, LDS_OST=LDS_WS+NW*64*4, LDS_BYTES=LDS_OST+NW*4096;
constexpr float C2=0.125f*1.4426950408889634f;
__device__ __forceinline__ void glds16(const void*gsrc,unsigned lds_dst){unsigned keep;
  asm volatile("s_mov_b32 %0, m0\n\ts_mov_b32 m0, %2\n\ts_nop 0\n\tglobal_load_lds_dwordx4 %1, off\n\ts_mov_b32 m0, %0":"=&s"(keep):"v"(gsrc),"s"(lds_dst):"memory");}
__device__ __forceinline__ float max3f(float a,float b,float c){float r;asm("v_max3_f32 %0, %1, %2, %3":"=v"(r):"v"(a),"v"(b),"v"(c));return r;}
__device__ __forceinline__ float max2f(float a,float b){float r;asm("v_max_f32_e32 %0, %1, %2":"=v"(r):"v"(a),"v"(b));return r;}
__device__ __forceinline__ float fadd_s(float a,float b){float r;asm("v_add_f32_e32 %0, %1, %2":"=v"(r):"v"(a),"v"(b));return r;}
__device__ __forceinline__ float fsub_s(float a,float b){float r;asm("v_sub_f32_e32 %0, %1, %2":"=v"(r):"v"(a),"v"(b));return r;}
typedef float f32x2_t __attribute__((ext_vector_type(2))); typedef __bf16 bf16x2_t __attribute__((ext_vector_type(2)));
__device__ __forceinline__ unsigned cvtpk_s(float lo,float hi){f32x2_t v={lo,hi};bf16x2_t b=__builtin_convertvector(v,bf16x2_t);return __builtin_bit_cast(unsigned,b);}
#define WAIT_BAR(N) asm volatile("s_waitcnt vmcnt(" #N ") lgkmcnt(0)\n\ts_barrier":::"memory")

__device__ __forceinline__ void qkt(f32x16&p0,f32x16&p1,const char*Kslot,const bf16x8*qr,const f32x16&negm,int r32,int hi){
  const char*kb=Kslot+hi*1024+r32*16;
  #pragma unroll
  for(int d0=0;d0<4;++d0){
    const bf16x8 b0=*reinterpret_cast<const bf16x8*>(kb+d0*2048);
    const bf16x8 b1=*reinterpret_cast<const bf16x8*>(kb+d0*2048+512);
    if(d0==0){p0=__builtin_amdgcn_mfma_f32_32x32x16_bf16(b0,qr[0],negm,0,0,0);p1=__builtin_amdgcn_mfma_f32_32x32x16_bf16(b1,qr[0],negm,0,0,0);}
    else{p0=__builtin_amdgcn_mfma_f32_32x32x16_bf16(b0,qr[d0],p0,0,0,0);p1=__builtin_amdgcn_mfma_f32_32x32x16_bf16(b1,qr[d0],p1,0,0,0);}}
}
typedef __attribute__((address_space(3))) const char* lds_cptr;
typedef short v4i16_t __attribute__((ext_vector_type(4)));
__device__ __forceinline__ void kload8(bf16x8*kf,lds_cptr kp){
  kf[0]=*(const __attribute__((address_space(3))) bf16x8*)(kp);      kf[1]=*(const __attribute__((address_space(3))) bf16x8*)(kp+512);
  kf[2]=*(const __attribute__((address_space(3))) bf16x8*)(kp+2048); kf[3]=*(const __attribute__((address_space(3))) bf16x8*)(kp+2560);
  kf[4]=*(const __attribute__((address_space(3))) bf16x8*)(kp+4096); kf[5]=*(const __attribute__((address_space(3))) bf16x8*)(kp+4608);
  kf[6]=*(const __attribute__((address_space(3))) bf16x8*)(kp+6144); kf[7]=*(const __attribute__((address_space(3))) bf16x8*)(kp+6656);
}
__device__ __forceinline__ void kload2(bf16x8*kf,lds_cptr kp,int j){ kf[2*j]=*(const __attribute__((address_space(3))) bf16x8*)(kp+j*2048); kf[2*j+1]=*(const __attribute__((address_space(3))) bf16x8*)(kp+j*2048+512); }
__device__ __forceinline__ s16x4 vtr(lds_cptr p){ return __builtin_bit_cast(s16x4,__builtin_amdgcn_ds_read_tr16_b64_v4i16((__attribute__((address_space(3))) v4i16_t*)p)); }
__device__ __forceinline__ float rowmax(const f32x16&p0,const f32x16&p1){
  float a=max3f(p0[0],p0[1],p1[0]),b=max3f(p0[2],p0[3],p1[1]);a=max3f(a,p1[2],p1[3]);
  #pragma unroll
  for(int r=4;r<16;r+=4){a=max3f(a,p0[r],p0[r+1]);b=max3f(b,p0[r+2],p0[r+3]);a=max3f(a,p1[r],p1[r+1]);b=max3f(b,p1[r+2],p1[r+3]);}
  const float m=max2f(a,b);
  auto rr=__builtin_amdgcn_permlane32_swap(__float_as_uint(m),__float_as_uint(m),false,false);
  return max2f(__uint_as_float(rr[0]),__uint_as_float(rr[1]));
}
__device__ __forceinline__ void pv(f32x16*o,int vb,bf16x8 pa0,bf16x8 pa1,bf16x8 pa2,bf16x8 pa3){
  #pragma unroll
  for(int d0=0;d0<2;++d0){s16x4 lo[4],hi[4];
    #pragma unroll
    for(int ks=0;ks<4;++ks){
      asm volatile("ds_read_b64_tr_b16 %0,%1 offset:%c2":"=&v"(lo[ks]):"v"(vb),"i"(d0*4096+ks*1024):"memory");
      asm volatile("ds_read_b64_tr_b16 %0,%1 offset:%c2":"=&v"(hi[ks]):"v"(vb),"i"(d0*4096+ks*1024+512):"memory");}
    asm volatile("s_waitcnt lgkmcnt(0)":::"memory");SBAR();
    #define PK(k) (bf16x8){lo[k][0],lo[k][1],lo[k][2],lo[k][3],hi[k][0],hi[k][1],hi[k][2],hi[k][3]}
    o[d0]=__builtin_amdgcn_mfma_f32_32x32x16_bf16(pa0,PK(0),o[d0],0,0,0);
    o[d0]=__builtin_amdgcn_mfma_f32_32x32x16_bf16(pa1,PK(1),o[d0],0,0,0);
    o[d0]=__builtin_amdgcn_mfma_f32_32x32x16_bf16(pa2,PK(2),o[d0],0,0,0);
    o[d0]=__builtin_amdgcn_mfma_f32_32x32x16_bf16(pa3,PK(3),o[d0],0,0,0);
    #undef PK
  }
}

#ifndef ATTN_STORE16
#define ATTN_STORE16(p,v) (*(u32x4*)(p)=(v))
#endif
template<int THRL> __device__ __forceinline__ void attn_unit(const bf16*Qu,const bf16*__restrict__ Kh,const bf16*__restrict__ Vh,bf16*Ou,const int NT,char*shm,const int tid){
  const int lane=tid&63,r32=lane&31,hi=lane>>5; const int wid=__builtin_amdgcn_readfirstlane(tid>>6);
  const bf16*Qw=Qu+(long)(wid*QBLK)*QP;
  const unsigned lds0=(unsigned)(uintptr_t)shm;
  float*wsf=(float*)(shm+LDS_WS)+wid*64;
  const bf16*ksrc=Kh+(long)lane*KP+wid*8;
  const bf16*vsrc=Vh+(long)(16*(wid&3)+(lane>>2))*KP+(wid>>2)*32+(lane&3)*8;
  const unsigned kdst=lds0+LDS_K+wid*1024, vdst=lds0+LDS_V+wid*1024;
  #define DMA_K(t,slot) glds16(ksrc+(long)(t)*KVBLK*KP,(unsigned)__builtin_amdgcn_readfirstlane(kdst+(slot)))
  #define DMA_V(t,slot) glds16(vsrc+(long)(t)*KVBLK*KP,(unsigned)__builtin_amdgcn_readfirstlane(vdst+(slot)))
  const int vb0=(int)(lds0+LDS_V)+((lane>>4)&1)*32+(lane&3)*8+(4*hi+((lane&15)>>2))*64;
  const char*Kbase=shm+LDS_K; bf16x8 kf[8];
  const lds_cptr shm3=(lds_cptr)shm; const lds_cptr kp0=shm3+LDS_K+hi*1024+r32*16; const lds_cptr vp0=shm3+LDS_V+((lane>>4)&1)*32+(lane&3)*8+(4*hi+((lane&15)>>2))*64;
  DMA_K(0,0);DMA_V(0,0);DMA_K(1,SLOTB);
  bf16x8 qr[4];
  #pragma unroll
  for(int d0=0;d0<4;++d0)qr[d0]=*reinterpret_cast<const bf16x8*>(&Qw[(long)r32*QP+d0*16+hi*8]);
  float mhat=0.f,l_reg=0.f;f32x16 o[2];o[0]=f32x16{};o[1]=f32x16{};f32x16 negm=f32x16{};asm volatile("":"+v"(negm));
  #define CMASK(P0,P1,t) do{}while(0)
  bool resc=false;
  #define START(P0,P1) do{ const float rm=rowmax(P0,P1); resc=false; \
    { const float dl=rm; mhat=fadd_s(mhat,dl); \
      _Pragma("unroll") for(int r=0;r<16;++r){P0[r]=fsub_s(P0[r],dl);P1[r]=fsub_s(P1[r],dl);} \
      _Pragma("unroll") for(int r=0;r<16;++r)negm[r]=-mhat; asm volatile("":"+v"(negm)); } \
    _Pragma("unroll") for(int r=0;r<16;++r)P0[r]=__builtin_amdgcn_exp2f(P0[r]); }while(0)
  #define RESC() do{ if(resc){ asm volatile("s_waitcnt lgkmcnt(0)":::"memory"); \
      _Pragma("unroll") for(int d_=0;d_<2;++d_) _Pragma("unroll") for(int r=0;r<16;++r)o[d_][r]*=wsf[crow(r,hi)]; } }while(0)
  f32x16 pA0,pA1,pB0,pB1;
  int sl_prev=0,sl_cur=0,sl_next=SLOTB;
  #define ROT() do{sl_prev=sl_cur;sl_cur=sl_next;sl_next=(sl_next==(NSLOT-1)*SLOTB)?0:sl_next+SLOTB;}while(0)
  DMA_K(2,2*SLOTB);
  WAIT_BAR(3);
  qkt(pA0,pA1,Kbase,qr,negm,r32,hi);asm volatile("s_nop 15\n\ts_nop 7":"+v"(pA0),"+v"(pA1));CMASK(pA0,pA1,0);
  START(pA0,pA1);
  _Pragma("unroll") for(int r=0;r<16;++r)pA1[r]=__builtin_amdgcn_exp2f(pA1[r]);
  WAIT_BAR(0);
  DMA_K(3,0);DMA_V(1,SLOTB);
  ROT();
  kload8(kf,kp0+sl_cur);
  WAIT_BAR(2);
  s16x4 vlo[8],vhi[8]; u32x4 pw0,pw1,pw2,pw3;
  #define PKW(P,B) cvtpk_s(P[B],P[B+1])
  #define PAF(k) __builtin_bit_cast(bf16x8,pw##k)
  #define VFR(i) (bf16x8){vlo[i][0],vlo[i][1],vlo[i][2],vlo[i][3],vhi[i][0],vhi[i][1],vhi[i][2],vhi[i][3]}
  #define PIN(x) asm volatile("":"+v"(x))
  #define MX3(a,b,c) __builtin_fmaxf(__builtin_fmaxf((a),(b)),(c))
  #define GAPA(MF,A0,A1,A2,A3,W0,W1,PW) do{ MF; sacc+=A0; sacc+=A1; sacc+=A2; sacc+=A3; PIN(sacc); W0; W1; PIN(PW); SBAR(); }while(0)
  #define EX(v) __builtin_amdgcn_exp2f(v)
  #define GAPB(MF,X,B) do{ MF; X[B]=EX(X[B]); X[B+1]=EX(X[B+1]); X[B+2]=EX(X[B+2]); X[B+3]=EX(X[B+3]); PIN(X); SBAR(); }while(0)
  #define VRD(i) do{ vlo[i]=vtr(vp_+(((i)>>2)*4096+((i)&3)*1024)); vhi[i]=vtr(vp_+(((i)>>2)*4096+((i)&3)*1024+512)); }while(0)
  #define KRD(G,j) do{ if(G){ kload2(kf,kp0+sl_next,j); SBAR(); } }while(0)
  #define STEP(C0,C1,P0,P1,t,GK,GV,GL) do{ SBAR(); \
    const lds_cptr vp_=vp0+sl_prev; \
    VRD(0); SBAR(); float sacc=(P0[0]+P0[1]); \
    GAPA(C0=__builtin_amdgcn_mfma_f32_32x32x16_bf16(kf[0],qr[0],negm,0,0,0), P0[2],P0[3],P0[4],P0[5],     pw0[0]=PKW(P0,0), pw0[1]=PKW(P0,2), pw0); \
    VRD(4); SBAR(); GAPA(C1=__builtin_amdgcn_mfma_f32_32x32x16_bf16(kf[1],qr[0],negm,0,0,0), P0[6],P0[7],P0[8],P0[9],     pw0[2]=PKW(P0,4), pw0[3]=PKW(P0,6), pw0); \
    VRD(1); SBAR(); GAPA(C0=__builtin_amdgcn_mfma_f32_32x32x16_bf16(kf[2],qr[1],C0,0,0,0),   P0[10],P0[11],P0[12],P0[13], pw1[0]=PKW(P0,8), pw1[1]=PKW(P0,10), pw1); \
    VRD(5); SBAR(); GAPA(C1=__builtin_amdgcn_mfma_f32_32x32x16_bf16(kf[3],qr[1],C1,0,0,0),   P0[14],P0[15],P1[0],P1[1],   pw1[2]=PKW(P0,12),pw1[3]=PKW(P0,14), pw1); \
    VRD(2); SBAR(); GAPA(C0=__builtin_amdgcn_mfma_f32_32x32x16_bf16(kf[4],qr[2],C0,0,0,0),   P1[2],P1[3],P1[4],P1[5],     pw2[0]=PKW(P1,0), pw2[1]=PKW(P1,2), pw2); \
    VRD(6); SBAR(); GAPA(C1=__builtin_amdgcn_mfma_f32_32x32x16_bf16(kf[5],qr[2],C1,0,0,0),   P1[6],P1[7],P1[8],P1[9],     pw2[2]=PKW(P1,4), pw2[3]=PKW(P1,6), pw2); \
    VRD(3); SBAR(); GAPA(C0=__builtin_amdgcn_mfma_f32_32x32x16_bf16(kf[6],qr[3],C0,0,0,0),   P1[10],P1[11],P1[12],P1[13], pw3[0]=PKW(P1,8), pw3[1]=PKW(P1,10), pw3); \
    VRD(7); SBAR(); GAPA(C1=__builtin_amdgcn_mfma_f32_32x32x16_bf16(kf[7],qr[3],C1,0,0,0),   P1[14],P1[15],0.f,0.f,       pw3[2]=PKW(P1,12),pw3[3]=PKW(P1,14), pw3); \
    l_reg+=sacc; \
    if(GK){DMA_K((t)+3,sl_cur);} if(GV){DMA_V((t)+1,sl_next);} \
    CMASK(C0,C1,t); \
    { float a=MX3(C0[0],C0[1],C1[0]),b=MX3(C0[2],C0[3],C1[1]); a=MX3(a,C1[2],C1[3]); \
      _Pragma("unroll") for(int r=4;r<16;r+=4){a=MX3(a,C0[r],C0[r+1]);b=MX3(b,C0[r+2],C0[r+3]);a=MX3(a,C1[r],C1[r+1]);b=MX3(b,C1[r+2],C1[r+3]);} \
      float rm=__builtin_fmaxf(a,b); { auto rr=__builtin_amdgcn_permlane32_swap(__float_as_uint(rm),__float_as_uint(rm),false,false); rm=__builtin_fmaxf(__uint_as_float(rr[0]),__uint_as_float(rr[1])); } \
      resc=false; \
      if(__builtin_expect(__any(rm>(float)THRL),0)){ const float dl=__builtin_fmaxf(rm,0.f); mhat+=dl; \
        _Pragma("unroll") for(int r=0;r<16;++r){C0[r]-=dl;C1[r]-=dl;} \
        _Pragma("unroll") for(int r=0;r<16;++r)negm[r]=-mhat; asm volatile("":"+v"(negm)); \
        const float f=__builtin_amdgcn_exp2f(-dl); l_reg*=f; if(hi==0)wsf[r32]=f; resc=true; } } \
    SBAR(); \
    GAPB(o[0]=__builtin_amdgcn_mfma_f32_32x32x16_bf16(PAF(0),VFR(0),o[0],0,0,0), C0,0); \
    GAPB(o[1]=__builtin_amdgcn_mfma_f32_32x32x16_bf16(PAF(0),VFR(4),o[1],0,0,0), C0,4); \
    KRD(GL,0); GAPB(o[0]=__builtin_amdgcn_mfma_f32_32x32x16_bf16(PAF(1),VFR(1),o[0],0,0,0), C0,8); \
    KRD(GL,1); GAPB(o[1]=__builtin_amdgcn_mfma_f32_32x32x16_bf16(PAF(1),VFR(5),o[1],0,0,0), C0,12); \
    KRD(GL,2); GAPB(o[0]=__builtin_amdgcn_mfma_f32_32x32x16_bf16(PAF(2),VFR(2),o[0],0,0,0), C1,0); \
    KRD(GL,3); GAPB(o[1]=__builtin_amdgcn_mfma_f32_32x32x16_bf16(PAF(2),VFR(6),o[1],0,0,0), C1,4); \
    GAPB(o[0]=__builtin_amdgcn_mfma_f32_32x32x16_bf16(PAF(3),VFR(3),o[0],0,0,0), C1,8); \
    GAPB(o[1]=__builtin_amdgcn_mfma_f32_32x32x16_bf16(PAF(3),VFR(7),o[1],0,0,0), C1,12); \
    }while(0)
  int t=1;
  #undef CMASK
  #define CMASK(P0,P1,t) do{}while(0)
  for(;t+5<NT;t+=2){
    STEP(pB0,pB1,pA0,pA1,t,true,true,true);     WAIT_BAR(2); RESC(); ROT();
    STEP(pA0,pA1,pB0,pB1,t+1,true,true,true);   WAIT_BAR(2); RESC(); ROT();
  }
  #undef CMASK
  #define CMASK(P0,P1,t) do{}while(0)
  #define ENDW(tt) do{ if((tt)+3<NT){WAIT_BAR(2);} else if((tt)+2<NT){WAIT_BAR(1);} else {WAIT_BAR(0);} }while(0)
  for(;t+1<NT;t+=2){
    STEP(pB0,pB1,pA0,pA1,t,(t+3<NT),(t+1<NT),(t+1<NT));       ENDW(t);   RESC(); ROT();
    STEP(pA0,pA1,pB0,pB1,t+1,(t+4<NT),(t+2<NT),(t+2<NT));     ENDW(t+1); RESC(); ROT();
  }
  STEP(pB0,pB1,pA0,pA1,NT-1,false,false,false); RESC();
  { float sacc=pB0[0]+pB0[1]; _Pragma("unroll") for(int r=2;r<16;++r)sacc+=pB0[r]; _Pragma("unroll") for(int r=0;r<16;++r)sacc+=pB1[r]; l_reg+=sacc;
    pw0=(u32x4){PKW(pB0,0),PKW(pB0,2),PKW(pB0,4),PKW(pB0,6)};pw1=(u32x4){PKW(pB0,8),PKW(pB0,10),PKW(pB0,12),PKW(pB0,14)};pw2=(u32x4){PKW(pB1,0),PKW(pB1,2),PKW(pB1,4),PKW(pB1,6)};pw3=(u32x4){PKW(pB1,8),PKW(pB1,10),PKW(pB1,12),PKW(pB1,14)};
    SBAR(); pv(o,vb0+sl_cur,PAF(0),PAF(1),PAF(2),PAF(3)); }
  #undef PKW
  #undef PAF
  #undef VFR
  #undef PIN
  #undef MX3
  #undef GAPA
  #undef GAPB
  #undef EX
  #undef VRD
  #undef KRD
  #undef STEP
  #undef ENDW
  {auto rr=__builtin_amdgcn_permlane32_swap(__float_as_uint(l_reg),__float_as_uint(l_reg),false,false);l_reg=__uint_as_float(rr[0])+__uint_as_float(rr[1]);}
  if(hi==0)wsf[32+r32]=l_reg;asm volatile("s_waitcnt lgkmcnt(0)":::"memory");
  float rli[16];
  #pragma unroll
  for(int r=0;r<16;++r)rli[r]=__builtin_amdgcn_rcpf(wsf[32+crow(r,hi)]);
  bf16*Ow=Ou+(long)(wid*QBLK)*QP;
  { bf16*stg=(bf16*)(shm+LDS_OST)+wid*2048;
    #pragma unroll
    for(int r=0;r<16;++r){const int orow=crow(r,hi);
      #pragma unroll
      for(int d0=0;d0<2;++d0)stg[orow*64+d0*32+r32]=__float2bfloat16(o[d0][r]*rli[r]);}
    asm volatile("s_waitcnt lgkmcnt(0)":::"memory");
    #pragma unroll
    for(int i=0;i<4;++i){const int row=i*8+(lane>>3),ch=lane&7; const u32x4 v=*(const u32x4*)(stg+row*64+ch*8); ATTN_STORE16(Ow+(long)row*QP+ch*8,v);} }
  asm volatile("s_waitcnt lgkmcnt(0)\n\ts_barrier":::"memory");
  #undef DMA_K
  #undef DMA_V
  #undef CMASK
  #undef START
  #undef RESC
  #undef ROT
}
constexpr int ATTN_LDS_BYTES=LDS_BYTES;
#undef SBAR
#undef WAIT_BAR
}

DEV void lru_loop(const P& p, int l, LAS unsigned char* lds, volatile LAS unsigned* misc, int tid);
DEV void phase_attn_lru(const P& p, int l, LAS unsigned char* lds, volatile LAS unsigned* misc, int tid) {
    const int nattn = (l == 0) ? 512 + 64 : 512;
    int u;
    for (;;) {
        __syncthreads();
        if (tid == 0) misc[4] = (unsigned)atomicAdd(p.qctr + l, 1);
        __syncthreads();
        u = (int)misc[4];
        if (u >= nattn) break;
        int t2 = tid; asm volatile("" : "+v"(t2));
        int b, h, qrow0, nt;
        if (u < 512) { b = u >> 6; h = (u >> 3) & 7; qrow0 = b * S + (u & 7) * 256; nt = KVS / 64; }
        else { const int u2 = u - 512; b = u2 >> 3; h = u2 & 7; qrow0 = TL + b * CL; nt = CL / 64; }
        attn_body::bf16* qp = (attn_body::bf16*)(p.q + (size_t)qrow0 * 512 + h * 64);
        const attn_body::bf16* kp = (const attn_body::bf16*)(p.k + (size_t)b * KVS * 128 + (h >> 2) * 64);
        const attn_body::bf16* vp = (const attn_body::bf16*)(p.v + (size_t)b * KVS * 128 + (h >> 2) * 64);
        attn_body::attn_unit<8>(qp, kp, vp, qp, nt, (char*)lds, t2);
    }
    { int t2 = tid; asm volatile("" : "+v"(t2)); lru_loop(p, l, lds, misc, t2); }
}

constexpr int NCHK = 18;
constexpr int LRU_SEG = 0  , LRU_WT = 16384  ,
              LRU_PRM = LRU_WT + 32768  , LRU_WAVE = LRU_PRM + 2816, LRU_WAVE_BYTES = 2432   + 2304   + 512  ;
static_assert(LRU_WAVE + 8 * LRU_WAVE_BYTES <= RING_BYTES, "LRU LDS map");
template <int CTRL> DEV float dpp_keep(float oldv, float src) { return __builtin_bit_cast(float, __builtin_amdgcn_update_dpp(__builtin_bit_cast(int, oldv), __builtin_bit_cast(int, src), CTRL, 0xf, 0xf, false)); }
template <int D> DEV void row_scan(float& A, float& H) {
#define LRU_STEP(SH) { const float Ap = dpp_keep<(D == 0 ? 0x110 : 0x100) + SH>(1.f, A), Hp = dpp_keep<(D == 0 ? 0x110 : 0x100) + SH>(0.f, H); H = A * Hp + H; A = A * Ap; }
    LRU_STEP(1) LRU_STEP(2) LRU_STEP(4) LRU_STEP(8)
#undef LRU_STEP
}
DEV void lru_mfma(const LAS bf16_t* Wt, const bf16x8 (&bu)[2], f32x4 (&pre)[2][4], int q, int cg) {
#pragma unroll
    for (int g = 0; g < 2; ++g)
#pragma unroll
        for (int ct = 0; ct < 4; ++ct) {
            f32x4 a4 = (f32x4){0.f, 0.f, 0.f, 0.f};
#pragma unroll
            for (int ks = 0; ks < 2; ++ks) { const bf16x8 wv = *(const LAS bf16x8*)(Wt + (g * 64 + ct * 16 + q) * 64 + (((ks * 4 + cg) ^ (q & 7)) << 3)); a4 = __builtin_amdgcn_mfma_f32_16x16x32_bf16(wv, bu[ks], a4, 0, 0, 0); }
            pre[g][ct] = a4;
        }
}
template <int D>
DEV void lru_ew_scan(const LAS float* par, const f32x4 (&pre)[2][4], const float (&uc)[4][4], float (&SA)[4][4], float (&SH)[4][4], LAS float* seg, int w, int q, int cg) {
#pragma unroll
    for (int ct = 0; ct < 4; ++ct) {
        const int ch0 = ct * 16 + cg * 4;
        const f32x4 ba = *(const LAS f32x4*)(par + (5 + 3 * D) * 64 + ch0), bx = *(const LAS f32x4*)(par + (6 + 3 * D) * 64 + ch0), sp = *(const LAS f32x4*)(par + (7 + 3 * D) * 64 + ch0);
#pragma unroll
        for (int j = 0; j < 4; ++j) {
            const float r = sigmoidf_(pre[0][ct][j] + ba[j]), ig = sigmoidf_(pre[1][ct][j] + bx[j]);
            float A = __expf(-8.f * r * sp[j]);
            float H = __builtin_amdgcn_sqrtf(fmaxf(1.f - A * A, 0.f)) * (ig * uc[ct][j]);
            row_scan<D>(A, H);
            SA[ct][j] = A; SH[ct][j] = H;
        }
        if (q == (D == 0 ? 15 : 0)) {
            *(LAS f32x4*)(seg + ((D * 2 + 0) * 8 + w) * 64 + ch0) = (f32x4){SA[ct][0], SA[ct][1], SA[ct][2], SA[ct][3]};
            *(LAS f32x4*)(seg + ((D * 2 + 1) * 8 + w) * 64 + ch0) = (f32x4){SH[ct][0], SH[ct][1], SH[ct][2], SH[ct][3]};
        }
    }
}
template <int D>
DEV void lru_apply(const P& p, int b, int n, int c, size_t tok0, const float (&SA)[4][4], const float (&SH)[4][4], LAS float* seg, LAS float* xch, int w, int lane, int q, int cg) {
    const LAS float* sA = seg + (D * 2 + 0) * 512; const LAS float* sH = seg + (D * 2 + 1) * 512;
    float ta[8], th[8];
#pragma unroll
    for (int sgi = 0; sgi < 8; ++sgi) { ta[sgi] = sA[sgi * 64 + lane]; th[sgi] = sH[sgi * 64 + lane]; }
    float hin = 0.f, apre = 1.f;
#pragma unroll
    for (int k = 0; k < 8; ++k) { const int sgi = D == 0 ? k : 7 - k; if (D == 0 ? (sgi < w) : (sgi > w)) { hin = ta[sgi] * hin + th[sgi]; apre *= ta[sgi]; } }
    if (w == (D == 0 ? 7 : 0)) {
        const float sa = D == 0 ? ta[7] : ta[0], sh = D == 0 ? th[7] : th[0]; const size_t ti = ((size_t)((b * 2 + D) * NCHK + c)) * 512 + n * 64 + lane;
        p.totA[ti] = apre * sa; p.totH[ti] = sa * hin + sh;
    }
    xch[lane] = hin; xch[64 + lane] = apre;
    asm volatile("s_waitcnt lgkmcnt(0)" ::: "memory");
    bf16_t* hp = p.hl + ((size_t)D * TT + tok0 + q) * 512 + n * 64 + cg * 4; bf16_t* ap = p.ac + ((size_t)D * TT + tok0 + q) * 512 + n * 64 + cg * 4;
#pragma unroll
    for (int ct = 0; ct < 4; ++ct) {
        const f32x4 h4 = *(const LAS f32x4*)(xch + ct * 16 + cg * 4), a4 = *(const LAS f32x4*)(xch + 64 + ct * 16 + cg * 4);
        *(u32x2*)(hp + ct * 16) = (u32x2){pack2(SH[ct][0] + SA[ct][0] * h4[0], SH[ct][1] + SA[ct][1] * h4[1]), pack2(SH[ct][2] + SA[ct][2] * h4[2], SH[ct][3] + SA[ct][3] * h4[3])};
        *(u32x2*)(ap + ct * 16) = (u32x2){pack2(SA[ct][0] * a4[0], SA[ct][1] * a4[1]), pack2(SA[ct][2] * a4[2], SA[ct][3] * a4[3])};
    }
}
DEV void lru_issue(const P& p, int n, int item, int w, int lane, u32x4 (&uv)[3]) {
    const int c = item % NCHK, b = item / NCHK;
    const bool isctx = c < 2;
    const int seqbase = isctx ? TL + b * CL : b * S, seqlen = isctx ? CL : S, p0 = (isctx ? 128 * c : 128 * (c - 2)) + 16 * w;
#pragma unroll
    for (int i = 0; i < 3; ++i) {
        const int r = (lane >> 3) + 8 * i, tok = p0 - 2 + r;
        uv[i] = (u32x4){0u, 0u, 0u, 0u};
        if (r < 19 && tok >= 0 && tok < seqlen) uv[i] = *(const u32x4*)(p.u + (size_t)(seqbase + tok) * 512 + n * 64 + (lane & 7) * 8);
    }
}
DEV int lru_compute(const P& p, int l, int n, int item, const u32x4 (&uv)[3], int nxt, int nlru, u32x4 (&uvn)[3], int par, int pub, int& pubn, volatile LAS unsigned* misc, LAS unsigned char* lds, int tid) {
    const int c = item % NCHK, b = item / NCHK;
    const int lane = tid & 63, w = __builtin_amdgcn_readfirstlane(tid >> 6), q = lane & 15, cg = lane >> 4;
    LAS float* seg = (LAS float*)(lds + LRU_SEG) + par * 2048;
    const LAS bf16_t* Wt = (const LAS bf16_t*)(lds + LRU_WT);
    const LAS float* prm = (const LAS float*)(lds + LRU_PRM);
    LAS bf16_t* Uraw = (LAS bf16_t*)(lds + LRU_WAVE + w * LRU_WAVE_BYTES);
    LAS bf16_t* Ub = (LAS bf16_t*)(lds + LRU_WAVE + w * LRU_WAVE_BYTES + 2432);
    LAS float* xch = (LAS float*)(lds + LRU_WAVE + w * LRU_WAVE_BYTES + 2432 + 2304);
    const bool isctx = c < 2;
    const int seqbase = isctx ? TL + b * CL : b * S, p0 = (isctx ? 128 * c : 128 * (c - 2)) + 16 * w;
    if (nxt < nlru) lru_issue(p, n, nxt, w, lane, uvn);
    pubn = 0;
    if (tid == 0) pubn = atomicAdd(p.qctr + 2 + l * 8 + n, 1);
#pragma unroll
    for (int i = 0; i < 3; ++i) { const int r = (lane >> 3) + 8 * i; if (r < 19) *(LAS u32x4*)(Uraw + r * 64 + (lane & 7) * 8) = uv[i]; }
    asm volatile("s_waitcnt lgkmcnt(0)" ::: "memory");
    float uc[4][4];
#pragma unroll
    for (int ct = 0; ct < 4; ++ct) {
        const int ch0 = ct * 16 + cg * 4;
        f32x4 acc = *(const LAS f32x4*)(prm + ch0);
#pragma unroll
        for (int j = 0; j < 4; ++j) {
            const u32x2 raw = *(const LAS u32x2*)(Uraw + (q + j) * 64 + ch0); const f32x4 cw = *(const LAS f32x4*)(prm + (1 + j) * 64 + ch0);
            acc[0] += bflo(raw.x) * cw[0]; acc[1] += bfhi(raw.x) * cw[1]; acc[2] += bflo(raw.y) * cw[2]; acc[3] += bfhi(raw.y) * cw[3];
        }
        uc[ct][0] = acc[0]; uc[ct][1] = acc[1]; uc[ct][2] = acc[2]; uc[ct][3] = acc[3];
        *(LAS u32x2*)(Ub + q * 72 + ch0) = (u32x2){pack2(acc[0], acc[1]), pack2(acc[2], acc[3])};
    }
    asm volatile("s_waitcnt lgkmcnt(0)" ::: "memory");
    bf16x8 bu[2];
#pragma unroll
    for (int ks = 0; ks < 2; ++ks) bu[ks] = *(const LAS bf16x8*)(Ub + q * 72 + ks * 32 + cg * 8);
    float SA0[4][4], SH0[4][4], SA1[4][4], SH1[4][4];
    f32x4 pre[2][4];
    lru_mfma(Wt, bu, pre, q, cg);
    lru_ew_scan<0>(prm, pre, uc, SA0, SH0, seg, w, q, cg);
    lru_mfma(Wt + 8192, bu, pre, q, cg);
    lru_ew_scan<1>(prm, pre, uc, SA1, SH1, seg, w, q, cg);
    if (tid == 0) misc[8 + par] = (unsigned)pub;
    __syncthreads();
    const int nn = (int)misc[8 + par];
    const size_t tok0 = (size_t)seqbase + p0;
    lru_apply<0>(p, b, n, c, tok0, SA0, SH0, seg, xch, w, lane, q, cg);
    lru_apply<1>(p, b, n, c, tok0, SA1, SH1, seg, xch, w, lane, q, cg);
    return nn;
}

DEV void lru_loop(const P& p, int l, LAS unsigned char* lds, volatile LAS unsigned* misc, int tid) {
    const int lane = tid & 63, w = __builtin_amdgcn_readfirstlane(tid >> 6);
    const int n = blockIdx.x & 7, nlru = NB * NCHK;
    int* qn = p.qctr + 2 + l * 8 + n;
    __syncthreads();
    if (tid == 0) { const int a = atomicAdd(qn, 2); misc[4] = (unsigned)a; }
    {
        LAS bf16_t* Wt = (LAS bf16_t*)(lds + LRU_WT);
#pragma unroll
        for (int k = 0; k < 4; ++k) {
            const int i = tid + NTHR * k, d = i >> 10, row = (i >> 3) & 127, c8 = i & 7;
            const u32x4 v = *(const u32x4*)(p.wt_lru + (size_t)(((l * 2 + d) * 8 + n) * 2) * 4096 + row * 64 + c8 * 8);
            *(LAS u32x4*)(Wt + d * 8192 + row * 64 + ((c8 ^ (row & 7)) << 3)) = v;
        }
        LAS float* prm = (LAS float*)(lds + LRU_PRM);
        if (tid < 64) {
            const int ch = n * 64 + tid;
            prm[tid] = p.conv_b[l * 512 + ch];
#pragma unroll
            for (int j = 0; j < 4; ++j) prm[(1 + j) * 64 + tid] = p.conv_w[(l * 4 + j) * 512 + ch];
#pragma unroll
            for (int d = 0; d < 2; ++d) { const int pi = (l * 2 + d) * 512 + ch; prm[(5 + 3 * d) * 64 + tid] = p.lru_ba[pi]; prm[(6 + 3 * d) * 64 + tid] = p.lru_bx[pi]; prm[(7 + 3 * d) * 64 + tid] = p.sptab[pi]; }
        }
    }
    __syncthreads();
    int cur = (int)misc[4], nxt = cur + 1;
    if (cur >= nlru) return;
    u32x4 uvA[3], uvB[3];
    lru_issue(p, n, cur, w, lane, uvA);
    int pub = 0, par = 0;
    if (tid == 0) pub = atomicAdd(qn, 1);
    for (;;) {
        int pubn;
        const int nn = lru_compute(p, l, n, cur, uvA, nxt, nlru, uvB, par, pub, pubn, misc, lds, tid);
        if (nxt >= nlru) break;
        cur = nxt; nxt = nn; pub = pubn; par ^= 1;
#pragma unroll
        for (int i = 0; i < 3; ++i) uvA[i] = uvB[i];
    }
}

DEV void phase_mix(const P& p, int l, int bid, int nb, LAS unsigned char* lds) {
    const int tid = otid(), lane = tid & 63, wv = tid >> 6;
    LAS float* cin = (LAS float*)lds;
    const int nitems = NB * NCHK;
    for (int it = bid; it < nitems; it += nb) {
        const int b = it / NCHK, c = it - b * NCHK;
        if (l == 1 && c < 2) continue;
        __syncthreads();
        {
            const int ch = tid;
            const float* tA = p.totA + (size_t)(b * 2) * NCHK * 512 + ch; const float* tH = p.totH + (size_t)(b * 2) * NCHK * 512 + ch;
            float fa[NCHK], fh[NCHK], ba_[NCHK], bh[NCHK];
#pragma unroll
            for (int cc = 0; cc < NCHK; ++cc) { fa[cc] = tA[cc * 512]; fh[cc] = tH[cc * 512]; ba_[cc] = tA[(NCHK + cc) * 512]; bh[cc] = tH[(NCHK + cc) * 512]; }
            float h = 0.f;
#pragma unroll
            for (int cc = 0; cc < NCHK; ++cc) if (cc < c) h = fa[cc] * h + fh[cc];
            cin[ch] = h;
            const int pos = c == 1 ? 0 : (c == 0 ? 1 : 2 + (NCHK - 1 - c));
            h = 0.f;
            if (0 < pos) h = bh[1];
            if (1 < pos) h = ba_[0] * h + bh[0];
#pragma unroll
            for (int k = 2; k < NCHK; ++k) if (k < pos) h = ba_[NCHK + 1 - k] * h + bh[NCHK + 1 - k];
            cin[512 + ch] = h;
        }
        __syncthreads();
        const int tbase = (c < 2) ? TL + b * CL + 128 * c : b * S + 128 * (c - 2);
        const int c0 = lane * 8;
        float gaq[8], grq[8];
#pragma unroll
        for (int i = 0; i < 8; ++i) { gaq[i] = p.attn_out_g[l * 512 + c0 + i]; grq[i] = p.lru_out_g[l * 512 + c0 + i]; }
        for (int r = wv; r < 128; r += 16) {
            uint4 a4[2], g4[2], hf4[2], hb4[2], af4[2], ab4[2];
#pragma unroll
            for (int rr = 0; rr < 2; ++rr) {
                const size_t t = (size_t)(tbase + r + 8 * rr);
                a4[rr] = *(const uint4*)(p.q + t * 512 + c0); g4[rr] = *(const uint4*)(p.gb + t * 512 + c0);
                hf4[rr] = *(const uint4*)(p.hl + t * 512 + c0); hb4[rr] = *(const uint4*)(p.hl + ((size_t)TT + t) * 512 + c0);
                af4[rr] = *(const uint4*)(p.ac + t * 512 + c0); ab4[rr] = *(const uint4*)(p.ac + ((size_t)TT + t) * 512 + c0);
            }
#pragma unroll
            for (int rr = 0; rr < 2; ++rr) {
                const size_t t = (size_t)(tbase + r + 8 * rr);
                float av[8] = {bflo(a4[rr].x), bfhi(a4[rr].x), bflo(a4[rr].y), bfhi(a4[rr].y), bflo(a4[rr].z), bfhi(a4[rr].z), bflo(a4[rr].w), bfhi(a4[rr].w)};
                const float gv[8] = {bflo(g4[rr].x), bfhi(g4[rr].x), bflo(g4[rr].y), bfhi(g4[rr].y), bflo(g4[rr].z), bfhi(g4[rr].z), bflo(g4[rr].w), bfhi(g4[rr].w)};
                const float hf[8] = {bflo(hf4[rr].x), bfhi(hf4[rr].x), bflo(hf4[rr].y), bfhi(hf4[rr].y), bflo(hf4[rr].z), bfhi(hf4[rr].z), bflo(hf4[rr].w), bfhi(hf4[rr].w)};
                const float hb[8] = {bflo(hb4[rr].x), bfhi(hb4[rr].x), bflo(hb4[rr].y), bfhi(hb4[rr].y), bflo(hb4[rr].z), bfhi(hb4[rr].z), bflo(hb4[rr].w), bfhi(hb4[rr].w)};
                const float af[8] = {bflo(af4[rr].x), bfhi(af4[rr].x), bflo(af4[rr].y), bfhi(af4[rr].y), bflo(af4[rr].z), bfhi(af4[rr].z), bflo(af4[rr].w), bfhi(af4[rr].w)};
                const float ab[8] = {bflo(ab4[rr].x), bfhi(ab4[rr].x), bflo(ab4[rr].y), bfhi(ab4[rr].y), bflo(ab4[rr].z), bfhi(ab4[rr].z), bflo(ab4[rr].w), bfhi(ab4[rr].w)};
                float rv[8]; float sa = 0.f, sr = 0.f;
#pragma unroll
                for (int i = 0; i < 8; ++i) { rv[i] = (hf[i] + af[i] * cin[c0 + i] + hb[i] + ab[i] * cin[512 + c0 + i]) * gelu_tanh(gv[i]); sa += av[i] * av[i]; sr += rv[i] * rv[i]; }
                sa = wave_sum(sa); sr = wave_sum(sr);
                const float ra = rsqrtf(sa * (1.f / 512.f) + EPS), rrs = rsqrtf(sr * (1.f / 512.f) + EPS);
#pragma unroll
                for (int i = 0; i < 8; ++i) { av[i] = av[i] * ra * gaq[i]; rv[i] = rv[i] * rrs * grq[i]; }
                uint4 o; o.x = pack2(av[0], av[1]); o.y = pack2(av[2], av[3]); o.z = pack2(av[4], av[5]); o.w = pack2(av[6], av[7]);
                *(uint4*)(p.xn + t * D + c0) = o;
                o.x = pack2(rv[0], rv[1]); o.y = pack2(rv[2], rv[3]); o.z = pack2(rv[4], rv[5]); o.w = pack2(rv[6], rv[7]);
                *(uint4*)(p.xn + t * D + 512 + c0) = o;
            }
        }
    }
}

DEV void route_select(const float (&lg)[16], const float* rb, int& e1, int& e2, float& w1n, float& w2n) {
    float sc_[16], bi[16];
#pragma unroll
    for (int e = 0; e < 16; ++e) { sc_[e] = __builtin_amdgcn_rcpf(1.f + __expf(-lg[e])); bi[e] = sc_[e] + rb[e]; }
    float gs[4];
#pragma unroll
    for (int g = 0; g < 4; ++g) {
        const float a = bi[g * 4], b = bi[g * 4 + 1], c = bi[g * 4 + 2], d = bi[g * 4 + 3];
        const float m1 = fmaxf(fmaxf(a, b), fmaxf(c, d));
        const float m2 = fmaxf(fmaxf(fminf(a, b), fminf(c, d)), fminf(fmaxf(a, b), fmaxf(c, d)));
        gs[g] = m1 + m2;
    }
    int bg = 0; float bgs = gs[0];
#pragma unroll
    for (int g = 1; g < 4; ++g) if (gs[g] > bgs) { bgs = gs[g]; bg = g; }
    float v0 = 0.f, v1 = 0.f, v2 = 0.f, v3 = 0.f, s0 = 0.f, s1 = 0.f, s2 = 0.f, s3 = 0.f;
#pragma unroll
    for (int g = 0; g < 4; ++g) if (bg == g) { v0 = bi[g * 4]; v1 = bi[g * 4 + 1]; v2 = bi[g * 4 + 2]; v3 = bi[g * 4 + 3]; s0 = sc_[g * 4]; s1 = sc_[g * 4 + 1]; s2 = sc_[g * 4 + 2]; s3 = sc_[g * 4 + 3]; }
    int i1 = 0; float b1 = v0, w1 = s0;
    if (v1 > b1) { b1 = v1; i1 = 1; w1 = s1; }
    if (v2 > b1) { b1 = v2; i1 = 2; w1 = s2; }
    if (v3 > b1) { b1 = v3; i1 = 3; w1 = s3; }
    int i2 = -1; float b2 = -1e30f, w2 = 0.f;
    if (i1 != 0 && v0 > b2) { b2 = v0; i2 = 0; w2 = s0; }
    if (i1 != 1 && v1 > b2) { b2 = v1; i2 = 1; w2 = s1; }
    if (i1 != 2 && v2 > b2) { b2 = v2; i2 = 2; w2 = s2; }
    if (i1 != 3 && v3 > b2) { b2 = v3; i2 = 3; w2 = s3; }
    const float inv = __builtin_amdgcn_rcpf(w1 + w2);
    e1 = bg * 4 + i1; e2 = bg * 4 + i2; w1n = w1 * inv; w2n = w2 * inv;
}
DEV void phase_route(const P& p, int l, int bid, int nb, LAS unsigned char* lds) {
    const int tid = otid(), lane = tid & 63, wv = tid >> 6;
    const int nrows = l == 0 ? TT : TL;
    const int rpw = (nrows + nb * 8 - 1) / (nb * 8);
    const int r0 = (bid * 8 + wv) * rpw, r1 = min(r0 + rpw, nrows);
    LAS int* lcnt = (LAS int*)lds;
    LAS int* lbase = (LAS int*)(lds + 64);
    LAS i32x2* ent = (LAS i32x2*)(lds + 128);
    LAS float* rwT = (LAS float*)(lds + 4096);
    __syncthreads();
    if (tid < NE) lcnt[tid] = 0;
    {
        f32x4 rwv[8];
#pragma unroll
        for (int k = 0; k < 8; ++k) rwv[k] = *(const f32x4*)(p.router_w + (size_t)(tid + NTHR * k) * 4);
#pragma unroll
        for (int k = 0; k < 8; ++k) { const int i4 = tid + NTHR * k, d = i4 >> 2, e0 = (i4 & 3) * 4;
#pragma unroll
            for (int j = 0; j < 4; ++j) rwT[(e0 + j) * 1024 + d] = rwv[k][j]; }
    }
    __syncthreads();
    for (int t0 = r0; t0 < r1;) {
        const bool two = (t0 + 1 < r1) && (mod_row(t0 + 1) == mod_row(t0));
        int lo = lane * 4; asm volatile("" : "+v"(lo));
        f32x4 xr[2][4], sh[4], sc[4], ng[4];
        {
            const float* mm = p.mod + (size_t)(l * 9 + mod_row(t0)) * 6144;
#pragma unroll
            for (int rr = 0; rr < 2; ++rr) {
                const float* src = p.xres + (size_t)(two ? t0 + rr : t0) * D;
#pragma unroll
                for (int i = 0; i < 4; ++i) xr[rr][i] = *(const f32x4*)(src + i * 256 + lo);
            }
#pragma unroll
            for (int i = 0; i < 4; ++i) { const int c0 = i * 256 + lo; sh[i] = *(const f32x4*)(mm + 3072 + c0); sc[i] = *(const f32x4*)(mm + 4096 + c0); ng[i] = *(const f32x4*)(p.norm2_g + l * D + c0); }
        }
        float ss0 = 0.f, ss1 = 0.f;
#pragma unroll
        for (int i = 0; i < 4; ++i)
#pragma unroll
            for (int j = 0; j < 4; ++j) { ss0 += xr[0][i][j] * xr[0][i][j]; ss1 += xr[1][i][j] * xr[1][i][j]; }
        ss0 = wave_sum(ss0); ss1 = wave_sum(ss1);
        const float rstd0 = rsqrtf(ss0 * (1.f / D) + EPS), rstd1 = rsqrtf(ss1 * (1.f / D) + EPS);
        f32x4 o0[4], o1[4];
#pragma unroll
        for (int i = 0; i < 4; ++i) {
            const int c0 = i * 256 + lo;
            o0[i] = xr[0][i] * rstd0 * ng[i] * (sc[i] + 1.f) + sh[i]; o1[i] = xr[1][i] * rstd1 * ng[i] * (sc[i] + 1.f) + sh[i];
            *(uint2*)(p.xn + (size_t)t0 * D + c0) = make_uint2(pack2(o0[i][0], o0[i][1]), pack2(o0[i][2], o0[i][3]));
            if (two) *(uint2*)(p.xn + (size_t)(t0 + 1) * D + c0) = make_uint2(pack2(o1[i][0], o1[i][1]), pack2(o1[i][2], o1[i][3]));
        }
        __builtin_amdgcn_sched_barrier(0);
        float lg0[16], lg1[16];
#pragma unroll
        for (int e = 0; e < 16; ++e) { lg0[e] = 0.f; lg1[e] = 0.f; }
#pragma unroll
        for (int i = 0; i < 4; ++i) {
#pragma unroll
            for (int e = 0; e < 16; ++e) {
                const f32x4 r4 = *(const LAS f32x4*)(rwT + e * 1024 + i * 256 + lo);
                lg0[e] += o0[i][0] * r4[0] + o0[i][1] * r4[1] + o0[i][2] * r4[2] + o0[i][3] * r4[3];
                lg1[e] += o1[i][0] * r4[0] + o1[i][1] * r4[1] + o1[i][2] * r4[2] + o1[i][3] * r4[3];
                if ((e & 7) == 7) __builtin_amdgcn_sched_barrier(0);
            }
        }
        float lgs[16];
#pragma unroll
        for (int e = 0; e < 16; ++e) { lg0[e] = wave_sum(lg0[e]); lg1[e] = wave_sum(lg1[e]); lgs[e] = lane < 32 ? lg0[e] : lg1[e]; if ((e & 3) == 3) __builtin_amdgcn_sched_barrier(0); }
        int e1, e2; float w1, w2;
        route_select(lgs, p.router_b, e1, e2, w1, w2);
        if ((lane == 0) || (lane == 32 && two)) {
            const int t = t0 + (lane >> 5);
            p.tokw[2 * t] = w1; p.tokw[2 * t + 1] = w2;
            const int p1 = __hip_atomic_fetch_add(&lcnt[e1], 1, __ATOMIC_RELAXED, __HIP_MEMORY_SCOPE_WORKGROUP);
            const int p2 = __hip_atomic_fetch_add(&lcnt[e2], 1, __ATOMIC_RELAXED, __HIP_MEMORY_SCOPE_WORKGROUP);
            const int nloc = wv * rpw + (t - r0);
            ent[2 * nloc] = (i32x2){2 * t, (e1 << 16) | p1}; ent[2 * nloc + 1] = (i32x2){2 * t + 1, (e2 << 16) | p2};
        }
        t0 += two ? 2 : 1;
    }
    __syncthreads();
    if (tid < NE) lbase[tid] = atomicAdd(&p.cnt[l * 16 + tid], lcnt[tid]);
    __syncthreads();
    for (int i = tid; i < 8 * rpw * 2; i += NTHR) {
        const int nloc = i >> 1, wq = nloc / rpw, k = nloc - wq * rpw;
        if ((bid * 8 + wq) * rpw + k < nrows) { const i32x2 en = ent[i]; const int e = en.y >> 16; p.list[e * TT + lbase[e] + (en.y & 0xffff)] = en.x; }
    }
}

__global__ void __launch_bounds__(NTHR, 2) fwd_megakernel(P p) {
    extern __shared__ __attribute__((aligned(16))) unsigned char lds_raw[];
    LAS unsigned char* lds = (LAS unsigned char*)lds_raw;
    volatile LAS unsigned* misc = (volatile LAS unsigned*)(lds + MISC_OFF);
    if (threadIdx.x < 16) misc[threadIdx.x] = 0u;
    __syncthreads();
    XcdBarrier gbar = xcd_barrier_post(p.bar, misc);
    const int bid = blockIdx.x, nb = gridDim.x;
    LAS float* rope_l = (LAS float*)(lds + MISC_OFF + MISC_ROPE);
    LAS i32x2* ptab = (LAS i32x2*)(lds + MISC_OFF + MISC_PTAB);
    {
        const int tid = otid();
        for (int i = tid; i < 1024; i += NTHR) {
            const int pos = i >> 4, f = i & 15;
            const float inv = exp2f(-(float)(2 * f) / 32.f * 13.287712379549449f);
            const float ang = (float)pos * inv;
            rope_l[i] = __cosf(ang); rope_l[1024 + i] = __sinf(ang);
        }
    }
    phase_prologue(p, bid, nb, lds);
    xcd_barrier(gbar);
#pragma unroll
    for (int l = 0; l < 2; ++l) {
        if (l == 0) phase_rowA<0>(p, l, bid, nb);
        else {
            phase_rowA<1>(p, l, bid, nb);
            const int tid = otid();
            convert_experts(p, 1, bid * 8 + (tid >> 6), nb * 8, (LAS float*)(lds + (tid >> 6) * 16384), tid & 63);
        }
        xcd_barrier(gbar);
        {
            const int tid = otid();
            pg8::GemmPlain g{p.xn, p.wt_in + (size_t)l * INW * D, D};
            pg8::RowMajorOrder so{7, (TT / 256) * 7, nb, bid};
            EpiIn E{&p, l, rope_l};
            pg8::gemm_phase<EpiIn, pg8::GemmPlain, pg8::RowMajorOrder, true>(lds, g, so, E, tid);
        }
        xcd_barrier(gbar);
        { const int tid = otid(); phase_attn_lru(p, l, lds, misc, tid); }
        xcd_barrier(gbar);
        phase_mix(p, l, bid, nb, lds);
        xcd_barrier(gbar);
        {
            const int tid = otid();
            pg8::GemmPlain g{p.xn, p.wt_out + (size_t)l * D * D, D};
            pg8::RowMajorOrder so{4, ((l == 0 ? TT : TL) / 256) * 4, nb, bid};
            EpiOut E{&p, l};
            pg8::gemm_phase<EpiOut, pg8::GemmPlain, pg8::RowMajorOrder, true>(lds, g, so, E, tid);
        }
        xcd_barrier(gbar);
        phase_route(p, l, bid, nb, lds);
        xcd_barrier(gbar);
        {
            const int tid = otid();
            const int np = moe_build_ptab(p.cnt + l * 16, ptab, tid);
            MoeUpDesc g{p.xn, p.wt_gu, D, ptab, p.cnt + l * 16, p.list};
            pg8::RowMajorOrder so{4, np * 4, nb, bid};
            EpiMoeUp E{p.hid};
            pg8::gemm_phase<EpiMoeUp, MoeUpDesc, pg8::RowMajorOrder, true>(lds, g, so, E, tid);
        }
        xcd_barrier(gbar);
        {
            const int tid = otid();
            const int np = ptab[MAXPANELS].x;
            MoeDownDesc g{p.hid, p.wt_d, DE, ptab};
            pg8::RowMajorOrder so{4, np * 4, nb, bid};
            EpiMoeDown E{p.y, p.tokw, ptab, p.cnt + l * 16, p.list};
            pg8::gemm_phase<EpiMoeDown, MoeDownDesc, pg8::RowMajorOrder, true>(lds, g, so, E, tid);
        }
        xcd_barrier(gbar);
    }
    phase_rowA<2>(p, 1, bid, nb);
}

extern "C" void kernel_launch(void* const* d_in, const int* in_sizes, int n_in, void* d_out, int out_size, void* d_ws, size_t ws_size, hipStream_t stream) {
    P p{};
    const float* const* in = (const float* const*)d_in;
    p.x = in[0]; p.c = in[1]; p.ctx = in[2]; p.c_ctx = in[3]; p.ada_w = in[4]; p.ada_b = in[5]; p.norm1_g = in[6]; p.w_in = in[7]; p.q_norm_g = in[8]; p.k_norm_g = in[9];
    p.conv_w = in[10]; p.conv_b = in[11]; p.lru_wa = in[12]; p.lru_ba = in[13]; p.lru_wx = in[14]; p.lru_bx = in[15]; p.lru_lambda = in[16]; p.attn_out_g = in[17];
    p.lru_out_g = in[18]; p.w_out = in[19]; p.norm2_g = in[20]; p.router_w = in[21]; p.router_b = in[22]; p.w_gate = in[23]; p.w_up = in[24]; p.w_down = in[25]; p.final_g = in[26];
    p.out = (float*)d_out;
    char* ws = (char*)d_ws; size_t off = 0;
    auto carve = [&](size_t bytes) { void* r = ws + off; off += (bytes + 255) & ~(size_t)255; return r; };
    p.bar = (unsigned*)carve(XCD_BAR_WORDS * 4);
    p.cnt = (int*)carve(32 * 4);
    p.qctr = (int*)carve(64 * 4);
    const size_t ctl_bytes = off;
    p.mod = (float*)carve((size_t)2 * 9 * 6144 * 4);
    p.tokw = (float*)carve((size_t)2 * TT * 4);
    p.list = (int*)carve((size_t)NE * TT * 4);
    p.sptab = (float*)carve(2 * 2 * 512 * 4);
    p.totA = (float*)carve((size_t)NB * 2 * NCHK * 512 * 4);
    p.totH = (float*)carve((size_t)NB * 2 * NCHK * 512 * 4);
    p.wt_lru = (bf16_t*)carve((size_t)2 * 2 * 8 * 2 * 4096 * 2);
    p.wt_in = (bf16_t*)carve((size_t)2 * INW * D * 2);
    p.wt_out = (bf16_t*)carve((size_t)2 * D * D * 2);
    p.wt_gu = (bf16_t*)carve((size_t)NE * D * D * 2);
    p.wt_d = (bf16_t*)carve((size_t)NE * D * DE * 2);
    p.xres = (float*)carve((size_t)TT * D * 4);
    p.xn = (bf16_t*)carve((size_t)TT * D * 2);
    p.hid = (bf16_t*)carve((size_t)MAXPANELS * 256 * DE * 2);
    p.q = (bf16_t*)carve((size_t)TT * 512 * 2);
    p.y = p.q;
    p.k = (bf16_t*)carve((size_t)TT * 128 * 2);
    p.v = (bf16_t*)carve((size_t)TT * 128 * 2);
    p.u = (bf16_t*)carve((size_t)TT * 512 * 2);
    p.gb = (bf16_t*)carve((size_t)TT * 512 * 2);
    p.hl = (bf16_t*)carve((size_t)2 * TT * 512 * 2);
    p.ac = p.hid;
    if (off > ws_size) { fprintf(stderr, "workspace too small: need %zu have %zu\n", off, ws_size); return; }
    static int grid_blocks = 0;
    if (!grid_blocks) {
        int dev = 0, cus = 0;
        (void)hipGetDevice(&dev);
        (void)hipDeviceGetAttribute(&cus, hipDeviceAttributeMultiprocessorCount, dev);
        if (hipFuncSetAttribute((const void*)fwd_megakernel, hipFuncAttributeMaxDynamicSharedMemorySize, LDS_BYTES) != hipSuccess) { fprintf(stderr, "hipFuncSetAttribute failed\n"); grid_blocks = -1; return; }
        grid_blocks = cus > 0 ? cus : 256;
    }
    if (grid_blocks < 0) return;
    (void)hipMemsetAsync(ws, 0, ctl_bytes, stream);
    hipLaunchKernelGGL(fwd_megakernel, dim3(grid_blocks), dim3(NTHR), LDS_BYTES, stream, p);
}
```
